# Optimizing an MI355X kernel written in HIP

```python
import math
import jax, jax.numpy as jnp
from jax import lax
import numpy as np

D_MODEL = 1024
BATCH = 32
SEQ = 2048
DEPTH = 2

HEAD_DIM = 64
NSA_HEADS = 4
DIFF_HEADS = 4
FOX_HEADS = 8
NSA_WIDTH = NSA_HEADS * HEAD_DIM
DIFF_WIDTH = DIFF_HEADS * HEAD_DIM
FOX_WIDTH = FOX_HEADS * HEAD_DIM
MIX_WIDTH = NSA_WIDTH + DIFF_WIDTH + FOX_WIDTH
NSA_KV_HEADS = 1
NSA_GROUP = NSA_HEADS // NSA_KV_HEADS
NSA_BRANCHES = 3
CMP_BLOCK = 32
CMP_STRIDE = 16
CMP_HIDDEN = 256
SLC_BLOCK = 64
SLC_TOPK = 16
WINDOW = 512
DIFF_QK_DIM = HEAD_DIM // 2
DIFF_V_DIM = HEAD_DIM
D_FF = 2752
PLE_DIM = 256
ROPE_THETA = 10000.0
QUERY_BLOCK = 128
SLC_QUERY_BLOCK = 32
LN_EPS = 1e-5
NEG_BIG = -1e30
DEEPNORM_ALPHA = (2.0 * DEPTH) ** 0.25
DEEPNORM_BETA = (8.0 * DEPTH) ** -0.25
IN_SPLITS = (
    NSA_WIDTH,
    6 * NSA_KV_HEADS * HEAD_DIM,
    NSA_BRANCHES * NSA_HEADS,
    2 * DIFF_HEADS * DIFF_QK_DIM,
    2 * DIFF_HEADS * DIFF_QK_DIM,
    DIFF_HEADS * DIFF_V_DIM,
    FOX_WIDTH, FOX_WIDTH, FOX_WIDTH,
    FOX_HEADS,
)
IN_COLS = sum(IN_SPLITS)

kernel_name = "hymba_nsa_diff_fox_macaron_deepnorm"


def layer_norm(x, g, b):
    xf = x.astype(jnp.float32)
    mu = jnp.mean(xf, axis=-1, keepdims=True)
    var = jnp.mean(jnp.square(xf - mu), axis=-1, keepdims=True)
    return ((xf - mu) * lax.rsqrt(var + LN_EPS) * g.astype(jnp.float32) + b.astype(jnp.float32)).astype(x.dtype)


def rope(x, pos):
    d = x.shape[-1]
    inv = ROPE_THETA ** (-jnp.arange(0, d, 2, dtype=jnp.float32) / d)
    ang = pos.astype(jnp.float32)[:, None] * inv[None, :]
    cos = jnp.cos(ang)[:, None, :]
    sin = jnp.sin(ang)[:, None, :]
    xf = x.astype(jnp.float32)
    x1, x2 = xf[..., : d // 2], xf[..., d // 2:]
    return jnp.concatenate([x1 * cos - x2 * sin, x2 * cos + x1 * sin], axis=-1).astype(x.dtype)


def swiglu(x, w_gate, w_up, w_down):
    return (jax.nn.silu(x @ w_gate) * (x @ w_up)) @ w_down


def masked_softmax(s, mask):
    p = jax.nn.softmax(jnp.where(mask, s.astype(jnp.float32), NEG_BIG), axis=-1)
    return jnp.where(mask, p, 0.0)


def sweep(fn, n_blocks):
    out = jnp.moveaxis(lax.map(fn, jnp.arange(n_blocks)), 0, 1)
    return out.reshape((out.shape[0], -1) + out.shape[3:])


def cmp_to_slc_matrix(n_cmp, n_slc):
    c0 = np.arange(n_cmp) * CMP_STRIDE
    s0 = np.arange(n_slc) * SLC_BLOCK
    m = (c0[:, None] < s0[None, :] + SLC_BLOCK) & (c0[:, None] + CMP_BLOCK > s0[None, :])
    return jnp.asarray(m.astype(np.float32))


def nsa_attention(q, k_cmp, v_cmp, k_slc, v_slc, k_win, v_win, gates, pos_k, pos_v, phi_k1, phi_k2, phi_v1, phi_v2):
    B, S = q.shape[0], q.shape[1]
    scale = HEAD_DIM ** -0.5
    t = jnp.arange(S)
    n_cmp = (S - CMP_BLOCK) // CMP_STRIDE + 1
    starts = jnp.arange(n_cmp) * CMP_STRIDE
    idx = starts[:, None] + jnp.arange(CMP_BLOCK)[None, :]

    def compress(kv, pe, w1, w2):
        blk = kv[:, idx] + pe[:, None, :]
        blk = jnp.transpose(blk, (0, 1, 3, 2, 4)).reshape(B, n_cmp, NSA_KV_HEADS, CMP_BLOCK * HEAD_DIM)
        return jax.nn.gelu(blk @ w1) @ w2

    block_end = starts + CMP_BLOCK - 1
    kc = rope(compress(k_cmp, pos_k, phi_k1, phi_k2), block_end)
    vc = compress(v_cmp, pos_v, phi_v1, phi_v2)
    mask_c = block_end[None, :] <= t[:, None]
    s_c = jnp.einsum('bthgd,bchd->bhgtc', q, kc) * scale
    p_c = masked_softmax(s_c, mask_c)
    o_cmp = jnp.einsum('bhgtc,bchd->bthgd', p_c.astype(vc.dtype), vc)
    n_slc = S // SLC_BLOCK
    top = min(SLC_TOPK, n_slc)
    imp = jnp.sum(p_c, axis=2) @ cmp_to_slc_matrix(n_cmp, n_slc)
    j = jnp.arange(n_slc)[None, :]
    blk_t = (t // SLC_BLOCK)[:, None]
    forced = (j == 0) | (j == blk_t) | (j == blk_t - 1)
    valid = j * SLC_BLOCK <= t[:, None]
    score = jnp.where(forced, 1e9, jnp.where(valid, imp, -1.0))
    _, sel = lax.top_k(score, top)
    sel = jnp.transpose(sel, (0, 2, 1, 3))
    k_blk = jnp.transpose(k_slc.reshape(B, n_slc, SLC_BLOCK, NSA_KV_HEADS, HEAD_DIM), (0, 3, 1, 2, 4))
    v_blk = jnp.transpose(v_slc.reshape(B, n_slc, SLC_BLOCK, NSA_KV_HEADS, HEAD_DIM), (0, 3, 1, 2, 4))
    b_idx = jnp.arange(B)[:, None, None, None]
    h_idx = jnp.arange(NSA_KV_HEADS)[None, None, :, None]

    def slc_block(i):
        t0 = i * SLC_QUERY_BLOCK
        qb = lax.dynamic_slice_in_dim(q, t0, SLC_QUERY_BLOCK, axis=1)
        sb = lax.dynamic_slice_in_dim(sel, t0, SLC_QUERY_BLOCK, axis=1)
        kg = k_blk[b_idx, h_idx, sb]
        vg = v_blk[b_idx, h_idx, sb].reshape(B, SLC_QUERY_BLOCK, NSA_KV_HEADS, top * SLC_BLOCK, HEAD_DIM)
        key_pos = sb[..., None] * SLC_BLOCK + jnp.arange(SLC_BLOCK)
        tq = t0 + jnp.arange(SLC_QUERY_BLOCK)
        mask = (key_pos <= tq[None, :, None, None, None]).reshape(B, SLC_QUERY_BLOCK, NSA_KV_HEADS, 1, top * SLC_BLOCK)
        s = jnp.einsum('bqhgd,bqhkld->bqhgkl', qb, kg) * scale
        p = masked_softmax(s.reshape(B, SLC_QUERY_BLOCK, NSA_KV_HEADS, NSA_GROUP, top * SLC_BLOCK), mask)
        return jnp.einsum('bqhgn,bqhnd->bqhgd', p.astype(vg.dtype), vg)

    o_slc = sweep(slc_block, S // SLC_QUERY_BLOCK)
    k_pad = jnp.pad(k_win, ((0, 0), (WINDOW, 0), (0, 0), (0, 0)))
    v_pad = jnp.pad(v_win, ((0, 0), (WINDOW, 0), (0, 0), (0, 0)))

    def win_block(i):
        t0 = i * QUERY_BLOCK
        qb = lax.dynamic_slice_in_dim(q, t0, QUERY_BLOCK, axis=1)
        kb = lax.dynamic_slice_in_dim(k_pad, t0, WINDOW + QUERY_BLOCK, axis=1)
        vb = lax.dynamic_slice_in_dim(v_pad, t0, WINDOW + QUERY_BLOCK, axis=1)
        key_pos = t0 - WINDOW + jnp.arange(WINDOW + QUERY_BLOCK)
        tq = (t0 + jnp.arange(QUERY_BLOCK))[:, None]
        mask = (key_pos[None, :] <= tq) & (key_pos[None, :] > tq - WINDOW) & (key_pos[None, :] >= 0)
        s = jnp.einsum('bqhgd,bkhd->bhgqk', qb, kb) * scale
        p = masked_softmax(s, mask)
        return jnp.einsum('bhgqk,bkhd->bqhgd', p.astype(vb.dtype), vb)

    o_win = sweep(win_block, S // QUERY_BLOCK)
    out = gates[..., 0:1] * o_cmp + gates[..., 1:2] * o_slc + gates[..., 2:3] * o_win
    return out.reshape(B, S, NSA_WIDTH)


def diff_attention(q, k, v, lam_params, subln_g, lambda_init):
    B, S = q.shape[0], q.shape[1]
    lp = lam_params.astype(jnp.float32)
    lam = jnp.exp(jnp.sum(lp[0] * lp[1])) - jnp.exp(jnp.sum(lp[2] * lp[3])) + lambda_init
    scale = DIFF_QK_DIM ** -0.5
    kpos = jnp.arange(S)

    def block(i):
        t0 = i * QUERY_BLOCK
        qb = lax.dynamic_slice_in_dim(q, t0, QUERY_BLOCK, axis=1)
        mask = kpos[None, :] <= (t0 + jnp.arange(QUERY_BLOCK))[:, None]
        s = jnp.einsum('bqhcd,bkhcd->bhcqk', qb, k) * scale
        p = masked_softmax(s, mask)
        a = p[:, :, 0] - lam * p[:, :, 1]
        return jnp.einsum('bhqk,bkhd->bqhd', a.astype(v.dtype), v)

    o = sweep(block, S // QUERY_BLOCK).astype(jnp.float32)
    o = o * lax.rsqrt(jnp.mean(jnp.square(o), axis=-1, keepdims=True) + LN_EPS) * subln_g.astype(jnp.float32)
    o = o * (1.0 - lambda_init)
    return o.astype(v.dtype).reshape(B, S, DIFF_WIDTH)


def forgetting_attention(q, k, v, f_logit):
    B, S = q.shape[0], q.shape[1]
    c = jnp.cumsum(jax.nn.log_sigmoid(f_logit.astype(jnp.float32)), axis=1)
    cT = jnp.transpose(c, (0, 2, 1))
    scale = HEAD_DIM ** -0.5
    kpos = jnp.arange(S)

    def block(i):
        t0 = i * QUERY_BLOCK
        qb = lax.dynamic_slice_in_dim(q, t0, QUERY_BLOCK, axis=1)
        cq = lax.dynamic_slice_in_dim(cT, t0, QUERY_BLOCK, axis=2)
        mask = kpos[None, :] <= (t0 + jnp.arange(QUERY_BLOCK))[:, None]
        s = jnp.einsum('bqhd,bkhd->bhqk', qb, k).astype(jnp.float32) * scale + (cq[..., :, None] - cT[..., None, :])
        p = masked_softmax(s, mask)
        return jnp.einsum('bhqk,bkhd->bqhd', p.astype(v.dtype), v)

    return sweep(block, S // QUERY_BLOCK).reshape(B, S, FOX_WIDTH)


def hybrid_mixer(x, w_in, fox_b_f, nsa_pos_k, nsa_pos_v, nsa_phi_k1, nsa_phi_k2, nsa_phi_v1, nsa_phi_v2,
                 diff_lambda, diff_subln_g, w_out, lambda_init):
    B, S, _ = x.shape
    pos = jnp.arange(S, dtype=jnp.int32)
    proj = x @ w_in
    offsets = np.cumsum(IN_SPLITS)[:-1].tolist()
    nsa_q, nsa_kv, nsa_g, diff_q, diff_k, diff_v, fox_q, fox_k, fox_v, fox_f = jnp.split(proj, offsets, axis=-1)
    q = rope(nsa_q.reshape(B, S, NSA_HEADS, HEAD_DIM), pos).reshape(B, S, NSA_KV_HEADS, NSA_GROUP, HEAD_DIM)
    kv = nsa_kv.reshape(B, S, 6, NSA_KV_HEADS, HEAD_DIM)
    gates = jax.nn.sigmoid(nsa_g.reshape(B, S, NSA_KV_HEADS, NSA_GROUP, NSA_BRANCHES))
    o_nsa = nsa_attention(q, kv[:, :, 0], kv[:, :, 1], rope(kv[:, :, 2], pos), kv[:, :, 3],
                          rope(kv[:, :, 4], pos), kv[:, :, 5], gates,
                          nsa_pos_k, nsa_pos_v, nsa_phi_k1, nsa_phi_k2, nsa_phi_v1, nsa_phi_v2)
    dq = rope(diff_q.reshape(B, S, 2 * DIFF_HEADS, DIFF_QK_DIM), pos).reshape(B, S, DIFF_HEADS, 2, DIFF_QK_DIM)
    dk = rope(diff_k.reshape(B, S, 2 * DIFF_HEADS, DIFF_QK_DIM), pos).reshape(B, S, DIFF_HEADS, 2, DIFF_QK_DIM)
    o_diff = diff_attention(dq, dk, diff_v.reshape(B, S, DIFF_HEADS, DIFF_V_DIM), diff_lambda, diff_subln_g, lambda_init)
    o_fox = forgetting_attention(fox_q.reshape(B, S, FOX_HEADS, HEAD_DIM), fox_k.reshape(B, S, FOX_HEADS, HEAD_DIM),
                                 fox_v.reshape(B, S, FOX_HEADS, HEAD_DIM), fox_f + fox_b_f)
    return jnp.concatenate([o_nsa, o_diff, o_fox], axis=-1) @ w_out


def setup_inputs(seed: int = 0) -> dict:
    key = jax.random.key(seed)
    ks = iter(jax.random.split(key, 32))
    L = DEPTH

    def nrm(shape, scale):
        return jax.random.normal(next(ks), shape, jnp.float32) * scale

    return {
        "x": nrm((BATCH, SEQ, D_MODEL), 1.0),
        "p": nrm((DEPTH, BATCH, SEQ, PLE_DIM), 1.0),
        "ln_g": 1.0 + nrm((L, 3, D_MODEL), 0.01),
        "ln_b": nrm((L, 3, D_MODEL), 0.01),
        "ffn1_w_gate": nrm((L, D_MODEL, D_FF), D_MODEL ** -0.5),
        "ffn1_w_up": nrm((L, D_MODEL, D_FF), D_MODEL ** -0.5),
        "ffn1_w_down": nrm((L, D_FF, D_MODEL), DEEPNORM_BETA * D_FF ** -0.5),
        "ffn2_w_gate": nrm((L, D_MODEL, D_FF), D_MODEL ** -0.5),
        "ffn2_w_up": nrm((L, D_MODEL, D_FF), D_MODEL ** -0.5),
        "ffn2_w_down": nrm((L, D_FF, D_MODEL), DEEPNORM_BETA * D_FF ** -0.5),
        "w_in": nrm((L, D_MODEL, IN_COLS), D_MODEL ** -0.5),
        "fox_b_f": 2.0 + nrm((L, FOX_HEADS), 0.1),
        "nsa_pos_k": nrm((L, CMP_BLOCK, HEAD_DIM), 0.02),
        "nsa_pos_v": nrm((L, CMP_BLOCK, HEAD_DIM), 0.02),
        "nsa_phi_k1": nrm((L, CMP_BLOCK * HEAD_DIM, CMP_HIDDEN), (CMP_BLOCK * HEAD_DIM) ** -0.5),
        "nsa_phi_k2": nrm((L, CMP_HIDDEN, HEAD_DIM), CMP_HIDDEN ** -0.5),
        "nsa_phi_v1": nrm((L, CMP_BLOCK * HEAD_DIM, CMP_HIDDEN), (CMP_BLOCK * HEAD_DIM) ** -0.5),
        "nsa_phi_v2": nrm((L, CMP_HIDDEN, HEAD_DIM), CMP_HIDDEN ** -0.5),
        "diff_lambda": nrm((L, 4, DIFF_QK_DIM), 0.1),
        "diff_subln_g": 1.0 + nrm((L, DIFF_V_DIM), 0.01),
        "w_out": nrm((L, MIX_WIDTH, D_MODEL), DEEPNORM_BETA * MIX_WIDTH ** -0.5),
        "ple_w_gate": nrm((L, D_MODEL, D_MODEL), D_MODEL ** -0.5),
        "ple_b_gate": nrm((L, D_MODEL), 0.01),
        "ple_w_proj": nrm((L, PLE_DIM, D_MODEL), PLE_DIM ** -0.5),
    }


def reference(x, p, ln_g, ln_b, ffn1_w_gate, ffn1_w_up, ffn1_w_down, ffn2_w_gate, ffn2_w_up, ffn2_w_down,
              w_in, fox_b_f, nsa_pos_k, nsa_pos_v, nsa_phi_k1, nsa_phi_k2, nsa_phi_v1, nsa_phi_v2,
              diff_lambda, diff_subln_g, w_out, ple_w_gate, ple_b_gate, ple_w_proj):
    for i in range(DEPTH):
        lambda_init = 0.8 - 0.6 * math.exp(-0.3 * i)
        h = 0.5 * swiglu(x, ffn1_w_gate[i], ffn1_w_up[i], ffn1_w_down[i])
        x = layer_norm(DEEPNORM_ALPHA * x + h, ln_g[i, 0], ln_b[i, 0])
        h = hybrid_mixer(x, w_in[i], fox_b_f[i], nsa_pos_k[i], nsa_pos_v[i], nsa_phi_k1[i], nsa_phi_k2[i],
                         nsa_phi_v1[i], nsa_phi_v2[i], diff_lambda[i], diff_subln_g[i], w_out[i], lambda_init)
        x = layer_norm(DEEPNORM_ALPHA * x + h, ln_g[i, 1], ln_b[i, 1])
        h = 0.5 * swiglu(x, ffn2_w_gate[i], ffn2_w_up[i], ffn2_w_down[i])
        x = layer_norm(DEEPNORM_ALPHA * x + h, ln_g[i, 2], ln_b[i, 2])
        x = x + jax.nn.sigmoid(x @ ple_w_gate[i] + ple_b_gate[i]) * (p[i] @ ple_w_proj[i])
    return x
```

```cpp
#include <hip/hip_runtime.h>
#include <hip/hip_cooperative_groups.h>
#include <cstdio>
#include <cstdint>
#include <cmath>
namespace cg = cooperative_groups;

__device__ __forceinline__ int lane_here() { int l; asm volatile("v_mbcnt_lo_u32_b32 %0, -1, 0\n\tv_mbcnt_hi_u32_b32 %0, -1, %0" : "=&v"(l)); return l; }
template <int O> __device__ __forceinline__ int shxi(int v) {
    if constexpr (O < 32) return __builtin_amdgcn_ds_swizzle(v, (O << 10) | 0x1f);
    else return __builtin_amdgcn_ds_bpermute((lane_here() ^ O) << 2, v);
}
template <int O> __device__ __forceinline__ float shx(float v) { return __builtin_bit_cast(float, shxi<O>(__builtin_bit_cast(int, v))); }

#define DI __device__ __forceinline__
#define LAS __attribute__((address_space(3)))
typedef unsigned short bf16_t;
typedef short bf16x8 __attribute__((ext_vector_type(8)));
typedef short s16x4 __attribute__((ext_vector_type(4)));
typedef float f32x2 __attribute__((ext_vector_type(2)));
typedef float f32x4 __attribute__((ext_vector_type(4)));
typedef float f32x16 __attribute__((ext_vector_type(16)));
typedef unsigned u32x2 __attribute__((ext_vector_type(2)));
typedef unsigned u32x4 __attribute__((ext_vector_type(4)));
typedef __bf16 bf16x2_t __attribute__((ext_vector_type(2)));

constexpr int DM = 1024, BATCH = 32, SEQ = 2048, DEPTH = 2, MTOK = BATCH * SEQ, DFF = 2752, DFFP = 2816, NUP = 2 * DFFP, NPROJ = 3072, PLED = 256;
constexpr int IN_COLS = 2964;
constexpr int C_NQ = 0, C_NKV = 256, C_DQ = 640, C_DK = 896, C_DV = 1152, C_FQ = 1408, C_FK = 1920, C_FV = 2432, C_NG = 2944, C_FF = 2956;
constexpr float LN_EPS = 1e-5f;
constexpr float DN_ALPHA = 1.41421356237f;
constexpr float LOG2E = 1.44269504089f;

constexpr size_t MiB = 1u << 20;
constexpr size_t WS_CTL = 0;
constexpr size_t WS_TBL = 1 * MiB;
constexpr size_t TB_COS64 = 0, TB_SIN64 = 256 * 1024, TB_COS32 = 512 * 1024, TB_SIN32 = 640 * 1024, TB_CBIAS = 768 * 1024, TB_LAM = 772 * 1024;
constexpr size_t WS_KC = 2 * MiB, WS_VC = 2 * MiB + 512 * 1024;
constexpr size_t WS_SEL = 3 * MiB;
constexpr size_t WS_CKL = 4 * MiB;
constexpr size_t WS_W = 8 * MiB, W_LAYER = 46 * MiB;
constexpr size_t W_UP1 = 0, W_DN1 = 11 * MiB, W_UP2 = W_DN1 + 5632 * 1024, W_DN2 = W_UP2 + 11 * MiB, W_IN = W_DN2 + 5632 * 1024, W_OUT = W_IN + 6 * MiB,
                 W_PLEG = W_OUT + 2 * MiB, W_PLEP = W_PLEG + 2 * MiB, W_K1 = W_PLEP + 512 * 1024, W_V1 = W_K1 + 1 * MiB, W_K2 = W_V1 + 1 * MiB, W_V2 = W_K2 + 32 * 1024;
static_assert(W_V2 + 32 * 1024 <= W_LAYER, "weights fit");
constexpr size_t WS_XB = 100 * MiB;
constexpr size_t WS_PB = 228 * MiB;
constexpr size_t WS_OCMP = 292 * MiB;
constexpr size_t WS_MIX = 356 * MiB;
constexpr size_t WS_BIG = 484 * MiB;
constexpr size_t WS_PP = 836 * MiB;
constexpr size_t WS_ST = 976 * MiB;
constexpr size_t WS_END = 1024 * MiB;
constexpr size_t CTL_FOLD = 65536, CTL_FOLD_LAYER = 98304;
constexpr int FO_CS_IN = 0, FO_CB_IN = 3072, FO_CS_UP = 6144, FO_CB_UP = 11776, FO_CS_PG = 17408, FO_CB_PG = 18432;
constexpr int CW_QUEUE = 64;

DI unsigned pk2(float lo, float hi) { f32x2 v = {lo, hi}; return __builtin_bit_cast(unsigned, __builtin_convertvector(v, bf16x2_t)); }
DI float bf2f(bf16_t h) { return __uint_as_float((unsigned)h << 16); }
DI bf16_t f2bf(float f) { return (bf16_t)(pk2(f, 0.f) & 0xffffu); }
DI float wave_sum(float v) {
    v += shx<1>(v); v += shx<2>(v); v += shx<4>(v); v += shx<8>(v); v += shx<16>(v); v += shx<32>(v);
    return v;
}
DI int crow(int i, int hh) { return (i & 3) + 8 * (i >> 2) + 4 * hh; }
#define MFMA32(a, b, c) __builtin_amdgcn_mfma_f32_32x32x16_bf16((a), (b), (c), 0, 0, 0)
#define MFMA16(a, b, c) __builtin_amdgcn_mfma_f32_16x16x32_bf16((a), (b), (c), 0, 0, 0)
#define LDS_WAIT() asm volatile("s_waitcnt lgkmcnt(0)" ::: "memory")

struct Args {
    const float* in[24]; float* out; unsigned char* ws; int ph_lo, ph_hi;
};
typedef const __attribute__((address_space(4))) Args* ARGP;
struct Ctx {
    int tid, lane, wave, bid, G;
    unsigned char* ws; LAS unsigned char* lds;
};

namespace pg8 {
#define PG8_LAS __attribute__((address_space(3)))
typedef unsigned short bf16_t;
typedef short bf16x8 __attribute__((ext_vector_type(8)));
typedef float f32x4 __attribute__((ext_vector_type(4)));
typedef unsigned u32x4 __attribute__((ext_vector_type(4)));
constexpr int BM = 256, BK = 64, HALF = 128, HTB = HALF * BK * 2  , STAGE_BYTES = 8 * HTB, NXCD = 8, WGM = 8;

__host__ __device__ __forceinline__ int lds_byte(int r, int c) { const int st = (r >> 4) * 2 + (c >> 5), rr = r & 15, cc = c & 31, ob = rr * 64 + cc * 2; return st * 1024 + (ob ^ (((ob >> 9) & 1) << 5)); }
__host__ __device__ __forceinline__ void stage_rc(int b, int& R, int& C) { const int st = b / 1024, sb = b % 1024, swz = sb ^ (((sb >> 9) & 1) << 5); R = (st >> 1) * 16 + swz / 64; C = (st & 1) * 32 + (swz % 64) / 2; }
__host__ __device__ __forceinline__ int perm32(int rho) { const int n = rho >> 4, i = rho & 15; return 8 * (i >> 2) + 4 * n + (i & 3); }

struct Unit { int pm, pn; };
struct Gemm { const bf16_t* A; const bf16_t* Bt; int M, N, K; };

struct StaticOrder {
    int nM, nN, nwg, G, c;
    __host__ __device__ void init(int M, int N, int G_, int c_) { nM = M / BM; nN = N / BM; nwg = nM * nN; G = G_; c = c_; }
    __host__ __device__ bool next(int i, Unit& u) const {
        const long L = (long)i * G + c; if (L >= nwg) return false;
        int wgid = (int)L; { const int q = nwg / NXCD, r = nwg % NXCD, xcd = wgid % NXCD, off = wgid / NXCD; wgid = (xcd < r ? xcd * (q + 1) : r * (q + 1) + (xcd - r) * q) + off; }
        const int nig = WGM * nN, gid = wgid / nig, fm = gid * WGM, gsz = (nM - fm) < WGM ? (nM - fm) : WGM;
        u.pm = fm + ((wgid % nig) % gsz); u.pn = (wgid % nig) / gsz; return true;
    }
    __device__ __forceinline__ void a_ready(const Unit&) const {}
    __device__ __forceinline__ void done(const Unit&) const {}
};

__device__ __forceinline__ unsigned cvt_pk_bf16(float lo, float hi) { unsigned r; asm volatile("v_cvt_pk_bf16_f32 %0, %1, %2" : "=v"(r) : "v"(lo), "v"(hi)); return r; }
typedef unsigned u32x2 __attribute__((ext_vector_type(2)));
typedef float f32x2 __attribute__((ext_vector_type(2)));
struct EpiBf16 {
    static constexpr bool PERM = true, AFTER_DRAIN = false;
    bf16_t* O; int ldc;
    __device__ __forceinline__ void operator()(const f32x4 (&acc)[2][2][4][2], const Unit& u, int wr, int wc, int fr, int fq) const {
        asm volatile("" : "+v"(fr), "+v"(fq));
        const int row0 = u.pm * BM + wr * 64 + fr; const int col0 = u.pn * BM + wc * 32 + 8 * fq;
#pragma unroll
        for (int ai = 0; ai < 2; ++ai)
#pragma unroll
            for (int m = 0; m < 4; ++m) { bf16_t* rowp = O + (size_t)(row0 + ai * HALF + m * 16) * ldc + col0;
#pragma unroll
                for (int bj = 0; bj < 2; ++bj) { const f32x4 v0 = acc[ai][bj][m][0], v1 = acc[ai][bj][m][1];
                    u32x4 w; w.x = cvt_pk_bf16(v0[0], v0[1]); w.y = cvt_pk_bf16(v0[2], v0[3]); w.z = cvt_pk_bf16(v1[0], v1[1]); w.w = cvt_pk_bf16(v1[2], v1[3]);
                    *(u32x4*)(rowp + bj * HALF) = w; } __builtin_amdgcn_sched_barrier(0); }
    }
};
__device__ __forceinline__ float silu_mul(float g, float uu) { return g * uu * __builtin_amdgcn_rcpf(1.0f + __builtin_amdgcn_exp2f(-1.44269504f * g)); }
struct EpiSwiGLU {
    static constexpr bool PERM = true, AFTER_DRAIN = false;
    bf16_t* H; int ldh;
    __device__ __forceinline__ void operator()(const f32x4 (&acc)[2][2][4][2], const Unit& u, int wr, int wc, int fr, int fq) const {
        asm volatile("" : "+v"(fr), "+v"(fq));
        const int row0 = u.pm * BM + wr * 64 + fr; const int col0 = u.pn * HALF + wc * 32 + 8 * fq;
#pragma unroll
        for (int ai = 0; ai < 2; ++ai)
#pragma unroll
            for (int m = 0; m < 4; ++m) { bf16_t* rowp = H + (size_t)(row0 + ai * HALF + m * 16) * ldh + col0;
                const f32x4 g0 = acc[ai][0][m][0], g1 = acc[ai][0][m][1], u0 = acc[ai][1][m][0], u1 = acc[ai][1][m][1];
                u32x4 w; w.x = cvt_pk_bf16(silu_mul(g0[0], u0[0]), silu_mul(g0[1], u0[1])); w.y = cvt_pk_bf16(silu_mul(g0[2], u0[2]), silu_mul(g0[3], u0[3]));
                w.z = cvt_pk_bf16(silu_mul(g1[0], u1[0]), silu_mul(g1[1], u1[1])); w.w = cvt_pk_bf16(silu_mul(g1[2], u1[2]), silu_mul(g1[3], u1[3]));
                *(u32x4*)rowp = w; __builtin_amdgcn_sched_barrier(0); }
    }
};
struct EpiResid {
    static constexpr bool PERM = false, AFTER_DRAIN = false;
    const float* X; float* Y; float alpha, s;
    __device__ __forceinline__ void operator()(const f32x4 (&acc)[2][2][4][2], const Unit& u, int wr, int wc, int fr, int fq) const {
        asm volatile("" : "+v"(fr), "+v"(fq));
        const int col0 = u.pn * BM + wc * 32 + 4 * fq;
#pragma unroll
        for (int ai = 0; ai < 2; ++ai)
#pragma unroll
            for (int m = 0; m < 4; ++m) { const size_t off = (size_t)(u.pm * BM + ai * HALF + wr * 64 + m * 16 + fr) * 1024 + col0;
#pragma unroll
                for (int bj = 0; bj < 2; ++bj)
#pragma unroll
                    for (int n = 0; n < 2; ++n) { const f32x4 xv = *(const f32x4*)(X + off + bj * HALF + n * 16);
                        *(f32x4*)(Y + off + bj * HALF + n * 16) = xv * alpha + acc[ai][bj][m][n] * s; } __builtin_amdgcn_sched_barrier(0); }
    }
};
struct EpiPle {
    static constexpr bool PERM = false, AFTER_DRAIN = false;
    const float* X; float* OUT; bf16_t* XB; const float* bias; const bf16_t* PP;
    __device__ __forceinline__ void operator()(const f32x4 (&acc)[2][2][4][2], const Unit& u, int wr, int wc, int fr, int fq) const {
        asm volatile("" : "+v"(fr), "+v"(fq));
        const int col0 = u.pn * BM + wc * 32 + 4 * fq;
#pragma unroll
        for (int ai = 0; ai < 2; ++ai)
#pragma unroll
            for (int m = 0; m < 4; ++m) { const size_t off = (size_t)(u.pm * BM + ai * HALF + wr * 64 + m * 16 + fr) * 1024 + col0;
#pragma unroll
                for (int bj = 0; bj < 2; ++bj)
#pragma unroll
                    for (int n = 0; n < 2; ++n) { const int co = bj * HALF + n * 16;
                        const f32x4 xv = *(const f32x4*)(X + off + co); const f32x4 bv = *(const f32x4*)(bias + col0 + co);
                        const u32x2 pw = *(const u32x2*)(PP + off + co);
                        f32x4 pv; pv[0] = __uint_as_float(pw.x << 16); pv[1] = __uint_as_float(pw.x & 0xffff0000u); pv[2] = __uint_as_float(pw.y << 16); pv[3] = __uint_as_float(pw.y & 0xffff0000u);
                        f32x4 o;
#pragma unroll
                        for (int e = 0; e < 4; ++e) { const float z = acc[ai][bj][m][n][e] + bv[e]; const float sg = __builtin_amdgcn_rcpf(1.0f + __builtin_amdgcn_exp2f(-1.44269504f * z)); o[e] = xv[e] + sg * pv[e]; }
                        *(f32x4*)(OUT + off + co) = o;
                        u32x2 w; w.x = cvt_pk_bf16(o[0], o[1]); w.y = cvt_pk_bf16(o[2], o[3]); *(u32x2*)(XB + off + co) = w; } __builtin_amdgcn_sched_barrier(0); }
    }
};
constexpr float EPI_LN_EPS = 1e-5f;
__device__ __forceinline__ void row_stats(const float* ST, int row, int fq, float& mu, float& rstd) {
    const f32x4* p = (const f32x4*)(ST + (size_t)row * 32) + fq * 2; const f32x4 a = p[0], b = p[1];
    float s = (a[0] + a[2]) + (b[0] + b[2]), q = (a[1] + a[3]) + (b[1] + b[3]);
    s += shx<16>(s); s += shx<32>(s); q += shx<16>(q); q += shx<32>(q);
    mu = s * (1.0f / 1024.0f); const float var = q * (1.0f / 1024.0f) - mu * mu; rstd = __builtin_amdgcn_rsqf(var + EPI_LN_EPS);
}
struct EpiResidLN {
    static constexpr bool PERM = false, AFTER_DRAIN = false;
    const float* Xin; unsigned char* ws; ::ARGP args; int sp, sn, lnk; float alpha, s; int useLN;
    __device__ __forceinline__ void operator()(const f32x4 (&acc)[2][2][4][2], const Unit& u, int wr, int wc, int fr, int fq) const {
        asm volatile("" : "+v"(fr), "+v"(fq));
        unsigned char* w_ = ws; asm volatile("" : "+s"(w_));
        float* Y = (float*)args->out; bf16_t* YB = (bf16_t*)(w_ + ::WS_XB);
        const float* STp = (const float*)(w_ + ::WS_ST) + (size_t)sp * ::MTOK * 32; float* STn = (float*)(w_ + ::WS_ST) + (size_t)sn * ::MTOK * 32;
        const float* g = args->in[2] + (size_t)lnk * 1024; const float* b = args->in[3] + (size_t)lnk * 1024;
        const int col0 = u.pn * BM + wc * 32 + 4 * fq;
#pragma unroll
        for (int ai = 0; ai < 2; ++ai)
#pragma unroll
            for (int m = 0; m < 4; ++m) { const int row = u.pm * BM + ai * HALF + wr * 64 + m * 16 + fr; const size_t off = (size_t)row * 1024 + col0;
                float mu = 0.f, rstd = 1.f; if (useLN) row_stats(STp, row, fq, mu, rstd);
                float sm = 0.f, sq = 0.f;
#pragma unroll
                for (int bj = 0; bj < 2; ++bj)
#pragma unroll
                    for (int n = 0; n < 2; ++n) { const int co = bj * HALF + n * 16; f32x4 xv = *(const f32x4*)(Xin + off + co);
                        if (useLN) { const f32x4 gv = *(const f32x4*)(g + col0 + co), bv = *(const f32x4*)(b + col0 + co); xv = (xv - mu) * rstd * gv + bv; }
                        const f32x4 yv = xv * alpha + acc[ai][bj][m][n] * s; *(f32x4*)(Y + off + co) = yv;
                        u32x2 w; w.x = cvt_pk_bf16(yv[0], yv[1]); w.y = cvt_pk_bf16(yv[2], yv[3]); *(u32x2*)(YB + off + co) = w;
                        sm += (yv[0] + yv[1]) + (yv[2] + yv[3]); sq += (yv[0] * yv[0] + yv[1] * yv[1]) + (yv[2] * yv[2] + yv[3] * yv[3]); }
                sm += shx<16>(sm); sm += shx<32>(sm); sq += shx<16>(sq); sq += shx<32>(sq);
                if (fq == 0) { f32x2 st; st[0] = sm; st[1] = sq; *(f32x2*)(STn + (size_t)row * 32 + (u.pn * 4 + wc) * 2) = st; }
                __builtin_amdgcn_sched_barrier(0); }
    }
};
struct EpiBf16LN {
    static constexpr bool PERM = true, AFTER_DRAIN = false;
    unsigned char* ws; int ldc, sp, fo_cs, fo_cb, L;
    __device__ __forceinline__ void operator()(const f32x4 (&acc)[2][2][4][2], const Unit& u, int wr, int wc, int fr, int fq) const {
        asm volatile("" : "+v"(fr), "+v"(fq));
        unsigned char* w_ = ws; asm volatile("" : "+s"(w_));
        bf16_t* O = (bf16_t*)(w_ + ::WS_BIG); const float* ST = (const float*)(w_ + ::WS_ST) + (size_t)sp * ::MTOK * 32;
        const float* cs = (const float*)(w_ + ::WS_CTL + ::CTL_FOLD + (size_t)L * ::CTL_FOLD_LAYER) + fo_cs; const float* cb = cs + (fo_cb - fo_cs);
        const int col0 = u.pn * BM + wc * 32 + 8 * fq;
#pragma unroll
        for (int ai = 0; ai < 2; ++ai)
#pragma unroll
            for (int m = 0; m < 4; ++m) { const int row = u.pm * BM + ai * HALF + wr * 64 + m * 16 + fr; bf16_t* rowp = O + (size_t)row * ldc + col0;
                float mu, rstd; row_stats(ST, row, fq, mu, rstd); const float mr = mu * rstd;
#pragma unroll
                for (int bj = 0; bj < 2; ++bj) { const int c = col0 + bj * HALF;
                    const f32x4 s0 = *(const f32x4*)(cs + c), s1 = *(const f32x4*)(cs + c + 4), b0 = *(const f32x4*)(cb + c), b1 = *(const f32x4*)(cb + c + 4);
                    const f32x4 v0 = acc[ai][bj][m][0] * rstd - s0 * mr + b0, v1 = acc[ai][bj][m][1] * rstd - s1 * mr + b1;
                    u32x4 w; w.x = cvt_pk_bf16(v0[0], v0[1]); w.y = cvt_pk_bf16(v0[2], v0[3]); w.z = cvt_pk_bf16(v1[0], v1[1]); w.w = cvt_pk_bf16(v1[2], v1[3]);
                    *(u32x4*)(rowp + bj * HALF) = w; }
                __builtin_amdgcn_sched_barrier(0); }
    }
};
struct EpiSwiGLULN {
    static constexpr bool PERM = true, AFTER_DRAIN = false;
    unsigned char* ws; int ldh, sp, fo_cs, fo_cb, L;
    __device__ __forceinline__ void operator()(const f32x4 (&acc)[2][2][4][2], const Unit& u, int wr, int wc, int fr, int fq) const {
        asm volatile("" : "+v"(fr), "+v"(fq));
        unsigned char* w_ = ws; asm volatile("" : "+s"(w_));
        bf16_t* H = (bf16_t*)(w_ + ::WS_BIG); const float* ST = (const float*)(w_ + ::WS_ST) + (size_t)sp * ::MTOK * 32;
        const float* cs = (const float*)(w_ + ::WS_CTL + ::CTL_FOLD + (size_t)L * ::CTL_FOLD_LAYER) + fo_cs; const float* cb = cs + (fo_cb - fo_cs);
        const int hcol0 = u.pn * HALF + wc * 32 + 8 * fq, c0 = u.pn * BM + wc * 32 + 8 * fq;
#pragma unroll
        for (int ai = 0; ai < 2; ++ai)
#pragma unroll
            for (int m = 0; m < 4; ++m) { const int row = u.pm * BM + ai * HALF + wr * 64 + m * 16 + fr; bf16_t* rowp = H + (size_t)row * ldh + hcol0;
                float mu, rstd; row_stats(ST, row, fq, mu, rstd); const float mr = mu * rstd;
                f32x4 gu[2][2];
#pragma unroll
                for (int bj = 0; bj < 2; ++bj)
#pragma unroll
                    for (int n = 0; n < 2; ++n) { const int c = c0 + bj * HALF + 4 * n; const f32x4 sv = *(const f32x4*)(cs + c), bv = *(const f32x4*)(cb + c); gu[bj][n] = acc[ai][bj][m][n] * rstd - sv * mr + bv; }
                u32x4 w; w.x = cvt_pk_bf16(silu_mul(gu[0][0][0], gu[1][0][0]), silu_mul(gu[0][0][1], gu[1][0][1])); w.y = cvt_pk_bf16(silu_mul(gu[0][0][2], gu[1][0][2]), silu_mul(gu[0][0][3], gu[1][0][3]));
                w.z = cvt_pk_bf16(silu_mul(gu[0][1][0], gu[1][1][0]), silu_mul(gu[0][1][1], gu[1][1][1])); w.w = cvt_pk_bf16(silu_mul(gu[0][1][2], gu[1][1][2]), silu_mul(gu[0][1][3], gu[1][1][3]));
                *(u32x4*)rowp = w; __builtin_amdgcn_sched_barrier(0); }
    }
};
struct EpiPleLN {
    static constexpr bool PERM = false, AFTER_DRAIN = false;
    unsigned char* ws; ::ARGP args; int sp, lnk, L;
    __device__ __forceinline__ void operator()(const f32x4 (&acc)[2][2][4][2], const Unit& u, int wr, int wc, int fr, int fq) const {
        asm volatile("" : "+v"(fr), "+v"(fq));
        unsigned char* w_ = ws; asm volatile("" : "+s"(w_));
        float* Y = (float*)args->out; bf16_t* XB2 = (bf16_t*)(w_ + ::WS_MIX); const bf16_t* PP = (const bf16_t*)(w_ + ::WS_PP); const float* ST = (const float*)(w_ + ::WS_ST) + (size_t)sp * ::MTOK * 32;
        const float* g = args->in[2] + (size_t)lnk * 1024; const float* b = args->in[3] + (size_t)lnk * 1024;
        const float* cs = (const float*)(w_ + ::WS_CTL + ::CTL_FOLD + (size_t)L * ::CTL_FOLD_LAYER) + ::FO_CS_PG; const float* cb = cs + (::FO_CB_PG - ::FO_CS_PG);
        const int col0 = u.pn * BM + wc * 32 + 4 * fq;
#pragma unroll
        for (int ai = 0; ai < 2; ++ai)
#pragma unroll
            for (int m = 0; m < 4; ++m) { const int row = u.pm * BM + ai * HALF + wr * 64 + m * 16 + fr; const size_t off = (size_t)row * 1024 + col0;
                float mu, rstd; row_stats(ST, row, fq, mu, rstd); const float mr = mu * rstd;
#pragma unroll
                for (int bj = 0; bj < 2; ++bj)
#pragma unroll
                    for (int n = 0; n < 2; ++n) { const int co = bj * HALF + n * 16;
                        const f32x4 yv = *(const f32x4*)(Y + off + co), gv = *(const f32x4*)(g + col0 + co), bv = *(const f32x4*)(b + col0 + co);
                        const f32x4 sv = *(const f32x4*)(cs + col0 + co), cv = *(const f32x4*)(cb + col0 + co); const u32x2 pw = *(const u32x2*)(PP + off + co);
                        f32x4 pv; pv[0] = __uint_as_float(pw.x << 16); pv[1] = __uint_as_float(pw.x & 0xffff0000u); pv[2] = __uint_as_float(pw.y << 16); pv[3] = __uint_as_float(pw.y & 0xffff0000u);
                        const f32x4 x3 = (yv - mu) * rstd * gv + bv; const f32x4 z = acc[ai][bj][m][n] * rstd - sv * mr + cv; f32x4 o;
#pragma unroll
                        for (int e = 0; e < 4; ++e) { const float sg = __builtin_amdgcn_rcpf(1.0f + __builtin_amdgcn_exp2f(-1.44269504f * z[e])); o[e] = x3[e] + sg * pv[e]; }
                        *(f32x4*)(Y + off + co) = o; u32x2 w; w.x = cvt_pk_bf16(o[0], o[1]); w.y = cvt_pk_bf16(o[2], o[3]); *(u32x2*)(XB2 + off + co) = w; }
                __builtin_amdgcn_sched_barrier(0); }
    }
};
template <class Epi, class Sched, bool ALIGN_EPI = false, bool SP2 = false>
__device__ __forceinline__ void gemm_phase(PG8_LAS unsigned char* lds, const Gemm g, const Sched& S, const Epi& E, const int tid_in) {
    int tid_ = tid_in; asm volatile("" : "+v"(tid_));
    const int tid = tid_, wid = __builtin_amdgcn_readfirstlane(tid >> 6), lane = tid & 63, wr = wid >> 2, wc = wid & 3, fr = lane & 15, fq = lane >> 4;
    const int K = g.K, nt = K / BK;
    unsigned voffA[2], voffB[2];
#pragma unroll
    for (int i = 0; i < 2; ++i) { int R, C; stage_rc(tid * 16 + i * 8192, R, C); const int Rb = Epi::PERM ? ((R & ~31) + perm32(R & 31)) : R;
        voffA[i] = (unsigned)(R * K + C) * 2u; voffB[i] = (unsigned)(Rb * K + C) * 2u; }
    const size_t kstep = (size_t)(BK * 2);
    const size_t hstep = (size_t)HALF * K * 2;
    const size_t tstep = 2 * hstep;
    const unsigned ldsw = (unsigned)wid * 1024u;
    const int aoff = lds_byte(wr * 64 + fr, fq * 8), boff = lds_byte(wc * 32 + fr, fq * 8);
#define PG8_SA(b, h) (((b) * 2 + (h)) * HTB)
#define PG8_SB(b, h) ((4 + (b) * 2 + (h)) * HTB)
#define PG8_STAGE(bufoff, gbase, voff) do { _Pragma("unroll") for (int _i = 0; _i < 2; ++_i) \
        __builtin_amdgcn_global_load_lds((const unsigned*)((const char*)(gbase) + (voff)[_i]), (PG8_LAS unsigned*)(lds + (bufoff) + ldsw + _i * 8192), 16, 0, 0); } while (0)
#define PG8_LDA(dst, b, h) do { _Pragma("unroll") for (int m = 0; m < 4; ++m) _Pragma("unroll") for (int k = 0; k < 2; ++k) dst[m][k] = *(const PG8_LAS bf16x8*)(lds + PG8_SA(b, h) + aoff + m * 2048 + k * 1024); } while (0)
#define PG8_LDB(dst, b, h) do { _Pragma("unroll") for (int n = 0; n < 2; ++n) _Pragma("unroll") for (int k = 0; k < 2; ++k) dst[n][k] = *(const PG8_LAS bf16x8*)(lds + PG8_SB(b, h) + boff + n * 2048 + k * 1024); } while (0)
#define PG8_MMA(ai, bj, At, Bt) do { __builtin_amdgcn_s_setprio(1); _Pragma("unroll") for (int m = 0; m < 4; ++m) _Pragma("unroll") for (int n = 0; n < 2; ++n) _Pragma("unroll") for (int k = 0; k < 2; ++k) \
        acc[ai][bj][m][n] = __builtin_amdgcn_mfma_f32_16x16x32_bf16(Bt[n][k], At[m][k], acc[ai][bj][m][n], 0, 0, 0); __builtin_amdgcn_s_setprio(0); } while (0)
#define PG8_WAIT_V(n) asm volatile("s_waitcnt vmcnt(" #n ")" ::: "memory")
#define PG8_WAIT_L(n) asm volatile("s_waitcnt lgkmcnt(" #n ")" ::: "memory")
#define PG8_BAR __builtin_amdgcn_s_barrier()
#define PG8_SCHED __builtin_amdgcn_sched_barrier(0)
    Unit cur, nxt; int ui = 0;
    if (!S.next(0, cur)) return;
    f32x4 acc[2][2][4][2];
#pragma unroll
    for (int a = 0; a < 2; ++a)
#pragma unroll
        for (int b = 0; b < 2; ++b)
#pragma unroll
            for (int m = 0; m < 4; ++m)
#pragma unroll
                for (int n = 0; n < 2; ++n) acc[a][b][m][n] = (f32x4){0.f, 0.f, 0.f, 0.f};
    bf16x8 At[4][2], B0[2][2], B1[2][2];
    const char* cA = (const char*)g.A + (size_t)cur.pm * tstep; const char* cB = (const char*)g.Bt + (size_t)cur.pn * tstep;
    S.a_ready(cur);
    if constexpr (SP2) {
        PG8_STAGE(PG8_SB(0, 0), cB, voffB); PG8_STAGE(PG8_SB(0, 1), cB + hstep, voffB); PG8_STAGE(PG8_SA(0, 0), cA, voffA); PG8_STAGE(PG8_SA(0, 1), cA + hstep, voffA);
        if (wr == 1) PG8_BAR;
        PG8_WAIT_V(2); PG8_BAR;
        PG8_STAGE(PG8_SB(1, 0), cB + kstep, voffB); PG8_STAGE(PG8_SA(1, 0), cA + kstep, voffA); PG8_STAGE(PG8_SB(1, 1), cB + hstep + kstep, voffB);
        PG8_WAIT_V(6); PG8_BAR;
    } else {
        PG8_STAGE(PG8_SB(0, 0), cB, voffB); PG8_STAGE(PG8_SA(0, 0), cA, voffA); PG8_STAGE(PG8_SB(0, 1), cB + hstep, voffB); PG8_STAGE(PG8_SA(0, 1), cA + hstep, voffA);
        if (wr == 1) PG8_BAR;
        PG8_WAIT_V(4); PG8_BAR;
        PG8_STAGE(PG8_SB(1, 0), cB + kstep, voffB); PG8_STAGE(PG8_SA(1, 0), cA + kstep, voffA); PG8_STAGE(PG8_SB(1, 1), cB + hstep + kstep, voffB);
        PG8_WAIT_V(6); PG8_BAR;
    }
    for (;;) {
        const bool has_next = S.next(ui + 1, nxt);
        const char* nA = has_next ? (const char*)g.A + (size_t)nxt.pm * tstep : cA; const char* nB = has_next ? (const char*)g.Bt + (size_t)nxt.pn * tstep : cB;
        for (int t = 0; t < nt; t += 2) {
            const bool last = (t == nt - 2);
            const char* a1 = cA + (size_t)(t + 1) * kstep;
            const char* a2 = last ? nA : cA + (size_t)(t + 2) * kstep; const char* b2 = last ? nB : cB + (size_t)(t + 2) * kstep;
            const char* a3 = a2 + kstep; const char* b3 = b2 + kstep;
            if (last && has_next) S.a_ready(nxt);
            if constexpr (SP2) {
            PG8_LDB(B0, 0, 0); PG8_LDB(B1, 0, 1); PG8_SCHED; PG8_LDA(At, 0, 0); PG8_STAGE(PG8_SA(1, 1), a1 + hstep, voffA);
            PG8_WAIT_V(8); PG8_WAIT_L(0); PG8_BAR; PG8_MMA(0, 0, At, B0); PG8_MMA(0, 1, At, B1); PG8_BAR; PG8_SCHED;
            PG8_LDA(At, 0, 1); PG8_STAGE(PG8_SB(0, 0), b2, voffB); PG8_STAGE(PG8_SB(0, 1), b2 + hstep, voffB); PG8_STAGE(PG8_SA(0, 0), a2, voffA);
            PG8_WAIT_V(8); PG8_WAIT_L(0); PG8_BAR; PG8_MMA(1, 0, At, B0); PG8_MMA(1, 1, At, B1); PG8_BAR; PG8_SCHED;
            PG8_LDB(B0, 1, 0); PG8_LDB(B1, 1, 1); PG8_SCHED; PG8_LDA(At, 1, 0); PG8_STAGE(PG8_SA(0, 1), a2 + hstep, voffA);
            PG8_WAIT_V(8); PG8_WAIT_L(0); PG8_BAR; PG8_MMA(0, 0, At, B0); PG8_MMA(0, 1, At, B1); PG8_BAR; PG8_SCHED;
            PG8_LDA(At, 1, 1); PG8_STAGE(PG8_SB(1, 0), b3, voffB); PG8_STAGE(PG8_SB(1, 1), b3 + hstep, voffB); PG8_STAGE(PG8_SA(1, 0), a3, voffA);
            PG8_WAIT_V(8); PG8_WAIT_L(0); PG8_BAR; PG8_MMA(1, 0, At, B0); PG8_MMA(1, 1, At, B1); PG8_BAR; PG8_SCHED;
            } else {
            PG8_LDB(B0, 0, 0); PG8_SCHED; PG8_LDA(At, 0, 0); PG8_STAGE(PG8_SA(1, 1), a1 + hstep, voffA);
            PG8_WAIT_L(8); PG8_BAR; PG8_WAIT_L(0); PG8_MMA(0, 0, At, B0); PG8_BAR; PG8_SCHED;
            PG8_LDB(B1, 0, 1); PG8_STAGE(PG8_SB(0, 0), b2, voffB);
            PG8_BAR; PG8_WAIT_L(0); PG8_MMA(0, 1, At, B1); PG8_BAR;
            PG8_LDA(At, 0, 1); PG8_STAGE(PG8_SA(0, 0), a2, voffA);
            PG8_BAR; PG8_WAIT_L(0); PG8_MMA(1, 0, At, B0); PG8_BAR; PG8_SCHED;
            PG8_STAGE(PG8_SB(0, 1), b2 + hstep, voffB);
            PG8_WAIT_V(6); PG8_BAR; PG8_MMA(1, 1, At, B1); PG8_BAR;
            PG8_LDB(B0, 1, 0); PG8_SCHED; PG8_LDA(At, 1, 0); PG8_STAGE(PG8_SA(0, 1), a2 + hstep, voffA);
            PG8_WAIT_L(8); PG8_BAR; PG8_WAIT_L(0); PG8_MMA(0, 0, At, B0); PG8_BAR; PG8_SCHED;
            PG8_LDB(B1, 1, 1); PG8_STAGE(PG8_SB(1, 0), b3, voffB);
            PG8_BAR; PG8_WAIT_L(0); PG8_MMA(0, 1, At, B1); PG8_BAR;
            PG8_LDA(At, 1, 1); PG8_STAGE(PG8_SA(1, 0), a3, voffA);
            PG8_BAR; PG8_WAIT_L(0); PG8_MMA(1, 0, At, B0); PG8_BAR; PG8_SCHED;
            PG8_STAGE(PG8_SB(1, 1), b3 + hstep, voffB);
            PG8_WAIT_V(6); PG8_BAR; PG8_MMA(1, 1, At, B1); PG8_BAR;
            }
        }
        if constexpr (ALIGN_EPI) { if (wr == 0) PG8_BAR; }
        if constexpr (!Epi::AFTER_DRAIN) { E(acc, cur, wr, wc, fr, fq); S.done(cur); }
        if (!has_next) break;
#pragma unroll
        for (int a = 0; a < 2; ++a)
#pragma unroll
            for (int b = 0; b < 2; ++b)
#pragma unroll
                for (int m = 0; m < 4; ++m)
#pragma unroll
                    for (int n = 0; n < 2; ++n) acc[a][b][m][n] = (f32x4){0.f, 0.f, 0.f, 0.f};
        cur = nxt; cA = nA; cB = nB; ++ui;
        if constexpr (ALIGN_EPI) { if (wr == 1) PG8_BAR; }
    }
    PG8_WAIT_V(0);
    if constexpr (!ALIGN_EPI) { if (wr == 0) PG8_BAR; }
    PG8_BAR;
    if constexpr (Epi::AFTER_DRAIN) { E.fused(acc, cur, wr, wc, fr, fq, lds, wid, lane); S.done(cur); }
#undef PG8_SA
#undef PG8_SB
#undef PG8_STAGE
#undef PG8_LDA
#undef PG8_LDB
#undef PG8_MMA
#undef PG8_WAIT_V
#undef PG8_WAIT_L
#undef PG8_BAR
#undef PG8_SCHED
}
}
DI void tr_item(const float* W, int ldn, int Ksrc, int srccol, bf16_t* WT, int ldk, int k0, int nrow0, LAS float* scr, int lane,
                const float* gvec = nullptr, const float* bvec = nullptr, float* CS = nullptr, float* CB = nullptr, const float* addb = nullptr) {
    float csum = 0.f, cbsum = 0.f;
#pragma unroll 8
    for (int i = 0; i < 32; ++i) { const int kk = 2 * i + (lane >> 5), k = k0 + kk; float v = 0.f; if (srccol >= 0 && k < Ksrc) v = W[(size_t)k * ldn + srccol];
        if (gvec) { cbsum += v * bvec[k]; v *= gvec[k]; csum += __uint_as_float(pk2(v, 0.f) << 16); }
        scr[kk * 33 + (lane & 31)] = v; }
    if (gvec) { csum += shx<32>(csum); cbsum += shx<32>(cbsum);
        if (lane < 32 && srccol >= 0) { atomicAdd(CS + nrow0 + lane, csum); atomicAdd(CB + nrow0 + lane, cbsum + ((addb && k0 == 0) ? addb[srccol] : 0.f)); } }
    LDS_WAIT();
    const int c = lane & 7;
#pragma unroll
    for (int j = 0; j < 4; ++j) { const int n = (lane >> 3) + 8 * j; const LAS float* s = scr + (8 * c) * 33 + n;
        u32x4 o; o.x = pk2(s[0 * 33], s[1 * 33]); o.y = pk2(s[2 * 33], s[3 * 33]); o.z = pk2(s[4 * 33], s[5 * 33]); o.w = pk2(s[6 * 33], s[7 * 33]);
        *(u32x4*)(WT + (size_t)(nrow0 + n) * ldk + k0 + 8 * c) = o; }
    LDS_WAIT();
}
DI int win_map(int n) { return n < 640 ? n : (n < 2944 ? n + 12 : (n < 2956 ? n - 2944 + 640 : (n < 2964 ? n : -1))); }

DI void prep_phase(const Ctx& C, ARGP a) {
    LAS float* scr = (LAS float*)(C.lds + C.wave * 16384);
    const int gw = C.bid * 8 + C.wave, NGW = C.G * 8, lane = C.lane;
    constexpr int I_UP = 16 * 176, I_DN = 44 * 32, I_IN = 16 * 96, I_SQ = 16 * 32, I_PP = 4 * 32, I_P1 = 32 * 8, I_P2 = 4 * 2;
    constexpr int PER_LAYER = 2 * I_UP + 2 * I_DN + I_IN + 2 * I_SQ + I_PP + 2 * I_P1 + 2 * I_P2;
    for (int it = gw; it < DEPTH * PER_LAYER; it += NGW) {
        const int L = it / PER_LAYER; int r = it % PER_LAYER;
        unsigned char* wb = C.ws + WS_W + (size_t)L * W_LAYER;
        float* fold = (float*)(C.ws + WS_CTL + CTL_FOLD + (size_t)L * CTL_FOLD_LAYER);
        const float* lng = a->in[2] + (size_t)L * 3 * DM; const float* lnb = a->in[3] + (size_t)L * 3 * DM;
        if (r < 2 * I_UP) { const int f = r / I_UP; r %= I_UP; const int kb = r / 176, nb = r % 176; const int n = 32 * nb + (lane & 31);
            const int pn = n >> 8, bj = (n >> 7) & 1, hid = 128 * pn + (n & 127);
            const float* src = a->in[(f ? 7 : 4) + bj] + (size_t)L * DM * DFF;
            if (f) tr_item(src, DFF, DM, hid < DFF ? hid : -1, (bf16_t*)(wb + W_UP2), DM, 64 * kb, 32 * nb, scr, lane, lng + DM, lnb + DM, fold + FO_CS_UP, fold + FO_CB_UP);
            else tr_item(src, DFF, DM, hid < DFF ? hid : -1, (bf16_t*)(wb + W_UP1), DM, 64 * kb, 32 * nb, scr, lane);
            continue; }
        r -= 2 * I_UP;
        if (r < 2 * I_DN) { const int f = r / I_DN; r %= I_DN; const int kb = r / 32, nb = r % 32;
            const float* src = a->in[f ? 9 : 6] + (size_t)L * DFF * DM;
            tr_item(src, DM, DFF, 32 * nb + (lane & 31), (bf16_t*)(wb + (f ? W_DN2 : W_DN1)), DFFP, 64 * kb, 32 * nb, scr, lane); continue; }
        r -= 2 * I_DN;
        if (r < I_IN) { const int kb = r / 96, nb = r % 96;
            tr_item(a->in[10] + (size_t)L * DM * IN_COLS, IN_COLS, DM, win_map(32 * nb + (lane & 31)), (bf16_t*)(wb + W_IN), DM, 64 * kb, 32 * nb, scr, lane, lng, lnb, fold + FO_CS_IN, fold + FO_CB_IN); continue; }
        r -= I_IN;
        if (r < 2 * I_SQ) { const int f = r / I_SQ; r %= I_SQ; const int kb = r / 32, nb = r % 32;
            if (f) tr_item(a->in[21] + (size_t)L * DM * DM, DM, DM, 32 * nb + (lane & 31), (bf16_t*)(wb + W_PLEG), DM, 64 * kb, 32 * nb, scr, lane, lng + 2 * DM, lnb + 2 * DM, fold + FO_CS_PG, fold + FO_CB_PG, a->in[22] + (size_t)L * DM);
            else tr_item(a->in[20] + (size_t)L * DM * DM, DM, DM, 32 * nb + (lane & 31), (bf16_t*)(wb + W_OUT), DM, 64 * kb, 32 * nb, scr, lane);
            continue; }
        r -= 2 * I_SQ;
        if (r < I_PP) { const int kb = r / 32, nb = r % 32;
            tr_item(a->in[23] + (size_t)L * PLED * DM, DM, PLED, 32 * nb + (lane & 31), (bf16_t*)(wb + W_PLEP), PLED, 64 * kb, 32 * nb, scr, lane); continue; }
        r -= I_PP;
        if (r < 2 * I_P1) { const int f = r / I_P1; r %= I_P1; const int kb = r / 8, nb = r % 8;
            tr_item(a->in[f ? 16 : 14] + (size_t)L * 2048 * 256, 256, 2048, 32 * nb + (lane & 31), (bf16_t*)(wb + (f ? W_V1 : W_K1)), 2048, 64 * kb, 32 * nb, scr, lane); continue; }
        r -= 2 * I_P1;
        { const int f = r / I_P2; r %= I_P2; const int kb = r / 2, nb = r % 2;
            tr_item(a->in[f ? 17 : 15] + (size_t)L * 256 * 64, 64, 256, 32 * nb + (lane & 31), (bf16_t*)(wb + (f ? W_V2 : W_K2)), 256, 64 * kb, 32 * nb, scr, lane); }
    }
    const size_t gt = (size_t)C.bid * 512 + C.tid, NT = (size_t)C.G * 512;
    { const float* x = a->in[0]; bf16_t* xb = (bf16_t*)(C.ws + WS_XB);
      for (size_t i = gt; i < (size_t)MTOK * DM / 8; i += NT) { const f32x4 v0 = *(const f32x4*)(x + i * 8), v1 = *(const f32x4*)(x + i * 8 + 4);
          u32x4 o; o.x = pk2(v0[0], v0[1]); o.y = pk2(v0[2], v0[3]); o.z = pk2(v1[0], v1[1]); o.w = pk2(v1[2], v1[3]); *(u32x4*)(xb + i * 8) = o; }
      const float* p = a->in[1]; bf16_t* pb = (bf16_t*)(C.ws + WS_PB);
      for (size_t i = gt; i < (size_t)DEPTH * MTOK * PLED / 8; i += NT) { const f32x4 v0 = *(const f32x4*)(p + i * 8), v1 = *(const f32x4*)(p + i * 8 + 4);
          u32x4 o; o.x = pk2(v0[0], v0[1]); o.y = pk2(v0[2], v0[3]); o.z = pk2(v1[0], v1[1]); o.w = pk2(v1[2], v1[3]); *(u32x4*)(pb + i * 8) = o; } }
    { float* tb = (float*)(C.ws + WS_TBL);
      for (size_t i = gt; i < (size_t)SEQ * 48; i += NT) {
          int pos, k; float inv; const bool big = i < (size_t)SEQ * 32; size_t j;
          if (big) { j = i; pos = (int)(i >> 5); k = (int)(i & 31); inv = exp2f(-(float)k * (13.2877123795f / 32.0f)); }
          else { j = i - (size_t)SEQ * 32; pos = (int)(j >> 4); k = (int)(j & 15); inv = exp2f(-(float)k * (13.2877123795f / 16.0f)); }
          const float ang = (float)pos * inv; double rv = (double)ang * 0.15915494309189535; rv -= floor(rv); const float fr = (float)rv;
          const float cs = __builtin_amdgcn_cosf(fr), sn = __builtin_amdgcn_sinf(fr);
          if (big) { tb[TB_COS64 / 4 + j] = cs; tb[TB_SIN64 / 4 + j] = sn; } else { tb[TB_COS32 / 4 + j] = cs; tb[TB_SIN32 / 4 + j] = sn; } } }
    { float* cb = (float*)(C.ws + WS_TBL + TB_CBIAS);
      for (int o = gw; o < DEPTH * 2 * 256; o += NGW) { const int L = o >> 9, kv = (o >> 8) & 1, n = o & 255;
          const float* pe = a->in[kv ? 13 : 12] + (size_t)L * 2048; const float* w1 = a->in[kv ? 16 : 14] + (size_t)L * 2048 * 256;
          float s = 0.f; for (int k = lane; k < 2048; k += 64) s += pe[k] * w1[(size_t)k * 256 + n];
          s = wave_sum(s); if (lane == 0) cb[o] = s; } }
    if (C.bid == 0 && C.tid < DEPTH) { const int L = C.tid; const float* lp = a->in[18] + L * 128; float s1 = 0.f, s2 = 0.f;
        for (int k = 0; k < 32; ++k) { s1 += lp[k] * lp[32 + k]; s2 += lp[64 + k] * lp[96 + k]; }
        const float li = 0.8f - 0.6f * __builtin_amdgcn_exp2f(-0.3f * LOG2E * (float)L);
        ((float*)(C.ws + WS_TBL + TB_LAM))[L] = __builtin_amdgcn_exp2f(LOG2E * s1) - __builtin_amdgcn_exp2f(LOG2E * s2) + li; }
}

DI void ln_phase(const Ctx& C, float* X, bf16_t* XB, const float* g, const float* b) {
    const int gw = C.bid * 8 + C.wave, NGW = C.G * 8, lane = C.lane;
    f32x4 gv[4], bv[4];
#pragma unroll
    for (int j = 0; j < 4; ++j) { gv[j] = *(const f32x4*)(g + 4 * lane + 256 * j); bv[j] = *(const f32x4*)(b + 4 * lane + 256 * j); }
    for (int m = gw; m < MTOK; m += NGW) {
        float* xr = X + (size_t)m * DM + 4 * lane; f32x4 v[4]; float s = 0.f;
#pragma unroll
        for (int j = 0; j < 4; ++j) { v[j] = *(const f32x4*)(xr + 256 * j); s += (v[j][0] + v[j][1]) + (v[j][2] + v[j][3]); }
        const float mean = wave_sum(s) * (1.f / DM); float s2 = 0.f;
#pragma unroll
        for (int j = 0; j < 4; ++j) { v[j] = v[j] - mean; s2 += (v[j][0] * v[j][0] + v[j][1] * v[j][1]) + (v[j][2] * v[j][2] + v[j][3] * v[j][3]); }
        const float rstd = __builtin_amdgcn_rsqf(wave_sum(s2) * (1.f / DM) + LN_EPS);
        bf16_t* xo = XB + (size_t)m * DM + 4 * lane;
#pragma unroll
        for (int j = 0; j < 4; ++j) { const f32x4 o = v[j] * rstd * gv[j] + bv[j]; *(f32x4*)(xr + 256 * j) = o;
            u32x2 w; w.x = pk2(o[0], o[1]); w.y = pk2(o[2], o[3]); *(u32x2*)(xo + 256 * j) = w; }
    }
}
#define XLAS __attribute__((address_space(3)))
#define XB_TMO      128
#define XB_XCNT(j)  (256  + 64 * (j))
#define XB_XSUB(j)  (1280 + 64 * (j))
#define XB_XGEN(j)  (2304 + 64 * (j))
#define XB_TOP      3328
#define XB_TOPGEN   3392
#define XCD_BAR_WORDS 3456
#define XB_SPIN_CAP (1u << 18)

__device__ __forceinline__ unsigned xb_ld(unsigned* p)              { return __hip_atomic_load(p, __ATOMIC_RELAXED, __HIP_MEMORY_SCOPE_AGENT); }
__device__ __forceinline__ unsigned xb_add(unsigned* p, unsigned v) { return __hip_atomic_fetch_add(p, v, __ATOMIC_RELAXED, __HIP_MEMORY_SCOPE_AGENT); }
__device__ __forceinline__ unsigned xb_xcc_id() { return (unsigned)__builtin_amdgcn_s_getreg((3 << 11) | 20) & 0xFu; }
#define XB_SPIN(cond, bar) do { unsigned _sp = 0; while (cond) { __builtin_amdgcn_s_sleep(1); \
    if ((++_sp & 255u) == 0u) { if (xb_ld(&(bar)[XB_TMO])) break; if (_sp > XB_SPIN_CAP) { atomicAdd(&(bar)[XB_TMO], 1u); break; } } } } while (0)

struct XcdBarrier {
    unsigned* bar; unsigned x;
    volatile XLAS unsigned* st;
};

__device__ __forceinline__ XcdBarrier xcd_barrier_post(unsigned* bar, volatile XLAS unsigned* st) {
    XcdBarrier b; b.bar = bar; b.x = xb_xcc_id(); b.st = st;
    if (threadIdx.x == 0) (void)xb_add(&bar[XB_XCNT(b.x)], 1u);
    return b;
}
__device__ __forceinline__ void xcd_barrier_complete(unsigned* bar, unsigned x, unsigned& nloc, unsigned& nx) {
    const unsigned G = gridDim.x * gridDim.y * gridDim.z;
    unsigned sum, cnt, mine, sp = 0u;
    for (;;) {
        sum = 0u; cnt = 0u; mine = 0u;
#pragma unroll
        for (unsigned j = 0; j < 16; ++j) { const unsigned c = xb_ld(&bar[XB_XCNT(j)]); sum += c; cnt += (c > 0u) ? 1u : 0u; mine = (j == x) ? c : mine; }
        if (sum == G) break;
        __builtin_amdgcn_s_sleep(1);
        if ((++sp & 255u) == 0u) { if (xb_ld(&bar[XB_TMO])) break; if (sp > XB_SPIN_CAP) { atomicAdd(&bar[XB_TMO], 1u); break; } }
    }
    nloc = mine > 0u ? mine : 1u; nx = cnt > 0u ? cnt : 1u;
}

__device__ __forceinline__ void xcd_barrier(const XcdBarrier& b, const bool leader) {
    asm volatile("s_waitcnt vmcnt(0)" ::: "memory");
    __syncthreads();
    if (leader) {
        unsigned* bar = b.bar;
        __builtin_amdgcn_s_waitcnt(0);
        unsigned nloc = b.st[0], nx = b.st[1];
        if (nloc == 0u) { xcd_barrier_complete(bar, b.x, nloc, nx); b.st[0] = nloc; b.st[1] = nx; }
        const unsigned old = xb_add(&bar[XB_XSUB(b.x)], 1u);
        const unsigned gen = old / nloc;
        if (old + 1u == (gen + 1u) * nloc) {
            __builtin_amdgcn_fence(__ATOMIC_RELEASE, "agent");
            asm volatile("s_waitcnt vmcnt(0)" ::: "memory");
            const unsigned og = xb_add(&bar[XB_TOP], 1u);
            const unsigned tg = og / nx;
            if (og + 1u == (tg + 1u) * nx) xb_add(&bar[XB_TOPGEN], 1u);
            else XB_SPIN(xb_ld(&bar[XB_TOPGEN]) == tg, bar);
            __builtin_amdgcn_fence(__ATOMIC_ACQUIRE, "agent");
            xb_add(&bar[XB_XGEN(b.x)], 1u);
            asm volatile("s_waitcnt vmcnt(0)" ::: "memory");
        } else {
            XB_SPIN(xb_ld(&bar[XB_XGEN(b.x)]) == gen, bar);
            __builtin_amdgcn_fence(__ATOMIC_ACQUIRE, "agent");
            asm volatile("s_waitcnt vmcnt(0)" ::: "memory");
        }
    }
    __syncthreads();
}
DI float gelu_tanh(float x) { const float z = 0.7978845608f * (x + 0.044715f * x * x * x); const float e = __builtin_amdgcn_exp2f(2.0f * LOG2E * z); return 0.5f * x * (2.0f - 2.0f * __builtin_amdgcn_rcpf(e + 1.0f)); }

DI void cmp_mlp_unit(const Ctx& C, const bf16_t* proj, int b, int cgp, int kv, const bf16_t* W1t, const bf16_t* W2t, const float* bias, bf16_t* outp, const float* cos64, const float* sin64) {
    constexpr int SP = 72, HP = 264;
    LAS bf16_t* span = (LAS bf16_t*)C.lds;
    LAS bf16_t* Hs = (LAS bf16_t*)(C.lds + 528 * SP * 2);
    LAS float* Os = (LAS float*)(C.lds + 528 * SP * 2 + 32 * HP * 2);
    const int tid = C.tid, lane = C.lane, w = C.wave, row16 = lane & 15, quad = lane >> 4;
    const int t0 = 512 * cgp;
    for (int idx = tid; idx < 528 * 8; idx += 512) { const int tr = idx >> 3, ch = idx & 7, t = t0 + tr; u32x4 v = {0u, 0u, 0u, 0u};
        if (t < SEQ) v = *(const u32x4*)(proj + (size_t)(b * SEQ + t) * NPROJ + C_NKV + kv * 64 + ch * 8);
        *(LAS u32x4*)(span + tr * SP + ch * 8) = v; }
    __syncthreads();
    f32x4 acc[2][2];
#pragma unroll
    for (int i = 0; i < 2; ++i)
#pragma unroll
        for (int j = 0; j < 2; ++j) acc[i][j] = (f32x4){0.f, 0.f, 0.f, 0.f};
    const bf16_t* wb0 = W1t + (size_t)(32 * w + row16) * 2048 + quad * 8;
#pragma unroll 4
    for (int ks = 0; ks < 64; ++ks) { const int l = ks >> 1, dq = ks & 1, k0 = l * 64 + 32 * dq;
        const bf16x8 b0 = *(const bf16x8*)(wb0 + k0), b1 = *(const bf16x8*)(wb0 + 16 * 2048 + k0);
        const bf16x8 a0 = *(const LAS bf16x8*)(span + (16 * row16 + l) * SP + 32 * dq + quad * 8);
        const bf16x8 a1 = *(const LAS bf16x8*)(span + (16 * (16 + row16) + l) * SP + 32 * dq + quad * 8);
        acc[0][0] = MFMA16(a0, b0, acc[0][0]); acc[0][1] = MFMA16(a0, b1, acc[0][1]); acc[1][0] = MFMA16(a1, b0, acc[1][0]); acc[1][1] = MFMA16(a1, b1, acc[1][1]); }
#pragma unroll
    for (int mi = 0; mi < 2; ++mi)
#pragma unroll
        for (int ni = 0; ni < 2; ++ni) { const int n = 32 * w + 16 * ni + row16; const float bs = bias[n];
#pragma unroll
            for (int j = 0; j < 4; ++j) Hs[(16 * mi + quad * 4 + j) * HP + n] = f2bf(gelu_tanh(acc[mi][ni][j] + bs)); }
    __syncthreads();
    { const int mt = w >> 2, nt = w & 3; f32x4 a2 = {0.f, 0.f, 0.f, 0.f};
#pragma unroll
      for (int ks = 0; ks < 8; ++ks) { const bf16x8 av = *(const LAS bf16x8*)(Hs + (16 * mt + row16) * HP + 32 * ks + quad * 8);
          const bf16x8 bv = *(const bf16x8*)(W2t + (size_t)(16 * nt + row16) * 256 + 32 * ks + quad * 8); a2 = MFMA16(av, bv, a2); }
#pragma unroll
      for (int j = 0; j < 4; ++j) Os[(16 * mt + quad * 4 + j) * 64 + 16 * nt + row16] = a2[j]; }
    __syncthreads();
    { const int c = tid >> 4, cglob = 32 * cgp + c; bf16_t* op = outp + (size_t)(b * 128 + cglob) * 64;
#pragma unroll
      for (int e = 0; e < 2; ++e) { const int i = (tid & 15) * 2 + e; float x1 = Os[c * 64 + i], x2 = Os[c * 64 + i + 32];
          if (cglob >= 127) { x1 = 0.f; x2 = 0.f; }
          else if (kv == 0) { const int pos = 16 * cglob + 31; const float cs = cos64[pos * 32 + i], sn = sin64[pos * 32 + i]; const float y1 = x1 * cs - x2 * sn, y2 = x2 * cs + x1 * sn; x1 = y1; x2 = y2; }
          op[i] = f2bf(x1); op[i + 32] = f2bf(x2); } }
    __syncthreads();
}

DI void attn_prep_phase(const Ctx& C, ARGP a, int L) {
    bf16_t* proj = (bf16_t*)(C.ws + WS_BIG);
    const float* tb = (const float*)(C.ws + WS_TBL);
    const float* cos64 = tb + TB_COS64 / 4; const float* sin64 = tb + TB_SIN64 / 4; const float* cos32 = tb + TB_COS32 / 4; const float* sin32 = tb + TB_SIN32 / 4;
    unsigned char* wb = C.ws + WS_W + (size_t)L * W_LAYER;
    for (int u = C.bid; u < BATCH * 4 * 2; u += C.G) { const int kv = u & 1, cgp = (u >> 1) & 3, b = u >> 3;
        cmp_mlp_unit(C, proj, b, cgp, kv, (const bf16_t*)(wb + (kv ? W_V1 : W_K1)), (const bf16_t*)(wb + (kv ? W_V2 : W_K2)),
                     (const float*)(C.ws + WS_TBL + TB_CBIAS) + (L * 2 + kv) * 256, (bf16_t*)(C.ws + (kv ? WS_VC : WS_KC)), cos64, sin64); }
    const int gw = C.bid * 8 + C.wave, NGW = C.G * 8, lane = C.lane;
    for (int m = gw; m < MTOK; m += NGW) { const int pos = m & (SEQ - 1); bf16_t* row = proj + (size_t)m * NPROJ;
#pragma unroll
        for (int k = 0; k < 7; ++k) { const int pi = lane + 64 * k; int c0, half; float cs, sn;
            if (pi < 192) { int i; if (pi < 128) { c0 = C_NQ + (pi >> 5) * 64; i = pi & 31; } else if (pi < 160) { c0 = C_NKV + 128; i = pi - 128; } else { c0 = C_NKV + 256; i = pi - 160; }
                c0 += i; half = 32; cs = cos64[pos * 32 + i]; sn = sin64[pos * 32 + i]; }
            else { const int q = pi - 192; const int s = (q >> 4) & 7, i = q & 15; c0 = (q < 128 ? C_DQ : C_DK) + 32 * s + i; half = 16; cs = cos32[pos * 16 + i]; sn = sin32[pos * 16 + i]; }
            const float x1 = bf2f(row[c0]), x2 = bf2f(row[c0 + half]);
            row[c0] = f2bf(x1 * cs - x2 * sn); row[c0 + half] = f2bf(x2 * cs + x1 * sn); } }
    for (int u = gw; u < BATCH * 8; u += NGW) { const int b = u >> 3, h = u & 7; const float bf = a->in[11][L * 8 + h];
        float* ck = (float*)(C.ws + WS_CKL) + (size_t)u * SEQ + lane * 32; const bf16_t* fp = proj + (size_t)(b * SEQ + lane * 32) * NPROJ + C_FF + h;
        float run = 0.f; float loc[32];
#pragma unroll
        for (int i = 0; i < 32; ++i) { const float x = bf2f(fp[(size_t)i * NPROJ]) + bf; const float ls = -__builtin_amdgcn_logf(1.0f + __builtin_amdgcn_exp2f(-LOG2E * x)); run += ls; loc[i] = run;     }
        float incl = run;
#pragma unroll
        for (int o = 1; o < 64; o <<= 1) { const float t = __builtin_bit_cast(float, __builtin_amdgcn_ds_bpermute((lane - o) << 2, __builtin_bit_cast(int, incl))); if (lane >= o) incl += t; }
        const float base = incl - run;
#pragma unroll
        for (int i = 0; i < 32; ++i) ck[i] = base + loc[i]; }
}

constexpr int KP = 72;
DI void cmp_attn_phase(const Ctx& C, int L) {
    const bf16_t* proj = (const bf16_t*)(C.ws + WS_BIG);
    LAS bf16_t* Ks = (LAS bf16_t*)C.lds;
    LAS bf16_t* Vs = (LAS bf16_t*)(C.lds + 128 * KP * 2);
    LAS float* Ps = (LAS float*)(C.lds + 2 * 128 * KP * 2 + C.wave * 5120);
    LAS float* Sc = Ps + 8 * 128;
    const int tid = C.tid, lane = C.lane, w = C.wave, r = lane & 31, hh = lane >> 5;
    const float c1 = 0.125f * LOG2E;
    for (int ug = C.bid; ug < BATCH * 8; ug += C.G) {
        const int b = ug >> 3;
        __syncthreads();
        for (int idx = tid; idx < 128 * 8 * 2; idx += 512) { const int kvs = idx >> 10, rem = idx & 1023, c = rem >> 3, ch = rem & 7;
            const u32x4 v = *(const u32x4*)((const bf16_t*)(C.ws + (kvs ? WS_VC : WS_KC)) + (size_t)(b * 128 + c) * 64 + ch * 8);
            *(LAS u32x4*)((kvs ? Vs : Ks) + c * KP + ch * 8) = v; }
        __syncthreads();
        for (int uu = 0; uu < 4; ++uu) {
            const int t0 = ((ug & 7) * 4 + uu) * 64; const int tok = t0 + 8 * w + (r >> 2), g = r & 3; const size_t m = (size_t)b * SEQ + tok;
            bf16x8 qf[4];
#pragma unroll
            for (int s = 0; s < 4; ++s) qf[s] = *(const bf16x8*)(proj + m * NPROJ + C_NQ + g * 64 + 16 * s + 8 * hh);
            f32x16 p[4];
#pragma unroll
            for (int kt = 0; kt < 4; ++kt) { f32x16 acc;
#pragma unroll
                for (int i = 0; i < 16; ++i) acc[i] = 0.f;
#pragma unroll
                for (int s = 0; s < 4; ++s) { const bf16x8 kf = *(const LAS bf16x8*)(Ks + (32 * kt + r) * KP + 16 * s + 8 * hh); acc = MFMA32(kf, qf[s], acc); }
                p[kt] = acc; }
            float mx = -1e30f; const int climh = ((tok - 31) >> 4) - 4 * hh;
#pragma unroll
            for (int kt = 0; kt < 4; ++kt)
#pragma unroll
                for (int i = 0; i < 16; ++i) { const bool ok = (32 * kt + (i & 3) + 8 * (i >> 2)) <= climh; p[kt][i] = ok ? p[kt][i] : -INFINITY; mx = fmaxf(mx, p[kt][i]); }
            mx = fmaxf(mx, shx<32>(mx));
            float sum = 0.f; const float off = mx * c1;
#pragma unroll
            for (int kt = 0; kt < 4; ++kt)
#pragma unroll
                for (int i = 0; i < 16; ++i) { const float e = __builtin_amdgcn_exp2f(p[kt][i] * c1 - off); p[kt][i] = e; sum += e; }
            sum += shx<32>(sum);
            const float inv = (tok >= 31) ? 1.0f / sum : 0.f;
#pragma unroll
            for (int kt = 0; kt < 4; ++kt)
#pragma unroll
                for (int i = 0; i < 16; ++i) p[kt][i] *= inv;
            __builtin_amdgcn_sched_barrier(0);
            f32x16 o[2];
#pragma unroll
            for (int dt = 0; dt < 2; ++dt)
#pragma unroll
                for (int i = 0; i < 16; ++i) o[dt][i] = 0.f;
            const int i16 = lane & 15, q4 = i16 >> 2, pp = i16 & 3, blk = (lane >> 4) & 1;
            const LAS bf16_t* vb = Vs + (4 * hh + q4) * KP + 16 * blk + 4 * pp;
#pragma unroll
            for (int kt = 0; kt < 4; ++kt)
#pragma unroll
                for (int s = 0; s < 2; ++s) { u32x4 pw; pw.x = pk2(p[kt][8 * s], p[kt][8 * s + 1]); pw.y = pk2(p[kt][8 * s + 2], p[kt][8 * s + 3]); pw.z = pk2(p[kt][8 * s + 4], p[kt][8 * s + 5]); pw.w = pk2(p[kt][8 * s + 6], p[kt][8 * s + 7]);
                    const bf16x8 pf = __builtin_bit_cast(bf16x8, pw);
#pragma unroll
                    for (int dt = 0; dt < 2; ++dt) { const s16x4 lo = __builtin_amdgcn_ds_read_tr16_b64_v4i16((LAS s16x4*)(vb + (32 * kt + 16 * s) * KP + 32 * dt));
                        const s16x4 hi = __builtin_amdgcn_ds_read_tr16_b64_v4i16((LAS s16x4*)(vb + (32 * kt + 16 * s + 8) * KP + 32 * dt));
                        const bf16x8 vf = __builtin_shufflevector(lo, hi, 0, 1, 2, 3, 4, 5, 6, 7); o[dt] = MFMA32(vf, pf, o[dt]); } __builtin_amdgcn_sched_barrier(0); }
            __builtin_amdgcn_sched_barrier(0);
            { const float gl = bf2f(proj[m * NPROJ + C_NG + g * 3 + 0]); const float gate = 1.0f / (1.0f + __expf(-gl));
              float* op = (float*)(C.ws + WS_OCMP) + m * 256 + g * 64;
#pragma unroll
              for (int dt = 0; dt < 2; ++dt)
#pragma unroll
                  for (int g4 = 0; g4 < 4; ++g4) { f32x4 v; v[0] = o[dt][4 * g4] * gate; v[1] = o[dt][4 * g4 + 1] * gate; v[2] = o[dt][4 * g4 + 2] * gate; v[3] = o[dt][4 * g4 + 3] * gate;
                      *(f32x4*)(op + 32 * dt + 8 * g4 + 4 * hh) = v; } }
            __builtin_amdgcn_sched_barrier(0);
#pragma unroll
            for (int kt = 0; kt < 4; ++kt)
#pragma unroll
                for (int i = 0; i < 16; ++i) { float v = p[kt][i]; v += shx<1>(v); v += shx<2>(v); p[kt][i] = v; }
            __builtin_amdgcn_sched_barrier(0);
            if (g == 0) {
#pragma unroll
                for (int kt = 0; kt < 4; ++kt)
#pragma unroll
                    for (int g4 = 0; g4 < 4; ++g4) { f32x4 v; v[0] = p[kt][4 * g4]; v[1] = p[kt][4 * g4 + 1]; v[2] = p[kt][4 * g4 + 2]; v[3] = p[kt][4 * g4 + 3];
                        *(LAS f32x4*)(Ps + (r >> 2) * 128 + 32 * kt + 8 * g4 + 4 * hh) = v; } }
            LDS_WAIT();
            { const int tk = lane >> 3, jg = lane & 7; const int t = t0 + 8 * w + tk; const int blk_t = t >> 6;
              float sc[4];
#pragma unroll
              for (int jj = 0; jj < 4; ++jj) { const int j = 4 * jg + jj; float imp = 0.f;
#pragma unroll
                  for (int cc = -1; cc < 4; ++cc) { const int c = 4 * j + cc; if (c >= 0) imp += Ps[tk * 128 + c]; }
                  const bool forced = (j == 0) || (j == blk_t) || (j == blk_t - 1); const bool valid = (j * 64) <= t;
                  sc[jj] = forced ? 1e9f : (valid ? imp : -1.0f); Sc[tk * 32 + j] = sc[jj]; }
              LDS_WAIT();
              unsigned bits = 0u;
#pragma unroll
              for (int jj = 0; jj < 4; ++jj) { const int j = 4 * jg + jj; int cnt = 0;
                  for (int j2 = 0; j2 < 32; ++j2) { const float o2 = Sc[tk * 32 + j2]; cnt += (o2 > sc[jj] || (o2 == sc[jj] && j2 < j)) ? 1 : 0; }
                  if (cnt < 16) bits |= 1u << j; }
              bits |= (unsigned)shxi<1>((int)bits); bits |= (unsigned)shxi<2>((int)bits); bits |= (unsigned)shxi<4>((int)bits);
              if (jg == 0) ((unsigned*)(C.ws + WS_SEL))[(size_t)b * SEQ + t] = bits; }
            LDS_WAIT();
        }
    }
}
constexpr int AT_KBUF = 64 * KP * 2;
constexpr int AT_K0 = 0, AT_V0 = 2 * AT_KBUF, AT_C0 = 4 * AT_KBUF, AT_MISC = AT_C0 + 2 * 256;

template <bool BIAS, int NS>
DI void tile_step(const LAS bf16_t* Kl, const LAS bf16_t* Vl, const LAS float* Cl, const bf16x8 (&qf)[NS], f32x16 (&o)[2], float& m, float& l,
                  const float c1, const int mmode, const int key0, const int trow, const bool kill, const int hh) {
    f32x16 p[2];
#pragma unroll
    for (int kt = 0; kt < 2; ++kt) { f32x16 acc;
#pragma unroll
        for (int i = 0; i < 16; ++i) acc[i] = 0.f;
#pragma unroll
        for (int s = 0; s < NS; ++s) { const bf16x8 kf = *(const LAS bf16x8*)(Kl + 32 * kt * KP + 16 * s); acc = MFMA32(kf, qf[s], acc); }
        p[kt] = acc; }
    if (BIAS) {
#pragma unroll
        for (int kt = 0; kt < 2; ++kt)
#pragma unroll
            for (int g4 = 0; g4 < 4; ++g4) { const f32x4 cv = *(const LAS f32x4*)(Cl + 32 * kt + 8 * g4);
#pragma unroll
                for (int e = 0; e < 4; ++e) p[kt][4 * g4 + e] = p[kt][4 * g4 + e] * c1 - cv[e]; }
    }
    const int lim = trow - key0 - 4 * hh;
    if (mmode == 1) {
#pragma unroll
        for (int kt = 0; kt < 2; ++kt)
#pragma unroll
            for (int i = 0; i < 16; ++i) p[kt][i] = ((32 * kt + (i & 3) + 8 * (i >> 2)) > lim) ? -INFINITY : p[kt][i];
    } else if (mmode == 2) {
#pragma unroll
        for (int kt = 0; kt < 2; ++kt)
#pragma unroll
            for (int i = 0; i < 16; ++i) p[kt][i] = ((32 * kt + (i & 3) + 8 * (i >> 2)) <= lim - 512) ? -INFINITY : p[kt][i];
    }
    if (kill) {
#pragma unroll
        for (int kt = 0; kt < 2; ++kt)
#pragma unroll
            for (int i = 0; i < 16; ++i) p[kt][i] = -INFINITY;
    }
    float mx = p[0][0];
#pragma unroll
    for (int kt = 0; kt < 2; ++kt)
#pragma unroll
        for (int i = 0; i < 16; ++i) mx = fmaxf(mx, p[kt][i]);
    mx = fmaxf(mx, shx<32>(mx));
    const float mn = fmaxf(m, mx);
    float alpha, off, sc;
    if (BIAS) { alpha = __builtin_amdgcn_exp2f(m - mn); off = mn; sc = 1.0f; } else { alpha = __builtin_amdgcn_exp2f((m - mn) * c1); off = mn * c1; sc = c1; }
    m = mn;
    float rs = 0.f;
#pragma unroll
    for (int kt = 0; kt < 2; ++kt)
#pragma unroll
        for (int i = 0; i < 16; ++i) { const float e = __builtin_amdgcn_exp2f(p[kt][i] * sc - off); p[kt][i] = e; rs += e; }
    l = l * alpha + rs;
#pragma unroll
    for (int dt = 0; dt < 2; ++dt)
#pragma unroll
        for (int i = 0; i < 16; ++i) o[dt][i] *= alpha;
#pragma unroll
    for (int kt = 0; kt < 2; ++kt)
#pragma unroll
        for (int s = 0; s < 2; ++s) { u32x4 pw; pw.x = pk2(p[kt][8 * s], p[kt][8 * s + 1]); pw.y = pk2(p[kt][8 * s + 2], p[kt][8 * s + 3]); pw.z = pk2(p[kt][8 * s + 4], p[kt][8 * s + 5]); pw.w = pk2(p[kt][8 * s + 6], p[kt][8 * s + 7]);
            const bf16x8 pf = __builtin_bit_cast(bf16x8, pw);
#pragma unroll
            for (int dt = 0; dt < 2; ++dt) { const s16x4 lo = __builtin_amdgcn_ds_read_tr16_b64_v4i16((LAS s16x4*)(Vl + (32 * kt + 16 * s) * KP + 32 * dt));
                const s16x4 hi = __builtin_amdgcn_ds_read_tr16_b64_v4i16((LAS s16x4*)(Vl + (32 * kt + 16 * s + 8) * KP + 32 * dt));
                const bf16x8 vf = __builtin_shufflevector(lo, hi, 0, 1, 2, 3, 4, 5, 6, 7); o[dt] = MFMA32(vf, pf, o[dt]); } }
}

struct TileRegs { u32x4 k, v; float c; };
template <bool BIAS>
DI void tile_gload(TileRegs& R, const bf16_t* kbase, const bf16_t* vbase, const float* cbase, int key0, int tid) {
    const size_t off = (size_t)(key0 + (tid >> 3)) * NPROJ + (tid & 7) * 8;
    R.k = *(const u32x4*)(kbase + off); R.v = *(const u32x4*)(vbase + off);
    if (BIAS) { if (tid < 64) R.c = cbase[key0 + tid]; }
}
template <bool BIAS>
DI void tile_lstore(const TileRegs& R, LAS unsigned char* lds, int buf, int tid) {
    const int o = ((tid >> 3) * KP + (tid & 7) * 8) * 2;
    *(LAS u32x4*)(lds + AT_K0 + buf * AT_KBUF + o) = R.k; *(LAS u32x4*)(lds + AT_V0 + buf * AT_KBUF + o) = R.v;
    if (BIAS) { if (tid < 64) *(LAS float*)(lds + AT_C0 + buf * 256 + tid * 4) = R.c; }
}

template <bool BIAS, int NS, int NMAP>
DI void flash_pass(const Ctx& C, const bf16_t* kbase, const bf16_t* vbase, const float* cbase, int j0, int j1, int wave_last, int lowtile,
                   const bf16x8 (&qf)[NMAP][NS], f32x16 (&o)[NMAP][2], float (&m)[NMAP], float (&l)[NMAP], float c1, int trow, unsigned selbits, int hh) {
    const int tid = C.tid, lane = C.lane, r = lane & 31;
    const int i16 = lane & 15, q4 = i16 >> 2, pp = i16 & 3, blk = (lane >> 4) & 1;
    TileRegs R;
    tile_gload<BIAS>(R, kbase, vbase, cbase, 64 * j0, tid);
    tile_lstore<BIAS>(R, C.lds, 0, tid);
    __syncthreads();
    int cur = 0;
    for (int j = j0; j <= j1; ++j) {
        if (j < j1) tile_gload<BIAS>(R, kbase, vbase, cbase, 64 * (j + 1), tid);
        if (j <= wave_last) {
            const LAS bf16_t* Kt = (const LAS bf16_t*)(C.lds + AT_K0 + cur * AT_KBUF);
            const LAS bf16_t* Vl = (const LAS bf16_t*)(C.lds + AT_V0 + cur * AT_KBUF) + (4 * hh + q4) * KP + 16 * blk + 4 * pp;
            const LAS float* Cl = (const LAS float*)(C.lds + AT_C0 + cur * 256) + 4 * hh;
            const int mmode = (j == wave_last) ? 1 : ((j == lowtile) ? 2 : 0);
            const bool kill = ((selbits >> j) & 1u) == 0u;
#pragma unroll
            for (int mp = 0; mp < NMAP; ++mp)
                tile_step<BIAS, NS>(Kt + r * KP + 8 * hh + mp * 32, Vl, Cl, qf[mp], o[mp], m[mp], l[mp], c1, mmode, 64 * j, trow, kill, hh);
        }
        if (j < j1) tile_lstore<BIAS>(R, C.lds, cur ^ 1, tid);
        __syncthreads();
        cur ^= 1;
    }
}

DI void store_row64(bf16_t* dst, const f32x16 (&v)[2], int hh) {
#pragma unroll
    for (int dt = 0; dt < 2; ++dt)
#pragma unroll
        for (int g4 = 0; g4 < 4; ++g4) { u32x2 w; w.x = pk2(v[dt][4 * g4], v[dt][4 * g4 + 1]); w.y = pk2(v[dt][4 * g4 + 2], v[dt][4 * g4 + 3]); *(u32x2*)(dst + 32 * dt + 8 * g4 + 4 * hh) = w; }
}

DI void attn_phase(const Ctx& C, ARGP a, int L) {
    const bf16_t* proj = (const bf16_t*)(C.ws + WS_BIG);
    bf16_t* mix = (bf16_t*)(C.ws + WS_MIX);
    unsigned* qctr = (unsigned*)(C.ws + WS_CTL) + CW_QUEUE + 64 * L;
    volatile LAS int* slot = (volatile LAS int*)(C.lds + AT_MISC);
    const int tid = C.tid, lane = C.lane, w = C.wave, r = lane & 31, hh = lane >> 5;
    for (;;) {
        __syncthreads();
        if (tid == 0) slot[0] = (int)atomicAdd(qctr, 1u);
        __syncthreads();
        const int idx = slot[0];
        if (idx >= 4096) break;
        const int qb8 = 7 - (idx >> 9), rem = idx & 511;
        if (rem >= 256) {
            const int r3 = rem - 256, b = r3 >> 3, h = r3 & 7; const int tok = 256 * qb8 + 32 * w + r; const size_t mrow = (size_t)b * SEQ + tok;
            bf16x8 qf[1][4];
#pragma unroll
            for (int s = 0; s < 4; ++s) qf[0][s] = *(const bf16x8*)(proj + mrow * NPROJ + C_FQ + h * 64 + 16 * s + 8 * hh);
            f32x16 o[1][2]; float m[1] = {-1e30f}, l[1] = {0.f};
#pragma unroll
            for (int dt = 0; dt < 2; ++dt)
#pragma unroll
                for (int i = 0; i < 16; ++i) o[0][dt][i] = 0.f;
            const bf16_t* kb = proj + (size_t)b * SEQ * NPROJ + C_FK + h * 64; const bf16_t* vb = proj + (size_t)b * SEQ * NPROJ + C_FV + h * 64;
            const float* cb = (const float*)(C.ws + WS_CKL) + (size_t)(b * 8 + h) * SEQ;
            flash_pass<true, 4, 1>(C, kb, vb, cb, 0, 4 * qb8 + 3, 4 * qb8 + (w >> 1), -1, qf, o, m, l, 0.125f * LOG2E, tok, 0xffffffffu, hh);
            const float lt = l[0] + shx<32>(l[0]); const float inv = 1.0f / lt;
#pragma unroll
            for (int dt = 0; dt < 2; ++dt)
#pragma unroll
                for (int i = 0; i < 16; ++i) o[0][dt][i] *= inv;
            store_row64(mix + mrow * DM + 512 + h * 64, o[0], hh);
        } else if (rem < 128) {
            const int b = rem >> 2, h = rem & 3; const int tok = 256 * qb8 + 32 * w + r; const size_t mrow = (size_t)b * SEQ + tok;
            bf16x8 qf[2][2];
#pragma unroll
            for (int mp = 0; mp < 2; ++mp)
#pragma unroll
                for (int s = 0; s < 2; ++s) qf[mp][s] = *(const bf16x8*)(proj + mrow * NPROJ + C_DQ + h * 64 + mp * 32 + 16 * s + 8 * hh);
            f32x16 o[2][2]; float m[2] = {-1e30f, -1e30f}, l[2] = {0.f, 0.f};
#pragma unroll
            for (int mp = 0; mp < 2; ++mp)
#pragma unroll
                for (int dt = 0; dt < 2; ++dt)
#pragma unroll
                    for (int i = 0; i < 16; ++i) o[mp][dt][i] = 0.f;
            const bf16_t* kb = proj + (size_t)b * SEQ * NPROJ + C_DK + h * 64; const bf16_t* vb = proj + (size_t)b * SEQ * NPROJ + C_DV + h * 64;
            flash_pass<false, 2, 2>(C, kb, vb, nullptr, 0, 4 * qb8 + 3, 4 * qb8 + (w >> 1), -1, qf, o, m, l, 0.17677669529f * LOG2E, tok, 0xffffffffu, hh);
            const float lam = ((const float*)(C.ws + WS_TBL + TB_LAM))[L]; const float li = 0.8f - 0.6f * __builtin_amdgcn_exp2f(-0.3f * LOG2E * (float)L);
            const float i0 = 1.0f / (l[0] + shx<32>(l[0])), i1 = lam / (l[1] + shx<32>(l[1]));
            float ss = 0.f;
#pragma unroll
            for (int dt = 0; dt < 2; ++dt)
#pragma unroll
                for (int i = 0; i < 16; ++i) { const float v = o[0][dt][i] * i0 - o[1][dt][i] * i1; o[0][dt][i] = v; ss += v * v; }
            ss += shx<32>(ss);
            const float rms = (__builtin_amdgcn_rsqf(ss * (1.0f / 64.0f) + LN_EPS)) * (1.0f - li);
            const float* sg = a->in[19] + L * 64;
#pragma unroll
            for (int dt = 0; dt < 2; ++dt)
#pragma unroll
                for (int g4 = 0; g4 < 4; ++g4) { const f32x4 gv = *(const f32x4*)(sg + 32 * dt + 8 * g4 + 4 * hh);
#pragma unroll
                    for (int e = 0; e < 4; ++e) o[0][dt][4 * g4 + e] *= rms * gv[e]; }
            store_row64(mix + mrow * DM + 256 + h * 64, o[0], hh);
        } else {
            const int r2 = rem - 128, b = r2 & 31, qb = 4 * qb8 + 3 - (r2 >> 5); const int tok = 64 * qb + 8 * w + (r >> 2), g = r & 3; const size_t mrow = (size_t)b * SEQ + tok;
            bf16x8 qf[1][4];
#pragma unroll
            for (int s = 0; s < 4; ++s) qf[0][s] = *(const bf16x8*)(proj + mrow * NPROJ + C_NQ + g * 64 + 16 * s + 8 * hh);
            const unsigned sel = ((const unsigned*)(C.ws + WS_SEL))[mrow];
            const bf16_t* pb = proj + (size_t)b * SEQ * NPROJ + C_NKV;
            f32x16 o[1][2], keep[2]; float m[1] = {-1e30f}, l[1] = {0.f};
#pragma unroll
            for (int dt = 0; dt < 2; ++dt)
#pragma unroll
                for (int i = 0; i < 16; ++i) o[0][dt][i] = 0.f;
            flash_pass<false, 4, 1>(C, pb + 128, pb + 192, nullptr, 0, qb, qb, -1, qf, o, m, l, 0.125f * LOG2E, tok, sel, hh);
            { const float g1 = 1.0f / (1.0f + __expf(-bf2f(proj[mrow * NPROJ + C_NG + g * 3 + 1]))); const float inv = g1 / (l[0] + shx<32>(l[0]));
              const float* oc = (const float*)(C.ws + WS_OCMP) + mrow * 256 + g * 64;
#pragma unroll
              for (int dt = 0; dt < 2; ++dt)
#pragma unroll
                  for (int g4 = 0; g4 < 4; ++g4) { const f32x4 cv = *(const f32x4*)(oc + 32 * dt + 8 * g4 + 4 * hh);
#pragma unroll
                      for (int e = 0; e < 4; ++e) { keep[dt][4 * g4 + e] = o[0][dt][4 * g4 + e] * inv + cv[e]; o[0][dt][4 * g4 + e] = 0.f; } } }
            m[0] = -1e30f; l[0] = 0.f;
            const int jlo = qb >= 8 ? qb - 8 : 0;
            flash_pass<false, 4, 1>(C, pb + 256, pb + 320, nullptr, jlo, qb, qb, qb >= 8 ? qb - 8 : -1, qf, o, m, l, 0.125f * LOG2E, tok, 0xffffffffu, hh);
            { const float g2 = 1.0f / (1.0f + __expf(-bf2f(proj[mrow * NPROJ + C_NG + g * 3 + 2]))); const float inv = g2 / (l[0] + shx<32>(l[0]));
#pragma unroll
              for (int dt = 0; dt < 2; ++dt)
#pragma unroll
                  for (int i = 0; i < 16; ++i) keep[dt][i] += o[0][dt][i] * inv; }
            store_row64(mix + mrow * DM + g * 64, keep, hh);
        }
    }
}
constexpr int LDS_BYTES = 147456;
constexpr int N_PHASES = 1 + 11 * DEPTH;

template <class Epi>
DI void run_gemm(const Ctx& C, const bf16_t* A, const bf16_t* Bt, int N, int K, const Epi& E) {
    asm volatile("" : "+s"(K), "+s"(N));
    pg8::Gemm g{A, Bt, MTOK, N, K}; pg8::StaticOrder S; S.init(MTOK, N, C.G, C.bid);
    pg8::gemm_phase<Epi, pg8::StaticOrder, true, true>((LAS unsigned char*)C.lds, g, S, E, C.tid);
}

__global__ void __launch_bounds__(512, 2) mega_fwd(Args args_k) {
    extern __shared__ __attribute__((aligned(16))) unsigned char lds_raw[];
    const ARGP ap0 = (ARGP)__builtin_amdgcn_kernarg_segment_ptr();
    Ctx C; const int wave_s = __builtin_amdgcn_readfirstlane((int)threadIdx.x >> 6); C.wave = wave_s; C.lane = 0; C.tid = 0; C.bid = blockIdx.x; C.G = gridDim.x;
    C.ws = args_k.ws; C.lds = (LAS unsigned char*)lds_raw;
    cg::grid_group grid = cg::this_grid();
#define BST ((volatile LAS unsigned*)(C.lds + 131072 + 256))
    if (threadIdx.x < 2) BST[threadIdx.x] = 0u;
    __syncthreads();
    (void)xcd_barrier_post((unsigned*)(C.ws + WS_CTL) + 4096, BST);
    const int lo = args_k.ph_lo, hi = args_k.ph_hi;
#define PH_BEGIN(k) if (lo <= (k) && (k) < hi) { ARGP args = ap0; asm volatile("" : "+s"(args)); unsigned char* ws = args->ws; C.ws = ws; float* X = args->out; (void)X; \
        { int l_; asm volatile("v_mbcnt_lo_u32_b32 %0, -1, 0\n\tv_mbcnt_hi_u32_b32 %0, -1, %0" : "=&v"(l_)); C.lane = l_; C.tid = wave_s * 64 + l_; int b_ = blockIdx.x, g_ = gridDim.x; asm volatile("" : "+s"(b_), "+s"(g_)); C.bid = b_; C.G = g_; }
#define PH_END(k) asm volatile("s_waitcnt vmcnt(0)" ::: "memory"); if ((k) + 1 < hi) { if ((k) == 0) grid.sync(); else { XcdBarrier xb_; xb_.bar = (unsigned*)(C.ws + WS_CTL) + 4096; xb_.x = xb_xcc_id(); xb_.st = BST; xcd_barrier(xb_, C.tid == 0); } } }
#define XB ((bf16_t*)(ws + WS_XB))
#define BIG ((bf16_t*)(ws + WS_BIG))
#define MIX ((bf16_t*)(ws + WS_MIX))
#define PPB ((bf16_t*)(ws + WS_PP))
#define WBT(off) ((const bf16_t*)(ws + WS_W + (size_t)L * W_LAYER + (off)))
#define FOLD(off) ((const float*)(ws + WS_CTL + CTL_FOLD + (size_t)L * CTL_FOLD_LAYER) + (off))
#define STP(k) ((float*)(ws + WS_ST) + (size_t)(L * 3 + (k)) * MTOK * 32)
#define LNG(k) (args->in[2] + (size_t)(L * 3 + (k)) * DM)
#define LNB(k) (args->in[3] + (size_t)(L * 3 + (k)) * DM)
    PH_BEGIN(0) prep_phase(C, args); PH_END(0)
    for (int L = 0; L < DEPTH; ++L) {
        const int pb = 1 + 11 * L;
        PH_BEGIN(pb + 0) { pg8::EpiSwiGLU E{BIG, DFFP}; run_gemm(C, L == 0 ? XB : MIX, WBT(W_UP1), NUP, DM, E); } PH_END(pb + 0)
        PH_BEGIN(pb + 1) { pg8::EpiResidLN E{L == 0 ? args->in[0] : X, ws, args, 0, L * 3 + 0, 0, DN_ALPHA, 0.5f, 0}; run_gemm(C, BIG, WBT(W_DN1), DM, DFFP, E); } PH_END(pb + 1)
        PH_BEGIN(pb + 2) { pg8::EpiBf16LN E{ws, NPROJ, L * 3 + 0, FO_CS_IN, FO_CB_IN, L}; run_gemm(C, XB, WBT(W_IN), NPROJ, DM, E); } PH_END(pb + 2)
        PH_BEGIN(pb + 3) attn_prep_phase(C, args, L); PH_END(pb + 3)
        PH_BEGIN(pb + 4) cmp_attn_phase(C, L); PH_END(pb + 4)
        PH_BEGIN(pb + 5) attn_phase(C, args, L); PH_END(pb + 5)
        PH_BEGIN(pb + 6) { pg8::EpiResidLN E{X, ws, args, L * 3 + 0, L * 3 + 1, L * 3 + 0, DN_ALPHA, 1.0f, 1}; run_gemm(C, MIX, WBT(W_OUT), DM, DM, E); } PH_END(pb + 6)
        PH_BEGIN(pb + 7) { pg8::EpiBf16 E{PPB, DM}; run_gemm(C, (const bf16_t*)(ws + WS_PB) + (size_t)L * MTOK * PLED, WBT(W_PLEP), DM, PLED, E); } PH_END(pb + 7)
        PH_BEGIN(pb + 8) { pg8::EpiSwiGLULN E{ws, DFFP, L * 3 + 1, FO_CS_UP, FO_CB_UP, L}; run_gemm(C, XB, WBT(W_UP2), NUP, DM, E); } PH_END(pb + 8)
        PH_BEGIN(pb + 9) { pg8::EpiResidLN E{X, ws, args, L * 3 + 1, L * 3 + 2, L * 3 + 1, DN_ALPHA, 0.5f, 1}; run_gemm(C, BIG, WBT(W_DN2), DM, DFFP, E); } PH_END(pb + 9)
        PH_BEGIN(pb + 10) { pg8::EpiPleLN E{ws, args, L * 3 + 2, L * 3 + 2, L}; run_gemm(C, XB, WBT(W_PLEG), DM, DM, E); } PH_END(pb + 10)
    }
}

#ifndef MK_SPLIT
#define MK_SPLIT 0
#endif
extern "C" void kernel_launch(void* const* d_in, const int* in_sizes, int n_in, void* d_out, int out_size, void* d_ws, size_t ws_size, hipStream_t stream) {
    static int grid = 0;
    if (grid == 0) {
        if (n_in != 24 || out_size != MTOK * DM || ws_size < WS_END) { fprintf(stderr, "kernel_launch: unexpected shapes (n_in %d out %d ws %zu)\n", n_in, out_size, ws_size); grid = -1; return; }
        if (hipFuncSetAttribute((const void*)mega_fwd, hipFuncAttributeMaxDynamicSharedMemorySize, LDS_BYTES) != hipSuccess) { fprintf(stderr, "kernel_launch: hipFuncSetAttribute failed\n"); grid = -1; return; }
        int dev = 0, cus = 0, per_cu = 0; hipGetDevice(&dev); hipDeviceGetAttribute(&cus, hipDeviceAttributeMultiprocessorCount, dev);
        hipOccupancyMaxActiveBlocksPerMultiprocessor(&per_cu, (const void*)mega_fwd, 512, LDS_BYTES);
        if (per_cu < 1) { fprintf(stderr, "kernel_launch: occupancy query says %d blocks/CU\n", per_cu); per_cu = 1; }
        (void)hipGetLastError();
        grid = cus;
    }
    if (grid < 0) return;
    hipMemsetAsync((char*)d_ws + WS_CTL, 0, 1 * MiB, stream);
    Args a{};
    for (int i = 0; i < 24; ++i) a.in[i] = (const float*)d_in[i];
    a.out = (float*)d_out; a.ws = (unsigned char*)d_ws;
#if MK_SPLIT
    for (int p = 0; p < N_PHASES; ++p) { a.ph_lo = p; a.ph_hi = p + 1; hipLaunchKernelGGL(mega_fwd, dim3(grid), dim3(512), LDS_BYTES, stream, a); }
#else
    a.ph_lo = 0; a.ph_hi = N_PHASES;
    void* kargs[] = {&a};
    hipError_t e = hipLaunchCooperativeKernel((const void*)mega_fwd, dim3(grid), dim3(512), kargs, LDS_BYTES, stream);
    if (e != hipSuccess) fprintf(stderr, "cooperative launch failed: %s (grid %d)\n", hipGetErrorString(e), grid);
#endif
}
```

```cpp
#include <hip/hip_runtime.h>
#include <hip/hip_cooperative_groups.h>
#include <cstdio>
#include <cstdint>
#include <cmath>
namespace cg = cooperative_groups;

namespace pg8 {
#define PG8_LAS __attribute__((address_space(3)))
typedef unsigned short bf16_t;
typedef short bf16x8 __attribute__((ext_vector_type(8)));
typedef float f32x4 __attribute__((ext_vector_type(4)));
typedef unsigned u32x4 __attribute__((ext_vector_type(4)));
constexpr int BM = 256, BK = 64, HALF = 128, HTB = HALF * BK * 2  , STAGE_BYTES = 8 * HTB, NXCD = 8, WGM = 8;

__host__ __device__ __forceinline__ int lds_byte(int r, int c) { const int st = (r >> 4) * 2 + (c >> 5), rr = r & 15, cc = c & 31, ob = rr * 64 + cc * 2; return st * 1024 + (ob ^ (((ob >> 9) & 1) << 5)); }
__host__ __device__ __forceinline__ void stage_rc(int b, int& R, int& C) { const int st = b / 1024, sb = b % 1024, swz = sb ^ (((sb >> 9) & 1) << 5); R = (st >> 1) * 16 + swz / 64; C = (st & 1) * 32 + (swz % 64) / 2; }
__host__ __device__ __forceinline__ int perm32(int rho) { const int n = rho >> 4, i = rho & 15; return 8 * (i >> 2) + 4 * n + (i & 3); }

struct Unit { int pm, pn; };
struct Gemm { const bf16_t* A; const bf16_t* Bt; int M, N, K; };

struct StaticOrder {
    int nM, nN, nwg, G, c;
    __host__ __device__ void init(int M, int N, int G_, int c_) { nM = M / BM; nN = N / BM; nwg = nM * nN; G = G_; c = c_; }
    __host__ __device__ bool next(int i, Unit& u) const {
        const long L = (long)i * G + c; if (L >= nwg) return false;
        int wgid = (int)L; { const int q = nwg / NXCD, r = nwg % NXCD, xcd = wgid % NXCD, off = wgid / NXCD; wgid = (xcd < r ? xcd * (q + 1) : r * (q + 1) + (xcd - r) * q) + off; }
        const int nig = WGM * nN, gid = wgid / nig, fm = gid * WGM, gsz = (nM - fm) < WGM ? (nM - fm) : WGM;
        u.pm = fm + ((wgid % nig) % gsz); u.pn = (wgid % nig) / gsz; return true;
    }
    __device__ __forceinline__ void a_ready(const Unit&) const {}
    __device__ __forceinline__ void done(const Unit&) const {}
};

__device__ __forceinline__ unsigned cvt_pk_bf16(float lo, float hi) { unsigned r; asm volatile("v_cvt_pk_bf16_f32 %0, %1, %2" : "=v"(r) : "v"(lo), "v"(hi)); return r; }
typedef unsigned u32x2 __attribute__((ext_vector_type(2)));
struct EpiBf16 {
    static constexpr bool PERM = true, AFTER_DRAIN = false;
    bf16_t* O; int ldc;
    __device__ __forceinline__ void operator()(const f32x4 (&acc)[2][2][4][2], const Unit& u, int wr, int wc, int fr, int fq) const {
        const int row0 = u.pm * BM + wr * 64 + fr; const int col0 = u.pn * BM + wc * 32 + 8 * fq;
#pragma unroll
        for (int ai = 0; ai < 2; ++ai)
#pragma unroll
            for (int m = 0; m < 4; ++m) { bf16_t* rowp = O + (size_t)(row0 + ai * HALF + m * 16) * ldc + col0;
#pragma unroll
                for (int bj = 0; bj < 2; ++bj) { const f32x4 v0 = acc[ai][bj][m][0], v1 = acc[ai][bj][m][1];
                    u32x4 w; w.x = cvt_pk_bf16(v0[0], v0[1]); w.y = cvt_pk_bf16(v0[2], v0[3]); w.z = cvt_pk_bf16(v1[0], v1[1]); w.w = cvt_pk_bf16(v1[2], v1[3]);
                    *(u32x4*)(rowp + bj * HALF) = w; } __builtin_amdgcn_sched_barrier(0); }
    }
};
__device__ __forceinline__ float silu_mul(float g, float uu) { return g * uu * __builtin_amdgcn_rcpf(1.0f + __builtin_amdgcn_exp2f(-1.44269504f * g)); }
struct EpiSwiGLU {
    static constexpr bool PERM = true, AFTER_DRAIN = false;
    bf16_t* H; int ldh;
    __device__ __forceinline__ void operator()(const f32x4 (&acc)[2][2][4][2], const Unit& u, int wr, int wc, int fr, int fq) const {
        const int row0 = u.pm * BM + wr * 64 + fr; const int col0 = u.pn * HALF + wc * 32 + 8 * fq;
#pragma unroll
        for (int ai = 0; ai < 2; ++ai)
#pragma unroll
            for (int m = 0; m < 4; ++m) { bf16_t* rowp = H + (size_t)(row0 + ai * HALF + m * 16) * ldh + col0;
                const f32x4 g0 = acc[ai][0][m][0], g1 = acc[ai][0][m][1], u0 = acc[ai][1][m][0], u1 = acc[ai][1][m][1];
                u32x4 w; w.x = cvt_pk_bf16(silu_mul(g0[0], u0[0]), silu_mul(g0[1], u0[1])); w.y = cvt_pk_bf16(silu_mul(g0[2], u0[2]), silu_mul(g0[3], u0[3]));
                w.z = cvt_pk_bf16(silu_mul(g1[0], u1[0]), silu_mul(g1[1], u1[1])); w.w = cvt_pk_bf16(silu_mul(g1[2], u1[2]), silu_mul(g1[3], u1[3]));
                *(u32x4*)rowp = w; __builtin_amdgcn_sched_barrier(0); }
    }
};
struct EpiResid {
    static constexpr bool PERM = false, AFTER_DRAIN = false;
    const float* X; float* Y; float alpha, s;
    __device__ __forceinline__ void operator()(const f32x4 (&acc)[2][2][4][2], const Unit& u, int wr, int wc, int fr, int fq) const {
        const int col0 = u.pn * BM + wc * 32 + 4 * fq;
#pragma unroll
        for (int ai = 0; ai < 2; ++ai)
#pragma unroll
            for (int m = 0; m < 4; ++m) { const size_t off = (size_t)(u.pm * BM + ai * HALF + wr * 64 + m * 16 + fr) * 1024 + col0;
#pragma unroll
                for (int bj = 0; bj < 2; ++bj)
#pragma unroll
                    for (int n = 0; n < 2; ++n) { const f32x4 xv = *(const f32x4*)(X + off + bj * HALF + n * 16);
                        *(f32x4*)(Y + off + bj * HALF + n * 16) = xv * alpha + acc[ai][bj][m][n] * s; } }
    }
};
struct EpiPle {
    static constexpr bool PERM = false, AFTER_DRAIN = false;
    const float* X; float* OUT; bf16_t* XB; const float* bias; const bf16_t* PP;
    __device__ __forceinline__ void operator()(const f32x4 (&acc)[2][2][4][2], const Unit& u, int wr, int wc, int fr, int fq) const {
        const int col0 = u.pn * BM + wc * 32 + 4 * fq;
#pragma unroll
        for (int ai = 0; ai < 2; ++ai)
#pragma unroll
            for (int m = 0; m < 4; ++m) { const size_t off = (size_t)(u.pm * BM + ai * HALF + wr * 64 + m * 16 + fr) * 1024 + col0;
#pragma unroll
                for (int bj = 0; bj < 2; ++bj)
#pragma unroll
                    for (int n = 0; n < 2; ++n) { const int co = bj * HALF + n * 16;
                        const f32x4 xv = *(const f32x4*)(X + off + co); const f32x4 bv = *(const f32x4*)(bias + col0 + co);
                        const u32x2 pw = *(const u32x2*)(PP + off + co);
                        f32x4 pv; pv[0] = __uint_as_float(pw.x << 16); pv[1] = __uint_as_float(pw.x & 0xffff0000u); pv[2] = __uint_as_float(pw.y << 16); pv[3] = __uint_as_float(pw.y & 0xffff0000u);
                        f32x4 o;
#pragma unroll
                        for (int e = 0; e < 4; ++e) { const float z = acc[ai][bj][m][n][e] + bv[e]; const float sg = __builtin_amdgcn_rcpf(1.0f + __builtin_amdgcn_exp2f(-1.44269504f * z)); o[e] = xv[e] + sg * pv[e]; }
                        *(f32x4*)(OUT + off + co) = o;
                        u32x2 w; w.x = cvt_pk_bf16(o[0], o[1]); w.y = cvt_pk_bf16(o[2], o[3]); *(u32x2*)(XB + off + co) = w; } }
    }
};
template <class Epi, class Sched, bool ALIGN_EPI = false, bool SP2 = false>
__device__ __forceinline__ void gemm_phase(PG8_LAS unsigned char* lds, const Gemm g, const Sched& S, const Epi& E, const int tid_in) {
    int tid_ = tid_in; asm volatile("" : "+v"(tid_));
    const int tid = tid_, wid = __builtin_amdgcn_readfirstlane(tid >> 6), lane = tid & 63, wr = wid >> 2, wc = wid & 3, fr = lane & 15, fq = lane >> 4;
    const int K = g.K, nt = K / BK;
    unsigned voffA[2], voffB[2];
#pragma unroll
    for (int i = 0; i < 2; ++i) { int R, C; stage_rc(tid * 16 + i * 8192, R, C); const int Rb = Epi::PERM ? ((R & ~31) + perm32(R & 31)) : R;
        voffA[i] = (unsigned)(R * K + C) * 2u; voffB[i] = (unsigned)(Rb * K + C) * 2u; }
    const size_t kstep = (size_t)(BK * 2);
    const size_t hstep = (size_t)HALF * K * 2;
    const size_t tstep = 2 * hstep;
    const unsigned ldsw = (unsigned)wid * 1024u;
    const int aoff = lds_byte(wr * 64 + fr, fq * 8), boff = lds_byte(wc * 32 + fr, fq * 8);
#define PG8_SA(b, h) (((b) * 2 + (h)) * HTB)
#define PG8_SB(b, h) ((4 + (b) * 2 + (h)) * HTB)
#define PG8_STAGE(bufoff, gbase, voff) do { _Pragma("unroll") for (int _i = 0; _i < 2; ++_i) \
        __builtin_amdgcn_global_load_lds((const unsigned*)((const char*)(gbase) + (voff)[_i]), (PG8_LAS unsigned*)(lds + (bufoff) + ldsw + _i * 8192), 16, 0, 0); } while (0)
#define PG8_LDA(dst, b, h) do { _Pragma("unroll") for (int m = 0; m < 4; ++m) _Pragma("unroll") for (int k = 0; k < 2; ++k) dst[m][k] = *(const PG8_LAS bf16x8*)(lds + PG8_SA(b, h) + aoff + m * 2048 + k * 1024); } while (0)
#define PG8_LDB(dst, b, h) do { _Pragma("unroll") for (int n = 0; n < 2; ++n) _Pragma("unroll") for (int k = 0; k < 2; ++k) dst[n][k] = *(const PG8_LAS bf16x8*)(lds + PG8_SB(b, h) + boff + n * 2048 + k * 1024); } while (0)
#define PG8_MMA(ai, bj, At, Bt) do { __builtin_amdgcn_s_setprio(1); _Pragma("unroll") for (int m = 0; m < 4; ++m) _Pragma("unroll") for (int n = 0; n < 2; ++n) _Pragma("unroll") for (int k = 0; k < 2; ++k) \
        acc[ai][bj][m][n] = __builtin_amdgcn_mfma_f32_16x16x32_bf16(Bt[n][k], At[m][k], acc[ai][bj][m][n], 0, 0, 0); __builtin_amdgcn_s_setprio(0); } while (0)
#define PG8_WAIT_V(n) asm volatile("s_waitcnt vmcnt(" #n ")" ::: "memory")
#define PG8_WAIT_L(n) asm volatile("s_waitcnt lgkmcnt(" #n ")" ::: "memory")
#define PG8_BAR __builtin_amdgcn_s_barrier()
#define PG8_SCHED __builtin_amdgcn_sched_barrier(0)
    Unit cur, nxt; int ui = 0;
    if (!S.next(0, cur)) return;
    f32x4 acc[2][2][4][2];
#pragma unroll
    for (int a = 0; a < 2; ++a)
#pragma unroll
        for (int b = 0; b < 2; ++b)
#pragma unroll
            for (int m = 0; m < 4; ++m)
#pragma unroll
                for (int n = 0; n < 2; ++n) acc[a][b][m][n] = (f32x4){0.f, 0.f, 0.f, 0.f};
    bf16x8 At[4][2], B0[2][2], B1[2][2];
    const char* cA = (const char*)g.A + (size_t)cur.pm * tstep; const char* cB = (const char*)g.Bt + (size_t)cur.pn * tstep;
    S.a_ready(cur);
    if constexpr (SP2) {
        PG8_STAGE(PG8_SB(0, 0), cB, voffB); PG8_STAGE(PG8_SB(0, 1), cB + hstep, voffB); PG8_STAGE(PG8_SA(0, 0), cA, voffA); PG8_STAGE(PG8_SA(0, 1), cA + hstep, voffA);
        if (wr == 1) PG8_BAR;
        PG8_WAIT_V(2); PG8_BAR;
        PG8_STAGE(PG8_SB(1, 0), cB + kstep, voffB); PG8_STAGE(PG8_SA(1, 0), cA + kstep, voffA); PG8_STAGE(PG8_SB(1, 1), cB + hstep + kstep, voffB);
        PG8_WAIT_V(6); PG8_BAR;
    } else {
        PG8_STAGE(PG8_SB(0, 0), cB, voffB); PG8_STAGE(PG8_SA(0, 0), cA, voffA); PG8_STAGE(PG8_SB(0, 1), cB + hstep, voffB); PG8_STAGE(PG8_SA(0, 1), cA + hstep, voffA);
        if (wr == 1) PG8_BAR;
        PG8_WAIT_V(4); PG8_BAR;
        PG8_STAGE(PG8_SB(1, 0), cB + kstep, voffB); PG8_STAGE(PG8_SA(1, 0), cA + kstep, voffA); PG8_STAGE(PG8_SB(1, 1), cB + hstep + kstep, voffB);
        PG8_WAIT_V(6); PG8_BAR;
    }
    for (;;) {
        const bool has_next = S.next(ui + 1, nxt);
        const char* nA = has_next ? (const char*)g.A + (size_t)nxt.pm * tstep : cA; const char* nB = has_next ? (const char*)g.Bt + (size_t)nxt.pn * tstep : cB;
        for (int t = 0; t < nt; t += 2) {
            const bool last = (t == nt - 2);
            const char* a1 = cA + (size_t)(t + 1) * kstep;
            const char* a2 = last ? nA : cA + (size_t)(t + 2) * kstep; const char* b2 = last ? nB : cB + (size_t)(t + 2) * kstep;
            const char* a3 = a2 + kstep; const char* b3 = b2 + kstep;
            if (last && has_next) S.a_ready(nxt);
            if constexpr (SP2) {
            PG8_LDB(B0, 0, 0); PG8_LDB(B1, 0, 1); PG8_SCHED; PG8_LDA(At, 0, 0); PG8_STAGE(PG8_SA(1, 1), a1 + hstep, voffA);
            PG8_WAIT_V(8); PG8_WAIT_L(0); PG8_BAR; PG8_MMA(0, 0, At, B0); PG8_MMA(0, 1, At, B1); PG8_BAR; PG8_SCHED;
            PG8_LDA(At, 0, 1); PG8_STAGE(PG8_SB(0, 0), b2, voffB); PG8_STAGE(PG8_SB(0, 1), b2 + hstep, voffB); PG8_STAGE(PG8_SA(0, 0), a2, voffA);
            PG8_WAIT_V(8); PG8_WAIT_L(0); PG8_BAR; PG8_MMA(1, 0, At, B0); PG8_MMA(1, 1, At, B1); PG8_BAR; PG8_SCHED;
            PG8_LDB(B0, 1, 0); PG8_LDB(B1, 1, 1); PG8_SCHED; PG8_LDA(At, 1, 0); PG8_STAGE(PG8_SA(0, 1), a2 + hstep, voffA);
            PG8_WAIT_V(8); PG8_WAIT_L(0); PG8_BAR; PG8_MMA(0, 0, At, B0); PG8_MMA(0, 1, At, B1); PG8_BAR; PG8_SCHED;
            PG8_LDA(At, 1, 1); PG8_STAGE(PG8_SB(1, 0), b3, voffB); PG8_STAGE(PG8_SB(1, 1), b3 + hstep, voffB); PG8_STAGE(PG8_SA(1, 0), a3, voffA);
            PG8_WAIT_V(8); PG8_WAIT_L(0); PG8_BAR; PG8_MMA(1, 0, At, B0); PG8_MMA(1, 1, At, B1); PG8_BAR; PG8_SCHED;
            } else {
            PG8_LDB(B0, 0, 0); PG8_SCHED; PG8_LDA(At, 0, 0); PG8_STAGE(PG8_SA(1, 1), a1 + hstep, voffA);
            PG8_WAIT_L(8); PG8_BAR; PG8_WAIT_L(0); PG8_MMA(0, 0, At, B0); PG8_BAR; PG8_SCHED;
            PG8_LDB(B1, 0, 1); PG8_STAGE(PG8_SB(0, 0), b2, voffB);
            PG8_BAR; PG8_WAIT_L(0); PG8_MMA(0, 1, At, B1); PG8_BAR;
            PG8_LDA(At, 0, 1); PG8_STAGE(PG8_SA(0, 0), a2, voffA);
            PG8_BAR; PG8_WAIT_L(0); PG8_MMA(1, 0, At, B0); PG8_BAR; PG8_SCHED;
            PG8_STAGE(PG8_SB(0, 1), b2 + hstep, voffB);
            PG8_WAIT_V(6); PG8_BAR; PG8_MMA(1, 1, At, B1); PG8_BAR;
            PG8_LDB(B0, 1, 0); PG8_SCHED; PG8_LDA(At, 1, 0); PG8_STAGE(PG8_SA(0, 1), a2 + hstep, voffA);
            PG8_WAIT_L(8); PG8_BAR; PG8_WAIT_L(0); PG8_MMA(0, 0, At, B0); PG8_BAR; PG8_SCHED;
            PG8_LDB(B1, 1, 1); PG8_STAGE(PG8_SB(1, 0), b3, voffB);
            PG8_BAR; PG8_WAIT_L(0); PG8_MMA(0, 1, At, B1); PG8_BAR;
            PG8_LDA(At, 1, 1); PG8_STAGE(PG8_SA(1, 0), a3, voffA);
            PG8_BAR; PG8_WAIT_L(0); PG8_MMA(1, 0, At, B0); PG8_BAR; PG8_SCHED;
            PG8_STAGE(PG8_SB(1, 1), b3 + hstep, voffB);
            PG8_WAIT_V(6); PG8_BAR; PG8_MMA(1, 1, At, B1); PG8_BAR;
            }
        }
        if constexpr (ALIGN_EPI) { if (wr == 0) PG8_BAR; }
        if constexpr (!Epi::AFTER_DRAIN) { E(acc, cur, wr, wc, fr, fq); S.done(cur); }
        if (!has_next) break;
#pragma unroll
        for (int a = 0; a < 2; ++a)
#pragma unroll
            for (int b = 0; b < 2; ++b)
#pragma unroll
                for (int m = 0; m < 4; ++m)
#pragma unroll
                    for (int n = 0; n < 2; ++n) acc[a][b][m][n] = (f32x4){0.f, 0.f, 0.f, 0.f};
        cur = nxt; cA = nA; cB = nB; ++ui;
        if constexpr (ALIGN_EPI) { if (wr == 1) PG8_BAR; }
    }
    PG8_WAIT_V(0);
    if constexpr (!ALIGN_EPI) { if (wr == 0) PG8_BAR; }
    PG8_BAR;
    if constexpr (Epi::AFTER_DRAIN) { E.fused(acc, cur, wr, wc, fr, fq, lds, wid, lane); S.done(cur); }
#undef PG8_SA
#undef PG8_SB
#undef PG8_STAGE
#undef PG8_LDA
#undef PG8_LDB
#undef PG8_MMA
#undef PG8_WAIT_V
#undef PG8_WAIT_L
#undef PG8_BAR
#undef PG8_SCHED
}
}
#define DI __device__ __forceinline__
#define LAS __attribute__((address_space(3)))
typedef unsigned short bf16_t;
typedef short bf16x8 __attribute__((ext_vector_type(8)));
typedef short s16x4 __attribute__((ext_vector_type(4)));
typedef float f32x2 __attribute__((ext_vector_type(2)));
typedef float f32x4 __attribute__((ext_vector_type(4)));
typedef float f32x16 __attribute__((ext_vector_type(16)));
typedef unsigned u32x2 __attribute__((ext_vector_type(2)));
typedef unsigned u32x4 __attribute__((ext_vector_type(4)));
typedef __bf16 bf16x2_t __attribute__((ext_vector_type(2)));

constexpr int DM = 1024, BATCH = 32, SEQ = 2048, DEPTH = 2, MTOK = BATCH * SEQ, DFF = 2752, DFFP = 2816, NUP = 2 * DFFP, NPROJ = 3072, PLED = 256;
constexpr int IN_COLS = 2964;
constexpr int C_NQ = 0, C_NKV = 256, C_DQ = 640, C_DK = 896, C_DV = 1152, C_FQ = 1408, C_FK = 1920, C_FV = 2432, C_NG = 2944, C_FF = 2956;
constexpr float LN_EPS = 1e-5f;
constexpr float DN_ALPHA = 1.41421356237f;
constexpr float LOG2E = 1.44269504089f;

constexpr size_t MiB = 1u << 20;
constexpr size_t WS_CTL = 0;
constexpr size_t WS_TBL = 1 * MiB;
constexpr size_t TB_COS64 = 0, TB_SIN64 = 256 * 1024, TB_COS32 = 512 * 1024, TB_SIN32 = 640 * 1024, TB_CBIAS = 768 * 1024, TB_LAM = 772 * 1024;
constexpr size_t WS_KC = 2 * MiB, WS_VC = 2 * MiB + 512 * 1024;
constexpr size_t WS_SEL = 3 * MiB;
constexpr size_t WS_CKL = 4 * MiB;
constexpr size_t WS_W = 8 * MiB, W_LAYER = 46 * MiB;
constexpr size_t W_UP1 = 0, W_DN1 = 11 * MiB, W_UP2 = W_DN1 + 5632 * 1024, W_DN2 = W_UP2 + 11 * MiB, W_IN = W_DN2 + 5632 * 1024, W_OUT = W_IN + 6 * MiB,
                 W_PLEG = W_OUT + 2 * MiB, W_PLEP = W_PLEG + 2 * MiB, W_K1 = W_PLEP + 512 * 1024, W_V1 = W_K1 + 1 * MiB, W_K2 = W_V1 + 1 * MiB, W_V2 = W_K2 + 32 * 1024;
static_assert(W_V2 + 32 * 1024 <= W_LAYER, "weights fit");
constexpr size_t WS_XB = 100 * MiB;
constexpr size_t WS_PB = 228 * MiB;
constexpr size_t WS_OCMP = 292 * MiB;
constexpr size_t WS_MIX = 356 * MiB;
constexpr size_t WS_BIG = 484 * MiB;
constexpr size_t WS_END = 868 * MiB;
constexpr int CW_QUEUE = 64;

DI unsigned pk2(float lo, float hi) { f32x2 v = {lo, hi}; return __builtin_bit_cast(unsigned, __builtin_convertvector(v, bf16x2_t)); }
DI float bf2f(bf16_t h) { return __uint_as_float((unsigned)h << 16); }
DI bf16_t f2bf(float f) { return (bf16_t)(pk2(f, 0.f) & 0xffffu); }
DI float wave_sum(float v) {
#pragma unroll
    for (int o = 1; o < 64; o <<= 1) v += __shfl_xor(v, o);
    return v;
}
DI int crow(int i, int hh) { return (i & 3) + 8 * (i >> 2) + 4 * hh; }
#define MFMA32(a, b, c) __builtin_amdgcn_mfma_f32_32x32x16_bf16((a), (b), (c), 0, 0, 0)
#define MFMA16(a, b, c) __builtin_amdgcn_mfma_f32_16x16x32_bf16((a), (b), (c), 0, 0, 0)
#define LDS_WAIT() asm volatile("s_waitcnt lgkmcnt(0)" ::: "memory")

struct Args {
    const float* in[24]; float* out; unsigned char* ws; int ph_lo, ph_hi;
};
typedef const __attribute__((address_space(4))) Args* ARGP;
struct Ctx {
    int tid, lane, wave, bid, G;
    unsigned char* ws; LAS unsigned char* lds;
};

DI void tr_item(const float* W, int ldn, int Ksrc, int srccol, bf16_t* WT, int ldk, int k0, int nrow0, LAS float* scr, int lane) {
#pragma unroll
    for (int i = 0; i < 32; ++i) { const int kk = 2 * i + (lane >> 5), k = k0 + kk; float v = 0.f; if (srccol >= 0 && k < Ksrc) v = W[(size_t)k * ldn + srccol]; scr[kk * 33 + (lane & 31)] = v; }
    LDS_WAIT();
    const int c = lane & 7;
#pragma unroll
    for (int j = 0; j < 4; ++j) { const int n = (lane >> 3) + 8 * j; const LAS float* s = scr + (8 * c) * 33 + n;
        u32x4 o; o.x = pk2(s[0 * 33], s[1 * 33]); o.y = pk2(s[2 * 33], s[3 * 33]); o.z = pk2(s[4 * 33], s[5 * 33]); o.w = pk2(s[6 * 33], s[7 * 33]);
        *(u32x4*)(WT + (size_t)(nrow0 + n) * ldk + k0 + 8 * c) = o; }
    LDS_WAIT();
}
DI int win_map(int n) { return n < 640 ? n : (n < 2944 ? n + 12 : (n < 2956 ? n - 2944 + 640 : (n < 2964 ? n : -1))); }

DI void prep_phase(const Ctx& C, ARGP a) {
    LAS float* scr = (LAS float*)(C.lds + C.wave * 16384);
    const int gw = C.bid * 8 + C.wave, NGW = C.G * 8, lane = C.lane;
    constexpr int I_UP = 16 * 176, I_DN = 44 * 32, I_IN = 16 * 96, I_SQ = 16 * 32, I_PP = 4 * 32, I_P1 = 32 * 8, I_P2 = 4 * 2;
    constexpr int PER_LAYER = 2 * I_UP + 2 * I_DN + I_IN + 2 * I_SQ + I_PP + 2 * I_P1 + 2 * I_P2;
    for (int it = gw; it < DEPTH * PER_LAYER; it += NGW) {
        const int L = it / PER_LAYER; int r = it % PER_LAYER;
        unsigned char* wb = C.ws + WS_W + (size_t)L * W_LAYER;
        if (r < 2 * I_UP) { const int f = r / I_UP; r %= I_UP; const int kb = r / 176, nb = r % 176; const int n = 32 * nb + (lane & 31);
            const int pn = n >> 8, bj = (n >> 7) & 1, hid = 128 * pn + (n & 127);
            const float* src = a->in[(f ? 7 : 4) + bj] + (size_t)L * DM * DFF;
            tr_item(src, DFF, DM, hid < DFF ? hid : -1, (bf16_t*)(wb + (f ? W_UP2 : W_UP1)), DM, 64 * kb, 32 * nb, scr, lane); continue; }
        r -= 2 * I_UP;
        if (r < 2 * I_DN) { const int f = r / I_DN; r %= I_DN; const int kb = r / 32, nb = r % 32;
            const float* src = a->in[f ? 9 : 6] + (size_t)L * DFF * DM;
            tr_item(src, DM, DFF, 32 * nb + (lane & 31), (bf16_t*)(wb + (f ? W_DN2 : W_DN1)), DFFP, 64 * kb, 32 * nb, scr, lane); continue; }
        r -= 2 * I_DN;
        if (r < I_IN) { const int kb = r / 96, nb = r % 96;
            tr_item(a->in[10] + (size_t)L * DM * IN_COLS, IN_COLS, DM, win_map(32 * nb + (lane & 31)), (bf16_t*)(wb + W_IN), DM, 64 * kb, 32 * nb, scr, lane); continue; }
        r -= I_IN;
        if (r < 2 * I_SQ) { const int f = r / I_SQ; r %= I_SQ; const int kb = r / 32, nb = r % 32;
            tr_item(a->in[f ? 21 : 20] + (size_t)L * DM * DM, DM, DM, 32 * nb + (lane & 31), (bf16_t*)(wb + (f ? W_PLEG : W_OUT)), DM, 64 * kb, 32 * nb, scr, lane); continue; }
        r -= 2 * I_SQ;
        if (r < I_PP) { const int kb = r / 32, nb = r % 32;
            tr_item(a->in[23] + (size_t)L * PLED * DM, DM, PLED, 32 * nb + (lane & 31), (bf16_t*)(wb + W_PLEP), PLED, 64 * kb, 32 * nb, scr, lane); continue; }
        r -= I_PP;
        if (r < 2 * I_P1) { const int f = r / I_P1; r %= I_P1; const int kb = r / 8, nb = r % 8;
            tr_item(a->in[f ? 16 : 14] + (size_t)L * 2048 * 256, 256, 2048, 32 * nb + (lane & 31), (bf16_t*)(wb + (f ? W_V1 : W_K1)), 2048, 64 * kb, 32 * nb, scr, lane); continue; }
        r -= 2 * I_P1;
        { const int f = r / I_P2; r %= I_P2; const int kb = r / 2, nb = r % 2;
            tr_item(a->in[f ? 17 : 15] + (size_t)L * 256 * 64, 64, 256, 32 * nb + (lane & 31), (bf16_t*)(wb + (f ? W_V2 : W_K2)), 256, 64 * kb, 32 * nb, scr, lane); }
    }
    const size_t gt = (size_t)C.bid * 512 + C.tid, NT = (size_t)C.G * 512;
    { const float* x = a->in[0]; bf16_t* xb = (bf16_t*)(C.ws + WS_XB); const float* p = a->in[1]; bf16_t* pb = (bf16_t*)(C.ws + WS_PB);
      constexpr size_t NX = (size_t)MTOK * DM / 8, NP = (size_t)DEPTH * MTOK * PLED / 8;
      for (size_t i0 = gt; i0 < NX + NP; i0 += 4 * NT) { f32x4 v[4][2];
#pragma unroll
          for (int q = 0; q < 4; ++q) { size_t i = i0 + q * NT; if (i >= NX + NP) i = gt; const float* src = i < NX ? x + i * 8 : p + (i - NX) * 8; v[q][0] = *(const f32x4*)src; v[q][1] = *(const f32x4*)(src + 4); }
#pragma unroll
          for (int q = 0; q < 4; ++q) { size_t i = i0 + q * NT; if (i >= NX + NP) i = gt; bf16_t* dst = i < NX ? xb + i * 8 : pb + (i - NX) * 8;
              u32x4 o; o.x = pk2(v[q][0][0], v[q][0][1]); o.y = pk2(v[q][0][2], v[q][0][3]); o.z = pk2(v[q][1][0], v[q][1][1]); o.w = pk2(v[q][1][2], v[q][1][3]); *(u32x4*)dst = o; } } }
    { float* tb = (float*)(C.ws + WS_TBL);
      for (size_t i = gt; i < (size_t)SEQ * 48; i += NT) {
          int pos, k; float inv; const bool big = i < (size_t)SEQ * 32; size_t j;
          if (big) { j = i; pos = (int)(i >> 5); k = (int)(i & 31); inv = exp2f(-(float)k * (13.2877123795f / 32.0f)); }
          else { j = i - (size_t)SEQ * 32; pos = (int)(j >> 4); k = (int)(j & 15); inv = exp2f(-(float)k * (13.2877123795f / 16.0f)); }
          const float ang = (float)pos * inv; double rv = (double)ang * 0.15915494309189535; rv -= floor(rv); const float fr = (float)rv;
          const float cs = __builtin_amdgcn_cosf(fr), sn = __builtin_amdgcn_sinf(fr);
          if (big) { tb[TB_COS64 / 4 + j] = cs; tb[TB_SIN64 / 4 + j] = sn; } else { tb[TB_COS32 / 4 + j] = cs; tb[TB_SIN32 / 4 + j] = sn; } } }
    { float* cb = (float*)(C.ws + WS_TBL + TB_CBIAS);
      for (int o = gw; o < DEPTH * 2 * 256; o += NGW) { const int L = o >> 9, kv = (o >> 8) & 1, n = o & 255;
          const float* pe = a->in[kv ? 13 : 12] + (size_t)L * 2048; const float* w1 = a->in[kv ? 16 : 14] + (size_t)L * 2048 * 256;
          float s = 0.f; for (int k = lane; k < 2048; k += 64) s += pe[k] * w1[(size_t)k * 256 + n];
          s = wave_sum(s); if (lane == 0) cb[o] = s; } }
    if (C.bid == 0 && C.tid < DEPTH) { const int L = C.tid; const float* lp = a->in[18] + L * 128; float s1 = 0.f, s2 = 0.f;
        for (int k = 0; k < 32; ++k) { s1 += lp[k] * lp[32 + k]; s2 += lp[64 + k] * lp[96 + k]; }
        const float li = 0.8f - 0.6f * expf(-0.3f * (float)L);
        ((float*)(C.ws + WS_TBL + TB_LAM))[L] = expf(s1) - expf(s2) + li; }
}

DI void ln_phase(const Ctx& C, float* X, bf16_t* XB, const float* g, const float* b) {
    const int gw = C.bid * 8 + C.wave, NGW = C.G * 8, lane = C.lane;
    f32x4 gv[4], bv[4];
#pragma unroll
    for (int j = 0; j < 4; ++j) { gv[j] = *(const f32x4*)(g + 4 * lane + 256 * j); bv[j] = *(const f32x4*)(b + 4 * lane + 256 * j); }
    for (int m = gw; m < MTOK; m += NGW) {
        float* xr = X + (size_t)m * DM + 4 * lane; f32x4 v[4]; float s = 0.f;
#pragma unroll
        for (int j = 0; j < 4; ++j) { v[j] = *(const f32x4*)(xr + 256 * j); s += (v[j][0] + v[j][1]) + (v[j][2] + v[j][3]); }
        const float mean = wave_sum(s) * (1.f / DM); float s2 = 0.f;
#pragma unroll
        for (int j = 0; j < 4; ++j) { v[j] = v[j] - mean; s2 += (v[j][0] * v[j][0] + v[j][1] * v[j][1]) + (v[j][2] * v[j][2] + v[j][3] * v[j][3]); }
        const float rstd = 1.0f / sqrtf(wave_sum(s2) * (1.f / DM) + LN_EPS);
        bf16_t* xo = XB + (size_t)m * DM + 4 * lane;
#pragma unroll
        for (int j = 0; j < 4; ++j) { const f32x4 o = v[j] * rstd * gv[j] + bv[j]; *(f32x4*)(xr + 256 * j) = o;
            u32x2 w; w.x = pk2(o[0], o[1]); w.y = pk2(o[2], o[3]); *(u32x2*)(xo + 256 * j) = w; }
    }
}
#define XLAS __attribute__((address_space(3)))
#define XB_TMO      128
#define XB_XCNT(j)  (256  + 64 * (j))
#define XB_XSUB(j)  (1280 + 64 * (j))
#define XB_XGEN(j)  (2304 + 64 * (j))
#define XB_TOP      3328
#define XB_TOPGEN   3392
#define XCD_BAR_WORDS 3456
#define XB_SPIN_CAP (1u << 18)

__device__ __forceinline__ unsigned xb_ld(unsigned* p)              { return __hip_atomic_load(p, __ATOMIC_RELAXED, __HIP_MEMORY_SCOPE_AGENT); }
__device__ __forceinline__ unsigned xb_add(unsigned* p, unsigned v) { return __hip_atomic_fetch_add(p, v, __ATOMIC_RELAXED, __HIP_MEMORY_SCOPE_AGENT); }
__device__ __forceinline__ unsigned xb_xcc_id() { return (unsigned)__builtin_amdgcn_s_getreg((3 << 11) | 20) & 0xFu; }
#define XB_SPIN(cond, bar) do { unsigned _sp = 0; while (cond) { __builtin_amdgcn_s_sleep(1); \
    if ((++_sp & 255u) == 0u) { if (xb_ld(&(bar)[XB_TMO])) break; if (_sp > XB_SPIN_CAP) { atomicAdd(&(bar)[XB_TMO], 1u); break; } } } } while (0)

struct XcdBarrier {
    unsigned* bar; unsigned x;
    volatile XLAS unsigned* st;
};

__device__ __forceinline__ XcdBarrier xcd_barrier_post(unsigned* bar, volatile XLAS unsigned* st) {
    XcdBarrier b; b.bar = bar; b.x = xb_xcc_id(); b.st = st;
    if (threadIdx.x == 0) (void)xb_add(&bar[XB_XCNT(b.x)], 1u);
    return b;
}
__device__ __forceinline__ void xcd_barrier_complete(unsigned* bar, unsigned x, unsigned& nloc, unsigned& nx) {
    const unsigned G = gridDim.x * gridDim.y * gridDim.z;
    unsigned sum, cnt, mine, sp = 0u;
    for (;;) {
        sum = 0u; cnt = 0u; mine = 0u;
#pragma unroll
        for (unsigned j = 0; j < 16; ++j) { const unsigned c = xb_ld(&bar[XB_XCNT(j)]); sum += c; cnt += (c > 0u) ? 1u : 0u; mine = (j == x) ? c : mine; }
        if (sum == G) break;
        __builtin_amdgcn_s_sleep(1);
        if ((++sp & 255u) == 0u) { if (xb_ld(&bar[XB_TMO])) break; if (sp > XB_SPIN_CAP) { atomicAdd(&bar[XB_TMO], 1u); break; } }
    }
    nloc = mine > 0u ? mine : 1u; nx = cnt > 0u ? cnt : 1u;
}

__device__ __forceinline__ void xcd_barrier(const XcdBarrier& b) {
    asm volatile("s_waitcnt vmcnt(0)" ::: "memory");
    __syncthreads();
    if (threadIdx.x == 0) {
        unsigned* bar = b.bar;
        __builtin_amdgcn_s_waitcnt(0);
        unsigned nloc = b.st[0], nx = b.st[1];
        if (nloc == 0u) { xcd_barrier_complete(bar, b.x, nloc, nx); b.st[0] = nloc; b.st[1] = nx; }
        const unsigned old = xb_add(&bar[XB_XSUB(b.x)], 1u);
        const unsigned gen = old / nloc;
        if (old + 1u == (gen + 1u) * nloc) {
            __builtin_amdgcn_fence(__ATOMIC_RELEASE, "agent");
            asm volatile("s_waitcnt vmcnt(0)" ::: "memory");
            const unsigned og = xb_add(&bar[XB_TOP], 1u);
            const unsigned tg = og / nx;
            if (og + 1u == (tg + 1u) * nx) xb_add(&bar[XB_TOPGEN], 1u);
            else XB_SPIN(xb_ld(&bar[XB_TOPGEN]) == tg, bar);
            __builtin_amdgcn_fence(__ATOMIC_ACQUIRE, "agent");
            xb_add(&bar[XB_XGEN(b.x)], 1u);
            asm volatile("s_waitcnt vmcnt(0)" ::: "memory");
        } else {
            XB_SPIN(xb_ld(&bar[XB_XGEN(b.x)]) == gen, bar);
            __builtin_amdgcn_fence(__ATOMIC_ACQUIRE, "agent");
            asm volatile("s_waitcnt vmcnt(0)" ::: "memory");
        }
    }
    __syncthreads();
}
DI float gelu_tanh(float x) { const float z = 0.7978845608f * (x + 0.044715f * x * x * x); const float e = __builtin_amdgcn_exp2f(2.0f * LOG2E * z); return 0.5f * x * (2.0f - 2.0f * __builtin_amdgcn_rcpf(e + 1.0f)); }

DI void cmp_mlp_unit(const Ctx& C, const bf16_t* proj, int b, int cgp, int kv, const bf16_t* W1t, const bf16_t* W2t, const float* bias, bf16_t* outp, const float* cos64, const float* sin64) {
    constexpr int SP = 72, HP = 264;
    LAS bf16_t* span = (LAS bf16_t*)C.lds;
    LAS bf16_t* Hs = (LAS bf16_t*)(C.lds + 528 * SP * 2);
    LAS float* Os = (LAS float*)(C.lds + 528 * SP * 2 + 32 * HP * 2);
    const int tid = C.tid, lane = C.lane, w = C.wave, row16 = lane & 15, quad = lane >> 4;
    const int t0 = 512 * cgp;
    for (int idx = tid; idx < 528 * 8; idx += 512) { const int tr = idx >> 3, ch = idx & 7, t = t0 + tr; u32x4 v = {0u, 0u, 0u, 0u};
        if (t < SEQ) v = *(const u32x4*)(proj + (size_t)(b * SEQ + t) * NPROJ + C_NKV + kv * 64 + ch * 8);
        *(LAS u32x4*)(span + tr * SP + ch * 8) = v; }
    __syncthreads();
    f32x4 acc[2][2];
#pragma unroll
    for (int i = 0; i < 2; ++i)
#pragma unroll
        for (int j = 0; j < 2; ++j) acc[i][j] = (f32x4){0.f, 0.f, 0.f, 0.f};
    const bf16_t* wb0 = W1t + (size_t)(32 * w + row16) * 2048 + quad * 8;
#pragma unroll 4
    for (int ks = 0; ks < 64; ++ks) { const int l = ks >> 1, dq = ks & 1, k0 = l * 64 + 32 * dq;
        const bf16x8 b0 = *(const bf16x8*)(wb0 + k0), b1 = *(const bf16x8*)(wb0 + 16 * 2048 + k0);
        const bf16x8 a0 = *(const LAS bf16x8*)(span + (16 * row16 + l) * SP + 32 * dq + quad * 8);
        const bf16x8 a1 = *(const LAS bf16x8*)(span + (16 * (16 + row16) + l) * SP + 32 * dq + quad * 8);
        acc[0][0] = MFMA16(a0, b0, acc[0][0]); acc[0][1] = MFMA16(a0, b1, acc[0][1]); acc[1][0] = MFMA16(a1, b0, acc[1][0]); acc[1][1] = MFMA16(a1, b1, acc[1][1]); }
#pragma unroll
    for (int mi = 0; mi < 2; ++mi)
#pragma unroll
        for (int ni = 0; ni < 2; ++ni) { const int n = 32 * w + 16 * ni + row16; const float bs = bias[n];
#pragma unroll
            for (int j = 0; j < 4; ++j) Hs[(16 * mi + quad * 4 + j) * HP + n] = f2bf(gelu_tanh(acc[mi][ni][j] + bs)); }
    __syncthreads();
    { const int mt = w >> 2, nt = w & 3; f32x4 a2 = {0.f, 0.f, 0.f, 0.f};
#pragma unroll
      for (int ks = 0; ks < 8; ++ks) { const bf16x8 av = *(const LAS bf16x8*)(Hs + (16 * mt + row16) * HP + 32 * ks + quad * 8);
          const bf16x8 bv = *(const bf16x8*)(W2t + (size_t)(16 * nt + row16) * 256 + 32 * ks + quad * 8); a2 = MFMA16(av, bv, a2); }
#pragma unroll
      for (int j = 0; j < 4; ++j) Os[(16 * mt + quad * 4 + j) * 64 + 16 * nt + row16] = a2[j]; }
    __syncthreads();
    { const int c = tid >> 4, cglob = 32 * cgp + c; bf16_t* op = outp + (size_t)(b * 128 + cglob) * 64;
#pragma unroll
      for (int e = 0; e < 2; ++e) { const int i = (tid & 15) * 2 + e; float x1 = Os[c * 64 + i], x2 = Os[c * 64 + i + 32];
          if (cglob >= 127) { x1 = 0.f; x2 = 0.f; }
          else if (kv == 0) { const int pos = 16 * cglob + 31; const float cs = cos64[pos * 32 + i], sn = sin64[pos * 32 + i]; const float y1 = x1 * cs - x2 * sn, y2 = x2 * cs + x1 * sn; x1 = y1; x2 = y2; }
          op[i] = f2bf(x1); op[i + 32] = f2bf(x2); } }
    __syncthreads();
}

DI void attn_prep_phase(const Ctx& C, ARGP a, int L) {
    bf16_t* proj = (bf16_t*)(C.ws + WS_BIG);
    const float* tb = (const float*)(C.ws + WS_TBL);
    const float* cos64 = tb + TB_COS64 / 4; const float* sin64 = tb + TB_SIN64 / 4; const float* cos32 = tb + TB_COS32 / 4; const float* sin32 = tb + TB_SIN32 / 4;
    unsigned char* wb = C.ws + WS_W + (size_t)L * W_LAYER;
    for (int u = C.bid; u < BATCH * 4 * 2; u += C.G) { const int kv = u & 1, cgp = (u >> 1) & 3, b = u >> 3;
        cmp_mlp_unit(C, proj, b, cgp, kv, (const bf16_t*)(wb + (kv ? W_V1 : W_K1)), (const bf16_t*)(wb + (kv ? W_V2 : W_K2)),
                     (const float*)(C.ws + WS_TBL + TB_CBIAS) + (L * 2 + kv) * 256, (bf16_t*)(C.ws + (kv ? WS_VC : WS_KC)), cos64, sin64); }
    const int gw = C.bid * 8 + C.wave, NGW = C.G * 8, lane = C.lane;
    for (int m = gw; m < MTOK; m += NGW) { const int pos = m & (SEQ - 1); bf16_t* row = proj + (size_t)m * NPROJ;
#pragma unroll
        for (int k = 0; k < 7; ++k) { const int pi = lane + 64 * k; int c0, half; float cs, sn;
            if (pi < 192) { int i; if (pi < 128) { c0 = C_NQ + (pi >> 5) * 64; i = pi & 31; } else if (pi < 160) { c0 = C_NKV + 128; i = pi - 128; } else { c0 = C_NKV + 256; i = pi - 160; }
                c0 += i; half = 32; cs = cos64[pos * 32 + i]; sn = sin64[pos * 32 + i]; }
            else { const int q = pi - 192; const int s = (q >> 4) & 7, i = q & 15; c0 = (q < 128 ? C_DQ : C_DK) + 32 * s + i; half = 16; cs = cos32[pos * 16 + i]; sn = sin32[pos * 16 + i]; }
            const float x1 = bf2f(row[c0]), x2 = bf2f(row[c0 + half]);
            row[c0] = f2bf(x1 * cs - x2 * sn); row[c0 + half] = f2bf(x2 * cs + x1 * sn); } }
    for (int u = gw; u < BATCH * 8; u += NGW) { const int b = u >> 3, h = u & 7; const float bf = a->in[11][L * 8 + h];
        float* ck = (float*)(C.ws + WS_CKL) + (size_t)u * SEQ + lane * 32; const bf16_t* fp = proj + (size_t)(b * SEQ + lane * 32) * NPROJ + C_FF + h;
        float run = 0.f; float loc[32];
#pragma unroll
        for (int i = 0; i < 32; ++i) { const float x = bf2f(fp[(size_t)i * NPROJ]) + bf; const float ls = fminf(x, 0.f) - log1pf(expf(-fabsf(x))); run += ls; loc[i] = run; }
        float incl = run;
#pragma unroll
        for (int o = 1; o < 64; o <<= 1) { const float t = __shfl_up(incl, o); if (lane >= o) incl += t; }
        const float base = incl - run;
#pragma unroll
        for (int i = 0; i < 32; ++i) ck[i] = (base + loc[i]) * LOG2E; }
}

constexpr int KP = 72;
DI void cmp_attn_phase(const Ctx& C, int L) {
    const bf16_t* proj = (const bf16_t*)(C.ws + WS_BIG);
    LAS bf16_t* Ks = (LAS bf16_t*)C.lds;
    LAS bf16_t* Vs = (LAS bf16_t*)(C.lds + 128 * KP * 2);
    LAS float* Ps = (LAS float*)(C.lds + 2 * 128 * KP * 2 + C.wave * 5120);
    LAS float* Sc = Ps + 8 * 128;
    const int tid = C.tid, lane = C.lane, w = C.wave, r = lane & 31, hh = lane >> 5;
    const float c1 = 0.125f * LOG2E;
    for (int ug = C.bid; ug < BATCH * 8; ug += C.G) {
        const int b = ug >> 3;
        __syncthreads();
        for (int idx = tid; idx < 128 * 8 * 2; idx += 512) { const int kvs = idx >> 10, rem = idx & 1023, c = rem >> 3, ch = rem & 7;
            const u32x4 v = *(const u32x4*)((const bf16_t*)(C.ws + (kvs ? WS_VC : WS_KC)) + (size_t)(b * 128 + c) * 64 + ch * 8);
            *(LAS u32x4*)((kvs ? Vs : Ks) + c * KP + ch * 8) = v; }
        __syncthreads();
        for (int uu = 0; uu < 4; ++uu) {
            const int t0 = ((ug & 7) * 4 + uu) * 64; const int tok = t0 + 8 * w + (r >> 2), g = r & 3; const size_t m = (size_t)b * SEQ + tok;
            bf16x8 qf[4];
#pragma unroll
            for (int s = 0; s < 4; ++s) qf[s] = *(const bf16x8*)(proj + m * NPROJ + C_NQ + g * 64 + 16 * s + 8 * hh);
            f32x16 p[4];
#pragma unroll
            for (int kt = 0; kt < 4; ++kt) { f32x16 acc;
#pragma unroll
                for (int i = 0; i < 16; ++i) acc[i] = 0.f;
#pragma unroll
                for (int s = 0; s < 4; ++s) { const bf16x8 kf = *(const LAS bf16x8*)(Ks + (32 * kt + r) * KP + 16 * s + 8 * hh); acc = MFMA32(kf, qf[s], acc); }
                p[kt] = acc; }
            float mx = -1e30f; const int climh = ((tok - 31) >> 4) - 4 * hh;
#pragma unroll
            for (int kt = 0; kt < 4; ++kt)
#pragma unroll
                for (int i = 0; i < 16; ++i) { const bool ok = (32 * kt + (i & 3) + 8 * (i >> 2)) <= climh; p[kt][i] = ok ? p[kt][i] : -INFINITY; mx = fmaxf(mx, p[kt][i]); }
            mx = fmaxf(mx, __shfl_xor(mx, 32));
            float sum = 0.f; const float off = mx * c1;
#pragma unroll
            for (int kt = 0; kt < 4; ++kt)
#pragma unroll
                for (int i = 0; i < 16; ++i) { const float e = __builtin_amdgcn_exp2f(p[kt][i] * c1 - off); p[kt][i] = e; sum += e; }
            sum += __shfl_xor(sum, 32);
            const float inv = (tok >= 31) ? 1.0f / sum : 0.f;
#pragma unroll
            for (int kt = 0; kt < 4; ++kt)
#pragma unroll
                for (int i = 0; i < 16; ++i) p[kt][i] *= inv;
            __builtin_amdgcn_sched_barrier(0);
            f32x16 o[2];
#pragma unroll
            for (int dt = 0; dt < 2; ++dt)
#pragma unroll
                for (int i = 0; i < 16; ++i) o[dt][i] = 0.f;
            const int i16 = lane & 15, q4 = i16 >> 2, pp = i16 & 3, blk = (lane >> 4) & 1;
            const LAS bf16_t* vb = Vs + (4 * hh + q4) * KP + 16 * blk + 4 * pp;
#pragma unroll
            for (int kt = 0; kt < 4; ++kt)
#pragma unroll
                for (int s = 0; s < 2; ++s) { u32x4 pw; pw.x = pk2(p[kt][8 * s], p[kt][8 * s + 1]); pw.y = pk2(p[kt][8 * s + 2], p[kt][8 * s + 3]); pw.z = pk2(p[kt][8 * s + 4], p[kt][8 * s + 5]); pw.w = pk2(p[kt][8 * s + 6], p[kt][8 * s + 7]);
                    const bf16x8 pf = __builtin_bit_cast(bf16x8, pw);
#pragma unroll
                    for (int dt = 0; dt < 2; ++dt) { const s16x4 lo = __builtin_amdgcn_ds_read_tr16_b64_v4i16((LAS s16x4*)(vb + (32 * kt + 16 * s) * KP + 32 * dt));
                        const s16x4 hi = __builtin_amdgcn_ds_read_tr16_b64_v4i16((LAS s16x4*)(vb + (32 * kt + 16 * s + 8) * KP + 32 * dt));
                        const bf16x8 vf = __builtin_shufflevector(lo, hi, 0, 1, 2, 3, 4, 5, 6, 7); o[dt] = MFMA32(vf, pf, o[dt]); } __builtin_amdgcn_sched_barrier(0); }
            __builtin_amdgcn_sched_barrier(0);
            { const float gl = bf2f(proj[m * NPROJ + C_NG + g * 3 + 0]); const float gate = 1.0f / (1.0f + __expf(-gl));
              float* op = (float*)(C.ws + WS_OCMP) + m * 256 + g * 64;
#pragma unroll
              for (int dt = 0; dt < 2; ++dt)
#pragma unroll
                  for (int g4 = 0; g4 < 4; ++g4) { f32x4 v; v[0] = o[dt][4 * g4] * gate; v[1] = o[dt][4 * g4 + 1] * gate; v[2] = o[dt][4 * g4 + 2] * gate; v[3] = o[dt][4 * g4 + 3] * gate;
                      *(f32x4*)(op + 32 * dt + 8 * g4 + 4 * hh) = v; } }
            __builtin_amdgcn_sched_barrier(0);
#pragma unroll
            for (int kt = 0; kt < 4; ++kt)
#pragma unroll
                for (int i = 0; i < 16; ++i) { float v = p[kt][i]; v += __shfl_xor(v, 1); v += __shfl_xor(v, 2); p[kt][i] = v; }
            __builtin_amdgcn_sched_barrier(0);
            if (g == 0) {
#pragma unroll
                for (int kt = 0; kt < 4; ++kt)
#pragma unroll
                    for (int g4 = 0; g4 < 4; ++g4) { f32x4 v; v[0] = p[kt][4 * g4]; v[1] = p[kt][4 * g4 + 1]; v[2] = p[kt][4 * g4 + 2]; v[3] = p[kt][4 * g4 + 3];
                        *(LAS f32x4*)(Ps + (r >> 2) * 128 + 32 * kt + 8 * g4 + 4 * hh) = v; } }
            LDS_WAIT();
            { const int tk = lane >> 3, jg = lane & 7; const int t = t0 + 8 * w + tk; const int blk_t = t >> 6;
              float sc[4];
#pragma unroll
              for (int jj = 0; jj < 4; ++jj) { const int j = 4 * jg + jj; float imp = 0.f;
#pragma unroll
                  for (int cc = -1; cc < 4; ++cc) { const int c = 4 * j + cc; if (c >= 0) imp += Ps[tk * 128 + c]; }
                  const bool forced = (j == 0) || (j == blk_t) || (j == blk_t - 1); const bool valid = (j * 64) <= t;
                  sc[jj] = forced ? 1e9f : (valid ? imp : -1.0f); Sc[tk * 32 + j] = sc[jj]; }
              LDS_WAIT();
              unsigned bits = 0u;
#pragma unroll
              for (int jj = 0; jj < 4; ++jj) { const int j = 4 * jg + jj; int cnt = 0;
                  for (int j2 = 0; j2 < 32; ++j2) { const float o2 = Sc[tk * 32 + j2]; cnt += (o2 > sc[jj] || (o2 == sc[jj] && j2 < j)) ? 1 : 0; }
                  if (cnt < 16) bits |= 1u << j; }
              bits |= __shfl_xor(bits, 1); bits |= __shfl_xor(bits, 2); bits |= __shfl_xor(bits, 4);
              if (jg == 0) ((unsigned*)(C.ws + WS_SEL))[(size_t)b * SEQ + t] = bits; }
            LDS_WAIT();
        }
    }
}
constexpr int AT_KBUF = 64 * KP * 2;
constexpr int AT_K0 = 0, AT_V0 = 2 * AT_KBUF, AT_C0 = 4 * AT_KBUF, AT_MISC = AT_C0 + 2 * 256;

template <bool BIAS, bool SEL, int NS>
DI void tile_step(const LAS bf16_t* Kl, const LAS bf16_t* Vl, const LAS float* Cl, const bf16x8 (&qf)[NS], f32x16 (&o)[2], float& m, float& l,
                  const float c1, const int mmode, const int key0, const int trow, const bool kill, const int hh) {
    f32x16 p[2];
#pragma unroll
    for (int kt = 0; kt < 2; ++kt) { f32x16 acc;
#pragma unroll
        for (int i = 0; i < 16; ++i) acc[i] = 0.f;
#pragma unroll
        for (int s = 0; s < NS; ++s) { const bf16x8 kf = *(const LAS bf16x8*)(Kl + 32 * kt * KP + 16 * s); acc = MFMA32(kf, qf[s], acc); }
        p[kt] = acc; }
    if (BIAS) {
        const f32x2 c1v = {c1, c1};
#pragma unroll
        for (int kt = 0; kt < 2; ++kt)
#pragma unroll
            for (int g4 = 0; g4 < 4; ++g4) { const f32x4 cv = *(const LAS f32x4*)(Cl + 32 * kt + 8 * g4);
                f32x2 a0 = {p[kt][4 * g4], p[kt][4 * g4 + 1]}, a1 = {p[kt][4 * g4 + 2], p[kt][4 * g4 + 3]};
                a0 = a0 * c1v - (f32x2){cv[0], cv[1]}; a1 = a1 * c1v - (f32x2){cv[2], cv[3]};
                p[kt][4 * g4] = a0[0]; p[kt][4 * g4 + 1] = a0[1]; p[kt][4 * g4 + 2] = a1[0]; p[kt][4 * g4 + 3] = a1[1]; }
    }
    const int lim = trow - key0 - 4 * hh;
    if (mmode == 1) {
#pragma unroll
        for (int kt = 0; kt < 2; ++kt)
#pragma unroll
            for (int i = 0; i < 16; ++i) p[kt][i] = ((32 * kt + (i & 3) + 8 * (i >> 2)) > lim) ? -INFINITY : p[kt][i];
    } else if (mmode == 2) {
#pragma unroll
        for (int kt = 0; kt < 2; ++kt)
#pragma unroll
            for (int i = 0; i < 16; ++i) p[kt][i] = ((32 * kt + (i & 3) + 8 * (i >> 2)) <= lim - 512) ? -INFINITY : p[kt][i];
    }
    if (SEL) { if (kill) {
#pragma unroll
        for (int kt = 0; kt < 2; ++kt)
#pragma unroll
            for (int i = 0; i < 16; ++i) p[kt][i] = -INFINITY; } }
    float mx = p[0][0];
#pragma unroll
    for (int kt = 0; kt < 2; ++kt)
#pragma unroll
        for (int i = 0; i < 16; ++i) mx = fmaxf(mx, p[kt][i]);
    mx = fmaxf(mx, __shfl_xor(mx, 32));
    const float mn = fmaxf(m, mx);
    float alpha, off, sc;
    if (BIAS) { alpha = __builtin_amdgcn_exp2f(m - mn); off = mn; sc = 1.0f; } else { alpha = __builtin_amdgcn_exp2f((m - mn) * c1); off = mn * c1; sc = c1; }
    m = mn;
    f32x2 rs2 = {0.f, 0.f}; const f32x2 scv = {sc, sc}, offv = {off, off};
#pragma unroll
    for (int kt = 0; kt < 2; ++kt)
#pragma unroll
        for (int i = 0; i < 16; i += 2) { f32x2 a = {p[kt][i], p[kt][i + 1]}; a = a * scv - offv; f32x2 e; e[0] = __builtin_amdgcn_exp2f(a[0]); e[1] = __builtin_amdgcn_exp2f(a[1]);
            p[kt][i] = e[0]; p[kt][i + 1] = e[1]; rs2 += e; }
    l = l * alpha + (rs2[0] + rs2[1]);
    const f32x2 av = {alpha, alpha};
#pragma unroll
    for (int dt = 0; dt < 2; ++dt)
#pragma unroll
        for (int i = 0; i < 16; i += 2) { f32x2 a = {o[dt][i], o[dt][i + 1]}; a = a * av; o[dt][i] = a[0]; o[dt][i + 1] = a[1]; }
#pragma unroll
    for (int kt = 0; kt < 2; ++kt)
#pragma unroll
        for (int s = 0; s < 2; ++s) { u32x4 pw; pw.x = pk2(p[kt][8 * s], p[kt][8 * s + 1]); pw.y = pk2(p[kt][8 * s + 2], p[kt][8 * s + 3]); pw.z = pk2(p[kt][8 * s + 4], p[kt][8 * s + 5]); pw.w = pk2(p[kt][8 * s + 6], p[kt][8 * s + 7]);
            const bf16x8 pf = __builtin_bit_cast(bf16x8, pw);
#pragma unroll
            for (int dt = 0; dt < 2; ++dt) { const s16x4 lo = __builtin_amdgcn_ds_read_tr16_b64_v4i16((LAS s16x4*)(Vl + (32 * kt + 16 * s) * KP + 32 * dt));
                const s16x4 hi = __builtin_amdgcn_ds_read_tr16_b64_v4i16((LAS s16x4*)(Vl + (32 * kt + 16 * s + 8) * KP + 32 * dt));
                const bf16x8 vf = __builtin_shufflevector(lo, hi, 0, 1, 2, 3, 4, 5, 6, 7); o[dt] = MFMA32(vf, pf, o[dt]); } }
}

struct TileRegs { u32x4 k, v; float c; };
template <bool BIAS>
DI void tile_gload(TileRegs& R, const bf16_t* kbase, const bf16_t* vbase, const float* cbase, int key0, int tid) {
    const size_t off = (size_t)(key0 + (tid >> 3)) * NPROJ + (tid & 7) * 8;
    R.k = *(const u32x4*)(kbase + off); R.v = *(const u32x4*)(vbase + off);
    if (BIAS) { if (tid < 64) R.c = cbase[key0 + tid]; }
}
template <bool BIAS>
DI void tile_lstore(const TileRegs& R, LAS unsigned char* lds, int buf, int tid) {
    const int o = ((tid >> 3) * KP + (tid & 7) * 8) * 2;
    *(LAS u32x4*)(lds + AT_K0 + buf * AT_KBUF + o) = R.k; *(LAS u32x4*)(lds + AT_V0 + buf * AT_KBUF + o) = R.v;
    if (BIAS) { if (tid < 64) *(LAS float*)(lds + AT_C0 + buf * 256 + tid * 4) = R.c; }
}

template <bool BIAS, bool SEL, int NS, int NMAP>
DI void flash_pass(const Ctx& C, const bf16_t* kbase, const bf16_t* vbase, const float* cbase, int j0, int j1, int wave_last, int lowtile,
                   const bf16x8 (&qf)[NMAP][NS], f32x16 (&o)[NMAP][2], float (&m)[NMAP], float (&l)[NMAP], float c1, int trow, unsigned selbits, int hh) {
    const int tid = C.tid, lane = C.lane, r = lane & 31;
    const int i16 = lane & 15, q4 = i16 >> 2, pp = i16 & 3, blk = (lane >> 4) & 1;
    TileRegs R;
    tile_gload<BIAS>(R, kbase, vbase, cbase, 64 * j0, tid);
    tile_lstore<BIAS>(R, C.lds, 0, tid);
    __syncthreads();
    int cur = 0;
    for (int j = j0; j <= j1; ++j) {
        if (j < j1) tile_gload<BIAS>(R, kbase, vbase, cbase, 64 * (j + 1), tid);
        if (j <= wave_last) {
            const LAS bf16_t* Kt = (const LAS bf16_t*)(C.lds + AT_K0 + cur * AT_KBUF);
            const LAS bf16_t* Vl = (const LAS bf16_t*)(C.lds + AT_V0 + cur * AT_KBUF) + (4 * hh + q4) * KP + 16 * blk + 4 * pp;
            const LAS float* Cl = (const LAS float*)(C.lds + AT_C0 + cur * 256) + 4 * hh;
            const int mmode = (j == wave_last) ? 1 : ((j == lowtile) ? 2 : 0);
            const bool kill = SEL ? (((selbits >> j) & 1u) == 0u) : false;
#pragma unroll
            for (int mp = 0; mp < NMAP; ++mp)
                tile_step<BIAS, SEL, NS>(Kt + r * KP + 8 * hh + mp * 32, Vl, Cl, qf[mp], o[mp], m[mp], l[mp], c1, mmode, 64 * j, trow, kill, hh);
        }
        if (j < j1) tile_lstore<BIAS>(R, C.lds, cur ^ 1, tid);
        __syncthreads();
        cur ^= 1;
    }
}

DI void store_row64(bf16_t* dst, const f32x16 (&v)[2], int hh) {
#pragma unroll
    for (int dt = 0; dt < 2; ++dt)
#pragma unroll
        for (int g4 = 0; g4 < 4; ++g4) { u32x2 w; w.x = pk2(v[dt][4 * g4], v[dt][4 * g4 + 1]); w.y = pk2(v[dt][4 * g4 + 2], v[dt][4 * g4 + 3]); *(u32x2*)(dst + 32 * dt + 8 * g4 + 4 * hh) = w; }
}

DI void attn_phase(const Ctx& C, ARGP a, int L) {
    const bf16_t* proj = (const bf16_t*)(C.ws + WS_BIG);
    bf16_t* mix = (bf16_t*)(C.ws + WS_MIX);
    unsigned* qctr = (unsigned*)(C.ws + WS_CTL) + CW_QUEUE + 64 * L;
    volatile LAS int* slot = (volatile LAS int*)(C.lds + AT_MISC);
    const int tid = C.tid, lane = C.lane, w = C.wave, r = lane & 31, hh = lane >> 5;
    for (;;) {
        __syncthreads();
        if (tid == 0) slot[0] = (int)atomicAdd(qctr, 1u);
        __syncthreads();
        const int idx = slot[0];
        if (idx >= 4096) break;
        const int qb8 = 7 - (idx >> 9), rem = idx & 511;
        if (rem >= 256) {
            const int r3 = rem - 256, b = r3 >> 3, h = r3 & 7; const int tok = 256 * qb8 + 32 * w + r; const size_t mrow = (size_t)b * SEQ + tok;
            bf16x8 qf[1][4];
#pragma unroll
            for (int s = 0; s < 4; ++s) qf[0][s] = *(const bf16x8*)(proj + mrow * NPROJ + C_FQ + h * 64 + 16 * s + 8 * hh);
            f32x16 o[1][2]; float m[1] = {-1e30f}, l[1] = {0.f};
#pragma unroll
            for (int dt = 0; dt < 2; ++dt)
#pragma unroll
                for (int i = 0; i < 16; ++i) o[0][dt][i] = 0.f;
            const bf16_t* kb = proj + (size_t)b * SEQ * NPROJ + C_FK + h * 64; const bf16_t* vb = proj + (size_t)b * SEQ * NPROJ + C_FV + h * 64;
            const float* cb = (const float*)(C.ws + WS_CKL) + (size_t)(b * 8 + h) * SEQ;
            flash_pass<true, false, 4, 1>(C, kb, vb, cb, 0, 4 * qb8 + 3, 4 * qb8 + (w >> 1), -1, qf, o, m, l, 0.125f * LOG2E, tok, 0xffffffffu, hh);
            const float lt = l[0] + __shfl_xor(l[0], 32); const float inv = 1.0f / lt;
#pragma unroll
            for (int dt = 0; dt < 2; ++dt)
#pragma unroll
                for (int i = 0; i < 16; ++i) o[0][dt][i] *= inv;
            store_row64(mix + mrow * DM + 512 + h * 64, o[0], hh);
        } else if (rem < 128) {
            const int b = rem >> 2, h = rem & 3; const int tok = 256 * qb8 + 32 * w + r; const size_t mrow = (size_t)b * SEQ + tok;
            bf16x8 qf[2][2];
#pragma unroll
            for (int mp = 0; mp < 2; ++mp)
#pragma unroll
                for (int s = 0; s < 2; ++s) qf[mp][s] = *(const bf16x8*)(proj + mrow * NPROJ + C_DQ + h * 64 + mp * 32 + 16 * s + 8 * hh);
            f32x16 o[2][2]; float m[2] = {-1e30f, -1e30f}, l[2] = {0.f, 0.f};
#pragma unroll
            for (int mp = 0; mp < 2; ++mp)
#pragma unroll
                for (int dt = 0; dt < 2; ++dt)
#pragma unroll
                    for (int i = 0; i < 16; ++i) o[mp][dt][i] = 0.f;
            const bf16_t* kb = proj + (size_t)b * SEQ * NPROJ + C_DK + h * 64; const bf16_t* vb = proj + (size_t)b * SEQ * NPROJ + C_DV + h * 64;
            flash_pass<false, false, 2, 2>(C, kb, vb, nullptr, 0, 4 * qb8 + 3, 4 * qb8 + (w >> 1), -1, qf, o, m, l, 0.17677669529f * LOG2E, tok, 0xffffffffu, hh);
            const float lam = ((const float*)(C.ws + WS_TBL + TB_LAM))[L]; const float li = 0.8f - 0.6f * expf(-0.3f * (float)L);
            const float i0 = 1.0f / (l[0] + __shfl_xor(l[0], 32)), i1 = lam / (l[1] + __shfl_xor(l[1], 32));
            float ss = 0.f;
#pragma unroll
            for (int dt = 0; dt < 2; ++dt)
#pragma unroll
                for (int i = 0; i < 16; ++i) { const float v = o[0][dt][i] * i0 - o[1][dt][i] * i1; o[0][dt][i] = v; ss += v * v; }
            ss += __shfl_xor(ss, 32);
            const float rms = (1.0f / sqrtf(ss * (1.0f / 64.0f) + LN_EPS)) * (1.0f - li);
            const float* sg = a->in[19] + L * 64;
#pragma unroll
            for (int dt = 0; dt < 2; ++dt)
#pragma unroll
                for (int g4 = 0; g4 < 4; ++g4) { const f32x4 gv = *(const f32x4*)(sg + 32 * dt + 8 * g4 + 4 * hh);
#pragma unroll
                    for (int e = 0; e < 4; ++e) o[0][dt][4 * g4 + e] *= rms * gv[e]; }
            store_row64(mix + mrow * DM + 256 + h * 64, o[0], hh);
        } else {
            const int r2 = rem - 128, b = r2 & 31, qb = 4 * qb8 + 3 - (r2 >> 5); const int tok = 64 * qb + 8 * w + (r >> 2), g = r & 3; const size_t mrow = (size_t)b * SEQ + tok;
            bf16x8 qf[1][4];
#pragma unroll
            for (int s = 0; s < 4; ++s) qf[0][s] = *(const bf16x8*)(proj + mrow * NPROJ + C_NQ + g * 64 + 16 * s + 8 * hh);
            const unsigned sel = ((const unsigned*)(C.ws + WS_SEL))[mrow];
            const bf16_t* pb = proj + (size_t)b * SEQ * NPROJ + C_NKV;
            f32x16 o[1][2], keep[2]; float m[1] = {-1e30f}, l[1] = {0.f};
#pragma unroll
            for (int dt = 0; dt < 2; ++dt)
#pragma unroll
                for (int i = 0; i < 16; ++i) o[0][dt][i] = 0.f;
            flash_pass<false, true, 4, 1>(C, pb + 128, pb + 192, nullptr, 0, qb, qb, -1, qf, o, m, l, 0.125f * LOG2E, tok, sel, hh);
            { const float g1 = 1.0f / (1.0f + __expf(-bf2f(proj[mrow * NPROJ + C_NG + g * 3 + 1]))); const float inv = g1 / (l[0] + __shfl_xor(l[0], 32));
              const float* oc = (const float*)(C.ws + WS_OCMP) + mrow * 256 + g * 64;
#pragma unroll
              for (int dt = 0; dt < 2; ++dt)
#pragma unroll
                  for (int g4 = 0; g4 < 4; ++g4) { const f32x4 cv = *(const f32x4*)(oc + 32 * dt + 8 * g4 + 4 * hh);
#pragma unroll
                      for (int e = 0; e < 4; ++e) { keep[dt][4 * g4 + e] = o[0][dt][4 * g4 + e] * inv + cv[e]; o[0][dt][4 * g4 + e] = 0.f; } } }
            m[0] = -1e30f; l[0] = 0.f;
            const int jlo = qb >= 8 ? qb - 8 : 0;
            flash_pass<false, false, 4, 1>(C, pb + 256, pb + 320, nullptr, jlo, qb, qb, qb >= 8 ? qb - 8 : -1, qf, o, m, l, 0.125f * LOG2E, tok, 0xffffffffu, hh);
            { const float g2 = 1.0f / (1.0f + __expf(-bf2f(proj[mrow * NPROJ + C_NG + g * 3 + 2]))); const float inv = g2 / (l[0] + __shfl_xor(l[0], 32));
#pragma unroll
              for (int dt = 0; dt < 2; ++dt)
#pragma unroll
                  for (int i = 0; i < 16; ++i) keep[dt][i] += o[0][dt][i] * inv; }
            store_row64(mix + mrow * DM + g * 64, keep, hh);
        }
    }
}
constexpr int LDS_BYTES = 147456;
constexpr int N_PHASES = 1 + 13 * DEPTH;

template <class Epi>
DI void run_gemm(const Ctx& C, const bf16_t* A, const bf16_t* Bt, int N, int K, const Epi& E) {
    pg8::Gemm g{A, Bt, MTOK, N, K}; pg8::StaticOrder S; S.init(MTOK, N, C.G, C.bid);
    pg8::gemm_phase<Epi, pg8::StaticOrder, true, true>((LAS unsigned char*)C.lds, g, S, E, C.tid);
}

__global__ void __launch_bounds__(512, 2) mega_fwd(Args args_k) {
    const ARGP ap0 = (ARGP)__builtin_amdgcn_kernarg_segment_ptr();
    extern __shared__ __attribute__((aligned(16))) unsigned char lds_raw[];
    Ctx C; const int wave_s = __builtin_amdgcn_readfirstlane((int)threadIdx.x >> 6); C.wave = wave_s; C.lane = 0; C.tid = 0; C.bid = blockIdx.x; C.G = gridDim.x;
    C.ws = args_k.ws; C.lds = (LAS unsigned char*)lds_raw;
    cg::grid_group grid = cg::this_grid();
#define BST ((volatile LAS unsigned*)(C.lds + 131072 + 256))
    if (threadIdx.x < 2) BST[threadIdx.x] = 0u;
    __syncthreads();
    (void)xcd_barrier_post((unsigned*)(C.ws + WS_CTL) + 4096, BST);
    const int lo = args_k.ph_lo, hi = args_k.ph_hi;
    float* X = args_k.out;
    bf16_t* XB = (bf16_t*)(C.ws + WS_XB); bf16_t* BIG = (bf16_t*)(C.ws + WS_BIG); bf16_t* MIX = (bf16_t*)(C.ws + WS_MIX);
#define PH_BEGIN(k) if (lo <= (k) && (k) < hi) { ARGP args = ap0; asm volatile("" : "+s"(args)); { int l_ = (int)__builtin_amdgcn_mbcnt_hi(~0u, __builtin_amdgcn_mbcnt_lo(~0u, 0u)); asm volatile("" : "+v"(l_)); C.lane = l_; C.tid = wave_s * 64 + l_; }
#define PH_END(k) asm volatile("s_waitcnt vmcnt(0)" ::: "memory"); if ((k) + 1 < hi) { if ((k) == 0) grid.sync(); else { XcdBarrier xb_; xb_.bar = (unsigned*)(C.ws + WS_CTL) + 4096; xb_.x = xb_xcc_id(); xb_.st = BST; xcd_barrier(xb_); } } }
    PH_BEGIN(0) prep_phase(C, args); PH_END(0)
    for (int L = 0; L < DEPTH; ++L) {
        const int pb = 1 + 13 * L;
        unsigned char* wb = C.ws + WS_W + (size_t)L * W_LAYER;
        PH_BEGIN(pb + 0) { pg8::EpiSwiGLU E{BIG, DFFP}; run_gemm(C, L == 0 ? XB : MIX, (const bf16_t*)(wb + W_UP1), NUP, DM, E); } PH_END(pb + 0)
        PH_BEGIN(pb + 1) { pg8::EpiResid E{L == 0 ? args->in[0] : X, X, DN_ALPHA, 0.5f}; run_gemm(C, BIG, (const bf16_t*)(wb + W_DN1), DM, DFFP, E); } PH_END(pb + 1)
        PH_BEGIN(pb + 2) ln_phase(C, X, XB, args->in[2] + (size_t)(L * 3 + 0) * DM, args->in[3] + (size_t)(L * 3 + 0) * DM); PH_END(pb + 2)
        PH_BEGIN(pb + 3) { pg8::EpiBf16 E{BIG, NPROJ}; run_gemm(C, XB, (const bf16_t*)(wb + W_IN), NPROJ, DM, E); } PH_END(pb + 3)
        PH_BEGIN(pb + 4) attn_prep_phase(C, args, L); PH_END(pb + 4)
        PH_BEGIN(pb + 5) cmp_attn_phase(C, L); PH_END(pb + 5)
        PH_BEGIN(pb + 6) attn_phase(C, args, L); PH_END(pb + 6)
        PH_BEGIN(pb + 7) { pg8::EpiResid E{X, X, DN_ALPHA, 1.0f}; run_gemm(C, MIX, (const bf16_t*)(wb + W_OUT), DM, DM, E); } PH_END(pb + 7)
        PH_BEGIN(pb + 8) ln_phase(C, X, XB, args->in[2] + (size_t)(L * 3 + 1) * DM, args->in[3] + (size_t)(L * 3 + 1) * DM); PH_END(pb + 8)
        PH_BEGIN(pb + 9) { pg8::EpiSwiGLU E{BIG, DFFP}; run_gemm(C, XB, (const bf16_t*)(wb + W_UP2), NUP, DM, E); } PH_END(pb + 9)
        PH_BEGIN(pb + 10) { pg8::EpiResid E{X, X, DN_ALPHA, 0.5f}; run_gemm(C, BIG, (const bf16_t*)(wb + W_DN2), DM, DFFP, E); } PH_END(pb + 10)
        PH_BEGIN(pb + 11) { ln_phase(C, X, XB, args->in[2] + (size_t)(L * 3 + 2) * DM, args->in[3] + (size_t)(L * 3 + 2) * DM); __syncthreads();
            pg8::EpiBf16 E{BIG, DM}; run_gemm(C, (const bf16_t*)(C.ws + WS_PB) + (size_t)L * MTOK * PLED, (const bf16_t*)(wb + W_PLEP), DM, PLED, E); } PH_END(pb + 11)
        PH_BEGIN(pb + 12) { pg8::EpiPle E{X, X, MIX, args->in[22] + (size_t)L * DM, BIG}; run_gemm(C, XB, (const bf16_t*)(wb + W_PLEG), DM, DM, E); } PH_END(pb + 12)
    }
}

#ifndef MK_SPLIT
#define MK_SPLIT 0
#endif
extern "C" void kernel_launch(void* const* d_in, const int* in_sizes, int n_in, void* d_out, int out_size, void* d_ws, size_t ws_size, hipStream_t stream) {
    static int grid = 0;
    if (grid == 0) {
        if (n_in != 24 || out_size != MTOK * DM || ws_size < WS_END) { fprintf(stderr, "kernel_launch: unexpected shapes (n_in %d out %d ws %zu)\n", n_in, out_size, ws_size); grid = -1; return; }
        if (hipFuncSetAttribute((const void*)mega_fwd, hipFuncAttributeMaxDynamicSharedMemorySize, LDS_BYTES) != hipSuccess) { fprintf(stderr, "kernel_launch: hipFuncSetAttribute failed\n"); grid = -1; return; }
        int dev = 0, cus = 0, per_cu = 0; hipGetDevice(&dev); hipDeviceGetAttribute(&cus, hipDeviceAttributeMultiprocessorCount, dev);
        hipOccupancyMaxActiveBlocksPerMultiprocessor(&per_cu, (const void*)mega_fwd, 512, LDS_BYTES);
        if (per_cu < 1) { fprintf(stderr, "kernel_launch: occupancy query says %d blocks/CU\n", per_cu); per_cu = 1; }
        (void)hipGetLastError();
        grid = cus;
    }
    if (grid < 0) return;
    hipMemsetAsync((char*)d_ws + WS_CTL, 0, 1 * MiB, stream);
    Args a{};
    for (int i = 0; i < 24; ++i) a.in[i] = (const float*)d_in[i];
    a.out = (float*)d_out; a.ws = (unsigned char*)d_ws;
#if MK_SPLIT
    for (int p = 0; p < N_PHASES; ++p) { a.ph_lo = p; a.ph_hi = p + 1; hipLaunchKernelGGL(mega_fwd, dim3(grid), dim3(512), LDS_BYTES, stream, a); }
#else
    a.ph_lo = 0; a.ph_hi = N_PHASES;
    void* kargs[] = {&a};
    hipError_t e = hipLaunchCooperativeKernel((const void*)mega_fwd, dim3(grid), dim3(512), kargs, LDS_BYTES, stream);
    if (e != hipSuccess) fprintf(stderr, "cooperative launch failed: %s (grid %d)\n", hipGetErrorString(e), grid);
#endif
}
```

```cpp
#include <hip/hip_runtime.h>
#include <hip/hip_cooperative_groups.h>
#include <cstdio>
#include <cstdint>
#include <cmath>
namespace cg = cooperative_groups;

namespace pg8 {
#define PG8_LAS __attribute__((address_space(3)))
typedef unsigned short bf16_t;
typedef short bf16x8 __attribute__((ext_vector_type(8)));
typedef float f32x4 __attribute__((ext_vector_type(4)));
typedef unsigned u32x4 __attribute__((ext_vector_type(4)));
constexpr int BM = 256, BK = 64, HALF = 128, HTB = HALF * BK * 2  , STAGE_BYTES = 8 * HTB, NXCD = 8, WGM = 8;

__host__ __device__ __forceinline__ int lds_byte(int r, int c) { const int st = (r >> 4) * 2 + (c >> 5), rr = r & 15, cc = c & 31, ob = rr * 64 + cc * 2; return st * 1024 + (ob ^ (((ob >> 9) & 1) << 5)); }
__host__ __device__ __forceinline__ void stage_rc(int b, int& R, int& C) { const int st = b / 1024, sb = b % 1024, swz = sb ^ (((sb >> 9) & 1) << 5); R = (st >> 1) * 16 + swz / 64; C = (st & 1) * 32 + (swz % 64) / 2; }
__host__ __device__ __forceinline__ int perm32(int rho) { const int n = rho >> 4, i = rho & 15; return 8 * (i >> 2) + 4 * n + (i & 3); }

struct Unit { int pm, pn; };
struct Gemm { const bf16_t* A; const bf16_t* Bt; int M, N, K; };

struct StaticOrder {
    int nM, nN, nwg, G, c;
    __host__ __device__ void init(int M, int N, int G_, int c_) { nM = M / BM; nN = N / BM; nwg = nM * nN; G = G_; c = c_; }
    __host__ __device__ bool next(int i, Unit& u) const {
        const long L = (long)i * G + c; if (L >= nwg) return false;
        int wgid = (int)L; { const int q = nwg / NXCD, r = nwg % NXCD, xcd = wgid % NXCD, off = wgid / NXCD; wgid = (xcd < r ? xcd * (q + 1) : r * (q + 1) + (xcd - r) * q) + off; }
        const int nig = WGM * nN, gid = wgid / nig, fm = gid * WGM, gsz = (nM - fm) < WGM ? (nM - fm) : WGM;
        u.pm = fm + ((wgid % nig) % gsz); u.pn = (wgid % nig) / gsz; return true;
    }
    __device__ __forceinline__ void a_ready(const Unit&) const {}
    __device__ __forceinline__ void done(const Unit&) const {}
};

__device__ __forceinline__ unsigned cvt_pk_bf16(float lo, float hi) { unsigned r; asm volatile("v_cvt_pk_bf16_f32 %0, %1, %2" : "=v"(r) : "v"(lo), "v"(hi)); return r; }
typedef unsigned u32x2 __attribute__((ext_vector_type(2)));
typedef float f32x2 __attribute__((ext_vector_type(2)));
struct EpiBf16 {
    static constexpr bool PERM = true, AFTER_DRAIN = false;
    bf16_t* O; int ldc;
    __device__ __forceinline__ void operator()(const f32x4 (&acc)[2][2][4][2], const Unit& u, int wr, int wc, int fr, int fq) const {
        const int row0 = u.pm * BM + wr * 64 + fr; const int col0 = u.pn * BM + wc * 32 + 8 * fq;
#pragma unroll
        for (int ai = 0; ai < 2; ++ai)
#pragma unroll
            for (int m = 0; m < 4; ++m) { bf16_t* rowp = O + (size_t)(row0 + ai * HALF + m * 16) * ldc + col0;
#pragma unroll
                for (int bj = 0; bj < 2; ++bj) { const f32x4 v0 = acc[ai][bj][m][0], v1 = acc[ai][bj][m][1];
                    u32x4 w; w.x = cvt_pk_bf16(v0[0], v0[1]); w.y = cvt_pk_bf16(v0[2], v0[3]); w.z = cvt_pk_bf16(v1[0], v1[1]); w.w = cvt_pk_bf16(v1[2], v1[3]);
                    *(u32x4*)(rowp + bj * HALF) = w; } __builtin_amdgcn_sched_barrier(0); }
    }
};
__device__ __forceinline__ float silu_mul(float g, float uu) { return g * uu * __builtin_amdgcn_rcpf(1.0f + __builtin_amdgcn_exp2f(-1.44269504f * g)); }
struct EpiSwiGLU {
    static constexpr bool PERM = true, AFTER_DRAIN = false;
    bf16_t* H; int ldh;
    __device__ __forceinline__ void operator()(const f32x4 (&acc)[2][2][4][2], const Unit& u, int wr, int wc, int fr, int fq) const {
        const int row0 = u.pm * BM + wr * 64 + fr; const int col0 = u.pn * HALF + wc * 32 + 8 * fq;
#pragma unroll
        for (int ai = 0; ai < 2; ++ai)
#pragma unroll
            for (int m = 0; m < 4; ++m) { bf16_t* rowp = H + (size_t)(row0 + ai * HALF + m * 16) * ldh + col0;
                const f32x4 g0 = acc[ai][0][m][0], g1 = acc[ai][0][m][1], u0 = acc[ai][1][m][0], u1 = acc[ai][1][m][1];
                u32x4 w; w.x = cvt_pk_bf16(silu_mul(g0[0], u0[0]), silu_mul(g0[1], u0[1])); w.y = cvt_pk_bf16(silu_mul(g0[2], u0[2]), silu_mul(g0[3], u0[3]));
                w.z = cvt_pk_bf16(silu_mul(g1[0], u1[0]), silu_mul(g1[1], u1[1])); w.w = cvt_pk_bf16(silu_mul(g1[2], u1[2]), silu_mul(g1[3], u1[3]));
                *(u32x4*)rowp = w; __builtin_amdgcn_sched_barrier(0); }
    }
};
struct EpiResid {
    static constexpr bool PERM = false, AFTER_DRAIN = false;
    const float* X; float* Y; float alpha, s; const float* ST; const float* g; const float* b;
    __device__ __forceinline__ void operator()(const f32x4 (&acc)[2][2][4][2], const Unit& u, int wr, int wc, int fr, int fq) const {
        const int col0 = u.pn * BM + wc * 32 + 4 * fq;
#pragma unroll
        for (int ai = 0; ai < 2; ++ai)
#pragma unroll
            for (int m = 0; m < 4; ++m) { const int row = u.pm * BM + ai * HALF + wr * 64 + m * 16 + fr; const size_t off = (size_t)row * 1024 + col0;
                f32x2 st = {0.f, 1.f}; if (ST) st = *(const f32x2*)(ST + 2 * (size_t)row);
#pragma unroll
                for (int bj = 0; bj < 2; ++bj)
#pragma unroll
                    for (int n = 0; n < 2; ++n) { f32x4 xv = *(const f32x4*)(X + off + bj * HALF + n * 16);
                        if (ST) { const f32x4 gv = *(const f32x4*)(g + col0 + bj * HALF + n * 16), bv = *(const f32x4*)(b + col0 + bj * HALF + n * 16); xv = (xv - st[0]) * st[1] * gv + bv; }
                        *(f32x4*)(Y + off + bj * HALF + n * 16) = xv * alpha + acc[ai][bj][m][n] * s; } }
    }
};
struct EpiPle {
    static constexpr bool PERM = false, AFTER_DRAIN = false;
    const float* X; float* OUT; bf16_t* XB; const float* bias; const bf16_t* PP; const float* ST; const float* g; const float* b;
    __device__ __forceinline__ void operator()(const f32x4 (&acc)[2][2][4][2], const Unit& u, int wr, int wc, int fr, int fq) const {
        const int col0 = u.pn * BM + wc * 32 + 4 * fq;
#pragma unroll
        for (int ai = 0; ai < 2; ++ai)
#pragma unroll
            for (int m = 0; m < 4; ++m) { const int row = u.pm * BM + ai * HALF + wr * 64 + m * 16 + fr; const size_t off = (size_t)row * 1024 + col0;
                const f32x2 st = *(const f32x2*)(ST + 2 * (size_t)row);
#pragma unroll
                for (int bj = 0; bj < 2; ++bj)
#pragma unroll
                    for (int n = 0; n < 2; ++n) { const int co = bj * HALF + n * 16;
                        f32x4 xv = *(const f32x4*)(X + off + co); const f32x4 bv = *(const f32x4*)(bias + col0 + co);
                        { const f32x4 gv = *(const f32x4*)(g + col0 + co), lb = *(const f32x4*)(b + col0 + co); xv = (xv - st[0]) * st[1] * gv + lb; }
                        const u32x2 pw = *(const u32x2*)(PP + off + co);
                        f32x4 pv; pv[0] = __uint_as_float(pw.x << 16); pv[1] = __uint_as_float(pw.x & 0xffff0000u); pv[2] = __uint_as_float(pw.y << 16); pv[3] = __uint_as_float(pw.y & 0xffff0000u);
                        f32x4 o;
#pragma unroll
                        for (int e = 0; e < 4; ++e) { const float z = acc[ai][bj][m][n][e] + bv[e]; const float sg = __builtin_amdgcn_rcpf(1.0f + __builtin_amdgcn_exp2f(-1.44269504f * z)); o[e] = xv[e] + sg * pv[e]; }
                        *(f32x4*)(OUT + off + co) = o;
                        u32x2 w; w.x = cvt_pk_bf16(o[0], o[1]); w.y = cvt_pk_bf16(o[2], o[3]); *(u32x2*)(XB + off + co) = w; } }
    }
};
template <class Epi, class Sched, bool ALIGN_EPI = false, bool SP2 = false>
__device__ __forceinline__ void gemm_phase(PG8_LAS unsigned char* lds, const Gemm g, const Sched& S, const Epi& E, const int tid_in) {
    int tid_ = tid_in; asm volatile("" : "+v"(tid_));
    const int tid = tid_, wid = __builtin_amdgcn_readfirstlane(tid >> 6), lane = tid & 63, wr = wid >> 2, wc = wid & 3, fr = lane & 15, fq = lane >> 4;
    const int K = g.K, nt = K / BK;
    unsigned voffA[2], voffB[2];
#pragma unroll
    for (int i = 0; i < 2; ++i) { int R, C; stage_rc(tid * 16 + i * 8192, R, C); const int Rb = Epi::PERM ? ((R & ~31) + perm32(R & 31)) : R;
        voffA[i] = (unsigned)(R * K + C) * 2u; voffB[i] = (unsigned)(Rb * K + C) * 2u; }
    const size_t kstep = (size_t)(BK * 2);
    const size_t hstep = (size_t)HALF * K * 2;
    const size_t tstep = 2 * hstep;
    const unsigned ldsw = (unsigned)wid * 1024u;
    const int aoff = lds_byte(wr * 64 + fr, fq * 8), boff = lds_byte(wc * 32 + fr, fq * 8);
#define PG8_SA(b, h) (((b) * 2 + (h)) * HTB)
#define PG8_SB(b, h) ((4 + (b) * 2 + (h)) * HTB)
#define PG8_STAGE(bufoff, gbase, voff) do { _Pragma("unroll") for (int _i = 0; _i < 2; ++_i) \
        __builtin_amdgcn_global_load_lds((const unsigned*)((const char*)(gbase) + (voff)[_i]), (PG8_LAS unsigned*)(lds + (bufoff) + ldsw + _i * 8192), 16, 0, 0); } while (0)
#define PG8_LDA(dst, b, h) do { _Pragma("unroll") for (int m = 0; m < 4; ++m) _Pragma("unroll") for (int k = 0; k < 2; ++k) dst[m][k] = *(const PG8_LAS bf16x8*)(lds + PG8_SA(b, h) + aoff + m * 2048 + k * 1024); } while (0)
#define PG8_LDB(dst, b, h) do { _Pragma("unroll") for (int n = 0; n < 2; ++n) _Pragma("unroll") for (int k = 0; k < 2; ++k) dst[n][k] = *(const PG8_LAS bf16x8*)(lds + PG8_SB(b, h) + boff + n * 2048 + k * 1024); } while (0)
#define PG8_MMA(ai, bj, At, Bt) do { __builtin_amdgcn_s_setprio(1); _Pragma("unroll") for (int m = 0; m < 4; ++m) _Pragma("unroll") for (int n = 0; n < 2; ++n) _Pragma("unroll") for (int k = 0; k < 2; ++k) \
        acc[ai][bj][m][n] = __builtin_amdgcn_mfma_f32_16x16x32_bf16(Bt[n][k], At[m][k], acc[ai][bj][m][n], 0, 0, 0); __builtin_amdgcn_s_setprio(0); } while (0)
#define PG8_WAIT_V(n) asm volatile("s_waitcnt vmcnt(" #n ")" ::: "memory")
#define PG8_WAIT_L(n) asm volatile("s_waitcnt lgkmcnt(" #n ")" ::: "memory")
#define PG8_BAR __builtin_amdgcn_s_barrier()
#define PG8_SCHED __builtin_amdgcn_sched_barrier(0)
    Unit cur, nxt; int ui = 0;
    if (!S.next(0, cur)) return;
    f32x4 acc[2][2][4][2];
#pragma unroll
    for (int a = 0; a < 2; ++a)
#pragma unroll
        for (int b = 0; b < 2; ++b)
#pragma unroll
            for (int m = 0; m < 4; ++m)
#pragma unroll
                for (int n = 0; n < 2; ++n) acc[a][b][m][n] = (f32x4){0.f, 0.f, 0.f, 0.f};
    bf16x8 At[4][2], B0[2][2], B1[2][2];
    const char* cA = (const char*)g.A + (size_t)cur.pm * tstep; const char* cB = (const char*)g.Bt + (size_t)cur.pn * tstep;
    S.a_ready(cur);
    if constexpr (SP2) {
        PG8_STAGE(PG8_SB(0, 0), cB, voffB); PG8_STAGE(PG8_SB(0, 1), cB + hstep, voffB); PG8_STAGE(PG8_SA(0, 0), cA, voffA); PG8_STAGE(PG8_SA(0, 1), cA + hstep, voffA);
        if (wr == 1) PG8_BAR;
        PG8_WAIT_V(2); PG8_BAR;
        PG8_STAGE(PG8_SB(1, 0), cB + kstep, voffB); PG8_STAGE(PG8_SA(1, 0), cA + kstep, voffA); PG8_STAGE(PG8_SB(1, 1), cB + hstep + kstep, voffB);
        PG8_WAIT_V(6); PG8_BAR;
    } else {
        PG8_STAGE(PG8_SB(0, 0), cB, voffB); PG8_STAGE(PG8_SA(0, 0), cA, voffA); PG8_STAGE(PG8_SB(0, 1), cB + hstep, voffB); PG8_STAGE(PG8_SA(0, 1), cA + hstep, voffA);
        if (wr == 1) PG8_BAR;
        PG8_WAIT_V(4); PG8_BAR;
        PG8_STAGE(PG8_SB(1, 0), cB + kstep, voffB); PG8_STAGE(PG8_SA(1, 0), cA + kstep, voffA); PG8_STAGE(PG8_SB(1, 1), cB + hstep + kstep, voffB);
        PG8_WAIT_V(6); PG8_BAR;
    }
    for (;;) {
        const bool has_next = S.next(ui + 1, nxt);
        const char* nA = has_next ? (const char*)g.A + (size_t)nxt.pm * tstep : cA; const char* nB = has_next ? (const char*)g.Bt + (size_t)nxt.pn * tstep : cB;
        for (int t = 0; t < nt; t += 2) {
            const bool last = (t == nt - 2);
            const char* a1 = cA + (size_t)(t + 1) * kstep;
            const char* a2 = last ? nA : cA + (size_t)(t + 2) * kstep; const char* b2 = last ? nB : cB + (size_t)(t + 2) * kstep;
            const char* a3 = a2 + kstep; const char* b3 = b2 + kstep;
            if (last && has_next) S.a_ready(nxt);
            if constexpr (SP2) {
            PG8_LDB(B0, 0, 0); PG8_LDB(B1, 0, 1); PG8_SCHED; PG8_LDA(At, 0, 0); PG8_STAGE(PG8_SA(1, 1), a1 + hstep, voffA);
            PG8_WAIT_V(8); PG8_WAIT_L(0); PG8_BAR; PG8_MMA(0, 0, At, B0); PG8_MMA(0, 1, At, B1); PG8_BAR; PG8_SCHED;
            PG8_LDA(At, 0, 1); PG8_STAGE(PG8_SB(0, 0), b2, voffB); PG8_STAGE(PG8_SB(0, 1), b2 + hstep, voffB); PG8_STAGE(PG8_SA(0, 0), a2, voffA);
            PG8_WAIT_V(8); PG8_WAIT_L(0); PG8_BAR; PG8_MMA(1, 0, At, B0); PG8_MMA(1, 1, At, B1); PG8_BAR; PG8_SCHED;
            PG8_LDB(B0, 1, 0); PG8_LDB(B1, 1, 1); PG8_SCHED; PG8_LDA(At, 1, 0); PG8_STAGE(PG8_SA(0, 1), a2 + hstep, voffA);
            PG8_WAIT_V(8); PG8_WAIT_L(0); PG8_BAR; PG8_MMA(0, 0, At, B0); PG8_MMA(0, 1, At, B1); PG8_BAR; PG8_SCHED;
            PG8_LDA(At, 1, 1); PG8_STAGE(PG8_SB(1, 0), b3, voffB); PG8_STAGE(PG8_SB(1, 1), b3 + hstep, voffB); PG8_STAGE(PG8_SA(1, 0), a3, voffA);
            PG8_WAIT_V(8); PG8_WAIT_L(0); PG8_BAR; PG8_MMA(1, 0, At, B0); PG8_MMA(1, 1, At, B1); PG8_BAR; PG8_SCHED;
            } else {
            PG8_LDB(B0, 0, 0); PG8_SCHED; PG8_LDA(At, 0, 0); PG8_STAGE(PG8_SA(1, 1), a1 + hstep, voffA);
            PG8_WAIT_L(8); PG8_BAR; PG8_WAIT_L(0); PG8_MMA(0, 0, At, B0); PG8_BAR; PG8_SCHED;
            PG8_LDB(B1, 0, 1); PG8_STAGE(PG8_SB(0, 0), b2, voffB);
            PG8_BAR; PG8_WAIT_L(0); PG8_MMA(0, 1, At, B1); PG8_BAR;
            PG8_LDA(At, 0, 1); PG8_STAGE(PG8_SA(0, 0), a2, voffA);
            PG8_BAR; PG8_WAIT_L(0); PG8_MMA(1, 0, At, B0); PG8_BAR; PG8_SCHED;
            PG8_STAGE(PG8_SB(0, 1), b2 + hstep, voffB);
            PG8_WAIT_V(6); PG8_BAR; PG8_MMA(1, 1, At, B1); PG8_BAR;
            PG8_LDB(B0, 1, 0); PG8_SCHED; PG8_LDA(At, 1, 0); PG8_STAGE(PG8_SA(0, 1), a2 + hstep, voffA);
            PG8_WAIT_L(8); PG8_BAR; PG8_WAIT_L(0); PG8_MMA(0, 0, At, B0); PG8_BAR; PG8_SCHED;
            PG8_LDB(B1, 1, 1); PG8_STAGE(PG8_SB(1, 0), b3, voffB);
            PG8_BAR; PG8_WAIT_L(0); PG8_MMA(0, 1, At, B1); PG8_BAR;
            PG8_LDA(At, 1, 1); PG8_STAGE(PG8_SA(1, 0), a3, voffA);
            PG8_BAR; PG8_WAIT_L(0); PG8_MMA(1, 0, At, B0); PG8_BAR; PG8_SCHED;
            PG8_STAGE(PG8_SB(1, 1), b3 + hstep, voffB);
            PG8_WAIT_V(6); PG8_BAR; PG8_MMA(1, 1, At, B1); PG8_BAR;
            }
        }
        if constexpr (ALIGN_EPI) { if (wr == 0) PG8_BAR; }
        if constexpr (!Epi::AFTER_DRAIN) { E(acc, cur, wr, wc, fr, fq); S.done(cur); }
        if (!has_next) break;
#pragma unroll
        for (int a = 0; a < 2; ++a)
#pragma unroll
            for (int b = 0; b < 2; ++b)
#pragma unroll
                for (int m = 0; m < 4; ++m)
#pragma unroll
                    for (int n = 0; n < 2; ++n) acc[a][b][m][n] = (f32x4){0.f, 0.f, 0.f, 0.f};
        cur = nxt; cA = nA; cB = nB; ++ui;
        if constexpr (ALIGN_EPI) { if (wr == 1) PG8_BAR; }
    }
    PG8_WAIT_V(0);
    if constexpr (!ALIGN_EPI) { if (wr == 0) PG8_BAR; }
    PG8_BAR;
    if constexpr (Epi::AFTER_DRAIN) { E.fused(acc, cur, wr, wc, fr, fq, lds, wid, lane); S.done(cur); }
#undef PG8_SA
#undef PG8_SB
#undef PG8_STAGE
#undef PG8_LDA
#undef PG8_LDB
#undef PG8_MMA
#undef PG8_WAIT_V
#undef PG8_WAIT_L
#undef PG8_BAR
#undef PG8_SCHED
}
}
#define DI __device__ __forceinline__
#define LAS __attribute__((address_space(3)))
typedef unsigned short bf16_t;
typedef short bf16x8 __attribute__((ext_vector_type(8)));
typedef short s16x4 __attribute__((ext_vector_type(4)));
typedef float f32x2 __attribute__((ext_vector_type(2)));
typedef float f32x4 __attribute__((ext_vector_type(4)));
typedef float f32x16 __attribute__((ext_vector_type(16)));
typedef unsigned u32x2 __attribute__((ext_vector_type(2)));
typedef unsigned u32x4 __attribute__((ext_vector_type(4)));
typedef __bf16 bf16x2_t __attribute__((ext_vector_type(2)));

constexpr int DM = 1024, BATCH = 32, SEQ = 2048, DEPTH = 2, MTOK = BATCH * SEQ, DFF = 2752, DFFP = 2816, NUP = 2 * DFFP, NPROJ = 3072, PLED = 256;
constexpr int IN_COLS = 2964;
constexpr int C_NQ = 0, C_NKV = 256, C_DQ = 640, C_DK = 896, C_DV = 1152, C_FQ = 1408, C_FK = 1920, C_FV = 2432, C_NG = 2944, C_FF = 2956;
constexpr float LN_EPS = 1e-5f;
constexpr float DN_ALPHA = 1.41421356237f;
constexpr float LOG2E = 1.44269504089f;

constexpr size_t MiB = 1u << 20;
constexpr size_t WS_CTL = 0;
constexpr size_t WS_TBL = 1 * MiB;
constexpr size_t TB_COS64 = 0, TB_SIN64 = 256 * 1024, TB_COS32 = 512 * 1024, TB_SIN32 = 640 * 1024, TB_CBIAS = 768 * 1024, TB_LAM = 772 * 1024;
constexpr size_t WS_KC = 2 * MiB, WS_VC = 2 * MiB + 512 * 1024;
constexpr size_t WS_SEL = 3 * MiB;
constexpr size_t WS_CKL = 4 * MiB;
constexpr size_t WS_W = 8 * MiB, W_LAYER = 46 * MiB;
constexpr size_t W_UP1 = 0, W_DN1 = 11 * MiB, W_UP2 = W_DN1 + 5632 * 1024, W_DN2 = W_UP2 + 11 * MiB, W_IN = W_DN2 + 5632 * 1024, W_OUT = W_IN + 6 * MiB,
                 W_PLEG = W_OUT + 2 * MiB, W_PLEP = W_PLEG + 2 * MiB, W_K1 = W_PLEP + 512 * 1024, W_V1 = W_K1 + 1 * MiB, W_K2 = W_V1 + 1 * MiB, W_V2 = W_K2 + 32 * 1024;
static_assert(W_V2 + 32 * 1024 <= W_LAYER, "weights fit");
constexpr size_t WS_XB = 100 * MiB;
constexpr size_t WS_PB = 228 * MiB;
constexpr size_t WS_OCMP = 292 * MiB;
constexpr size_t WS_MIX = 356 * MiB;
constexpr size_t WS_BIG = 484 * MiB;
constexpr size_t WS_END = 868 * MiB;
constexpr size_t WS_LNST = 6 * MiB;
constexpr int CW_QUEUE = 64;

DI unsigned pk2(float lo, float hi) { f32x2 v = {lo, hi}; return __builtin_bit_cast(unsigned, __builtin_convertvector(v, bf16x2_t)); }
DI float bf2f(bf16_t h) { return __uint_as_float((unsigned)h << 16); }
DI bf16_t f2bf(float f) { return (bf16_t)(pk2(f, 0.f) & 0xffffu); }
DI float wave_sum(float v) {
#pragma unroll
    for (int o = 1; o < 64; o <<= 1) v += __shfl_xor(v, o);
    return v;
}
DI int crow(int i, int hh) { return (i & 3) + 8 * (i >> 2) + 4 * hh; }
#define MFMA32(a, b, c) __builtin_amdgcn_mfma_f32_32x32x16_bf16((a), (b), (c), 0, 0, 0)
#define MFMA16(a, b, c) __builtin_amdgcn_mfma_f32_16x16x32_bf16((a), (b), (c), 0, 0, 0)
#define LDS_WAIT() asm volatile("s_waitcnt lgkmcnt(0)" ::: "memory")

struct Args {
    const float* in[24]; float* out; unsigned char* ws; int ph_lo, ph_hi;
};
typedef const __attribute__((address_space(4))) Args* ARGP;
struct Ctx {
    int tid, lane, wave, bid, G;
    unsigned char* ws; LAS unsigned char* lds;
};

DI void tr_item(const float* W, int ldn, int Ksrc, int srccol, bf16_t* WT, int ldk, int k0, int nrow0, LAS float* scr, int lane) {
#pragma unroll
    for (int i = 0; i < 32; ++i) { const int kk = 2 * i + (lane >> 5), k = k0 + kk; float v = 0.f; if (srccol >= 0 && k < Ksrc) v = W[(size_t)k * ldn + srccol]; scr[kk * 33 + (lane & 31)] = v; }
    LDS_WAIT();
    const int c = lane & 7;
#pragma unroll
    for (int j = 0; j < 4; ++j) { const int n = (lane >> 3) + 8 * j; const LAS float* s = scr + (8 * c) * 33 + n;
        u32x4 o; o.x = pk2(s[0 * 33], s[1 * 33]); o.y = pk2(s[2 * 33], s[3 * 33]); o.z = pk2(s[4 * 33], s[5 * 33]); o.w = pk2(s[6 * 33], s[7 * 33]);
        *(u32x4*)(WT + (size_t)(nrow0 + n) * ldk + k0 + 8 * c) = o; }
    LDS_WAIT();
}
DI int win_map(int n) { return n < 640 ? n : (n < 2944 ? n + 12 : (n < 2956 ? n - 2944 + 640 : (n < 2964 ? n : -1))); }

DI void prep_phase(const Ctx& C, ARGP a) {
    LAS float* scr = (LAS float*)(C.lds + C.wave * 16384);
    const int gw = C.bid * 8 + C.wave, NGW = C.G * 8, lane = C.lane;
    constexpr int I_UP = 16 * 176, I_DN = 44 * 32, I_IN = 16 * 96, I_SQ = 16 * 32, I_PP = 4 * 32, I_P1 = 32 * 8, I_P2 = 4 * 2;
    constexpr int PER_LAYER = 2 * I_UP + 2 * I_DN + I_IN + 2 * I_SQ + I_PP + 2 * I_P1 + 2 * I_P2;
    for (int it = gw; it < DEPTH * PER_LAYER; it += NGW) {
        const int L = it / PER_LAYER; int r = it % PER_LAYER;
        unsigned char* wb = C.ws + WS_W + (size_t)L * W_LAYER;
        if (r < 2 * I_UP) { const int f = r / I_UP; r %= I_UP; const int kb = r / 176, nb = r % 176; const int n = 32 * nb + (lane & 31);
            const int pn = n >> 8, bj = (n >> 7) & 1, hid = 128 * pn + (n & 127);
            const float* src = a->in[(f ? 7 : 4) + bj] + (size_t)L * DM * DFF;
            tr_item(src, DFF, DM, hid < DFF ? hid : -1, (bf16_t*)(wb + (f ? W_UP2 : W_UP1)), DM, 64 * kb, 32 * nb, scr, lane); continue; }
        r -= 2 * I_UP;
        if (r < 2 * I_DN) { const int f = r / I_DN; r %= I_DN; const int kb = r / 32, nb = r % 32;
            const float* src = a->in[f ? 9 : 6] + (size_t)L * DFF * DM;
            tr_item(src, DM, DFF, 32 * nb + (lane & 31), (bf16_t*)(wb + (f ? W_DN2 : W_DN1)), DFFP, 64 * kb, 32 * nb, scr, lane); continue; }
        r -= 2 * I_DN;
        if (r < I_IN) { const int kb = r / 96, nb = r % 96;
            tr_item(a->in[10] + (size_t)L * DM * IN_COLS, IN_COLS, DM, win_map(32 * nb + (lane & 31)), (bf16_t*)(wb + W_IN), DM, 64 * kb, 32 * nb, scr, lane); continue; }
        r -= I_IN;
        if (r < 2 * I_SQ) { const int f = r / I_SQ; r %= I_SQ; const int kb = r / 32, nb = r % 32;
            tr_item(a->in[f ? 21 : 20] + (size_t)L * DM * DM, DM, DM, 32 * nb + (lane & 31), (bf16_t*)(wb + (f ? W_PLEG : W_OUT)), DM, 64 * kb, 32 * nb, scr, lane); continue; }
        r -= 2 * I_SQ;
        if (r < I_PP) { const int kb = r / 32, nb = r % 32;
            tr_item(a->in[23] + (size_t)L * PLED * DM, DM, PLED, 32 * nb + (lane & 31), (bf16_t*)(wb + W_PLEP), PLED, 64 * kb, 32 * nb, scr, lane); continue; }
        r -= I_PP;
        if (r < 2 * I_P1) { const int f = r / I_P1; r %= I_P1; const int kb = r / 8, nb = r % 8;
            tr_item(a->in[f ? 16 : 14] + (size_t)L * 2048 * 256, 256, 2048, 32 * nb + (lane & 31), (bf16_t*)(wb + (f ? W_V1 : W_K1)), 2048, 64 * kb, 32 * nb, scr, lane); continue; }
        r -= 2 * I_P1;
        { const int f = r / I_P2; r %= I_P2; const int kb = r / 2, nb = r % 2;
            tr_item(a->in[f ? 17 : 15] + (size_t)L * 256 * 64, 64, 256, 32 * nb + (lane & 31), (bf16_t*)(wb + (f ? W_V2 : W_K2)), 256, 64 * kb, 32 * nb, scr, lane); }
    }
    const size_t gt = (size_t)C.bid * 512 + C.tid, NT = (size_t)C.G * 512;
    { const float* x = a->in[0]; bf16_t* xb = (bf16_t*)(C.ws + WS_XB); const float* p = a->in[1]; bf16_t* pb = (bf16_t*)(C.ws + WS_PB);
      constexpr size_t NX = (size_t)MTOK * DM / 8, NP = (size_t)DEPTH * MTOK * PLED / 8;
      for (size_t i0 = gt; i0 < NX + NP; i0 += 4 * NT) { f32x4 v[4][2];
#pragma unroll
          for (int q = 0; q < 4; ++q) { size_t i = i0 + q * NT; if (i >= NX + NP) i = gt; const float* src = i < NX ? x + i * 8 : p + (i - NX) * 8; v[q][0] = *(const f32x4*)src; v[q][1] = *(const f32x4*)(src + 4); }
#pragma unroll
          for (int q = 0; q < 4; ++q) { size_t i = i0 + q * NT; if (i >= NX + NP) i = gt; bf16_t* dst = i < NX ? xb + i * 8 : pb + (i - NX) * 8;
              u32x4 o; o.x = pk2(v[q][0][0], v[q][0][1]); o.y = pk2(v[q][0][2], v[q][0][3]); o.z = pk2(v[q][1][0], v[q][1][1]); o.w = pk2(v[q][1][2], v[q][1][3]); *(u32x4*)dst = o; } } }
    { float* tb = (float*)(C.ws + WS_TBL);
      for (size_t i = gt; i < (size_t)SEQ * 48; i += NT) {
          int pos, k; float inv; const bool big = i < (size_t)SEQ * 32; size_t j;
          if (big) { j = i; pos = (int)(i >> 5); k = (int)(i & 31); inv = exp2f(-(float)k * (13.2877123795f / 32.0f)); }
          else { j = i - (size_t)SEQ * 32; pos = (int)(j >> 4); k = (int)(j & 15); inv = exp2f(-(float)k * (13.2877123795f / 16.0f)); }
          const float ang = (float)pos * inv; double rv = (double)ang * 0.15915494309189535; rv -= floor(rv); const float fr = (float)rv;
          const float cs = __builtin_amdgcn_cosf(fr), sn = __builtin_amdgcn_sinf(fr);
          if (big) { tb[TB_COS64 / 4 + j] = cs; tb[TB_SIN64 / 4 + j] = sn; } else { tb[TB_COS32 / 4 + j] = cs; tb[TB_SIN32 / 4 + j] = sn; } } }
    { float* cb = (float*)(C.ws + WS_TBL + TB_CBIAS);
      for (int o = gw; o < DEPTH * 2 * 256; o += NGW) { const int L = o >> 9, kv = (o >> 8) & 1, n = o & 255;
          const float* pe = a->in[kv ? 13 : 12] + (size_t)L * 2048; const float* w1 = a->in[kv ? 16 : 14] + (size_t)L * 2048 * 256;
          float s = 0.f; for (int k = lane; k < 2048; k += 64) s += pe[k] * w1[(size_t)k * 256 + n];
          s = wave_sum(s); if (lane == 0) cb[o] = s; } }
    if (C.bid == 0 && C.tid < DEPTH) { const int L = C.tid; const float* lp = a->in[18] + L * 128; float s1 = 0.f, s2 = 0.f;
        for (int k = 0; k < 32; ++k) { s1 += lp[k] * lp[32 + k]; s2 += lp[64 + k] * lp[96 + k]; }
        const float li = 0.8f - 0.6f * expf(-0.3f * (float)L);
        ((float*)(C.ws + WS_TBL + TB_LAM))[L] = expf(s1) - expf(s2) + li; }
}

DI void ln_phase(const Ctx& C, const float* X, bf16_t* XB, const float* g, const float* b) {
    const int gw = C.bid * 8 + C.wave, NGW = C.G * 8, lane = C.lane;
    f32x4 gv[4], bv[4];
#pragma unroll
    for (int j = 0; j < 4; ++j) { gv[j] = *(const f32x4*)(g + 4 * lane + 256 * j); bv[j] = *(const f32x4*)(b + 4 * lane + 256 * j); }
    for (int m = gw; m < MTOK; m += NGW) {
        const float* xr = X + (size_t)m * DM + 4 * lane; f32x4 v[4]; float s = 0.f;
#pragma unroll
        for (int j = 0; j < 4; ++j) { v[j] = *(const f32x4*)(xr + 256 * j); s += (v[j][0] + v[j][1]) + (v[j][2] + v[j][3]); }
        const float mean = wave_sum(s) * (1.f / DM); float s2 = 0.f;
#pragma unroll
        for (int j = 0; j < 4; ++j) { v[j] = v[j] - mean; s2 += (v[j][0] * v[j][0] + v[j][1] * v[j][1]) + (v[j][2] * v[j][2] + v[j][3] * v[j][3]); }
        const float rstd = 1.0f / sqrtf(wave_sum(s2) * (1.f / DM) + LN_EPS);
        bf16_t* xo = XB + (size_t)m * DM + 4 * lane;
#pragma unroll
        for (int j = 0; j < 4; ++j) { const f32x4 o = v[j] * rstd * gv[j] + bv[j];
            u32x2 w; w.x = pk2(o[0], o[1]); w.y = pk2(o[2], o[3]); *(u32x2*)(xo + 256 * j) = w; }
        if (lane == 0) { f32x2 st; st[0] = mean; st[1] = rstd; *(f32x2*)((float*)(C.ws + WS_LNST) + 2 * (size_t)m) = st; }
    }
}
#define XLAS __attribute__((address_space(3)))
#define XB_TMO      128
#define XB_XCNT(j)  (256  + 64 * (j))
#define XB_XSUB(j)  (1280 + 64 * (j))
#define XB_XGEN(j)  (2304 + 64 * (j))
#define XB_TOP      3328
#define XB_TOPGEN   3392
#define XCD_BAR_WORDS 3456
#define XB_SPIN_CAP (1u << 18)

__device__ __forceinline__ unsigned xb_ld(unsigned* p)              { return __hip_atomic_load(p, __ATOMIC_RELAXED, __HIP_MEMORY_SCOPE_AGENT); }
__device__ __forceinline__ unsigned xb_add(unsigned* p, unsigned v) { return __hip_atomic_fetch_add(p, v, __ATOMIC_RELAXED, __HIP_MEMORY_SCOPE_AGENT); }
__device__ __forceinline__ unsigned xb_xcc_id() { return (unsigned)__builtin_amdgcn_s_getreg((3 << 11) | 20) & 0xFu; }
#define XB_SPIN(cond, bar) do { unsigned _sp = 0; while (cond) { __builtin_amdgcn_s_sleep(1); \
    if ((++_sp & 255u) == 0u) { if (xb_ld(&(bar)[XB_TMO])) break; if (_sp > XB_SPIN_CAP) { atomicAdd(&(bar)[XB_TMO], 1u); break; } } } } while (0)

struct XcdBarrier {
    unsigned* bar; unsigned x;
    volatile XLAS unsigned* st;
};

__device__ __forceinline__ XcdBarrier xcd_barrier_post(unsigned* bar, volatile XLAS unsigned* st) {
    XcdBarrier b; b.bar = bar; b.x = xb_xcc_id(); b.st = st;
    if (threadIdx.x == 0) (void)xb_add(&bar[XB_XCNT(b.x)], 1u);
    return b;
}
__device__ __forceinline__ void xcd_barrier_complete(unsigned* bar, unsigned x, unsigned& nloc, unsigned& nx) {
    const unsigned G = gridDim.x * gridDim.y * gridDim.z;
    unsigned sum, cnt, mine, sp = 0u;
    for (;;) {
        sum = 0u; cnt = 0u; mine = 0u;
#pragma unroll
        for (unsigned j = 0; j < 16; ++j) { const unsigned c = xb_ld(&bar[XB_XCNT(j)]); sum += c; cnt += (c > 0u) ? 1u : 0u; mine = (j == x) ? c : mine; }
        if (sum == G) break;
        __builtin_amdgcn_s_sleep(1);
        if ((++sp & 255u) == 0u) { if (xb_ld(&bar[XB_TMO])) break; if (sp > XB_SPIN_CAP) { atomicAdd(&bar[XB_TMO], 1u); break; } }
    }
    nloc = mine > 0u ? mine : 1u; nx = cnt > 0u ? cnt : 1u;
}

__device__ __forceinline__ void xcd_barrier(const XcdBarrier& b) {
    asm volatile("s_waitcnt vmcnt(0)" ::: "memory");
    __syncthreads();
    if (threadIdx.x == 0) {
        unsigned* bar = b.bar;
        __builtin_amdgcn_s_waitcnt(0);
        unsigned nloc = b.st[0], nx = b.st[1];
        if (nloc == 0u) { xcd_barrier_complete(bar, b.x, nloc, nx); b.st[0] = nloc; b.st[1] = nx; }
        const unsigned old = xb_add(&bar[XB_XSUB(b.x)], 1u);
        const unsigned gen = old / nloc;
        if (old + 1u == (gen + 1u) * nloc) {
            __builtin_amdgcn_fence(__ATOMIC_RELEASE, "agent");
            asm volatile("s_waitcnt vmcnt(0)" ::: "memory");
            const unsigned og = xb_add(&bar[XB_TOP], 1u);
            const unsigned tg = og / nx;
            if (og + 1u == (tg + 1u) * nx) xb_add(&bar[XB_TOPGEN], 1u);
            else XB_SPIN(xb_ld(&bar[XB_TOPGEN]) == tg, bar);
            __builtin_amdgcn_fence(__ATOMIC_ACQUIRE, "agent");
            xb_add(&bar[XB_XGEN(b.x)], 1u);
            asm volatile("s_waitcnt vmcnt(0)" ::: "memory");
        } else {
            XB_SPIN(xb_ld(&bar[XB_XGEN(b.x)]) == gen, bar);
            __builtin_amdgcn_fence(__ATOMIC_ACQUIRE, "agent");
            asm volatile("s_waitcnt vmcnt(0)" ::: "memory");
        }
    }
    __syncthreads();
}
DI float gelu_tanh(float x) { const float z = 0.7978845608f * (x + 0.044715f * x * x * x); const float e = __builtin_amdgcn_exp2f(2.0f * LOG2E * z); return 0.5f * x * (2.0f - 2.0f * __builtin_amdgcn_rcpf(e + 1.0f)); }

DI void cmp_mlp_unit(const Ctx& C, const bf16_t* proj, int b, int cgp, int kv, const bf16_t* W1t, const bf16_t* W2t, const float* bias, bf16_t* outp, const float* cos64, const float* sin64) {
    constexpr int SP = 72, HP = 264;
    LAS bf16_t* span = (LAS bf16_t*)C.lds;
    LAS bf16_t* Hs = (LAS bf16_t*)(C.lds + 528 * SP * 2);
    LAS float* Os = (LAS float*)(C.lds + 528 * SP * 2 + 32 * HP * 2);
    const int tid = C.tid, lane = C.lane, w = C.wave, row16 = lane & 15, quad = lane >> 4;
    const int t0 = 512 * cgp;
    for (int idx = tid; idx < 528 * 8; idx += 512) { const int tr = idx >> 3, ch = idx & 7, t = t0 + tr; u32x4 v = {0u, 0u, 0u, 0u};
        if (t < SEQ) v = *(const u32x4*)(proj + (size_t)(b * SEQ + t) * NPROJ + C_NKV + kv * 64 + ch * 8);
        *(LAS u32x4*)(span + tr * SP + ch * 8) = v; }
    __syncthreads();
    f32x4 acc[2][2];
#pragma unroll
    for (int i = 0; i < 2; ++i)
#pragma unroll
        for (int j = 0; j < 2; ++j) acc[i][j] = (f32x4){0.f, 0.f, 0.f, 0.f};
    const bf16_t* wb0 = W1t + (size_t)(32 * w + row16) * 2048 + quad * 8;
#pragma unroll 4
    for (int ks = 0; ks < 64; ++ks) { const int l = ks >> 1, dq = ks & 1, k0 = l * 64 + 32 * dq;
        const bf16x8 b0 = *(const bf16x8*)(wb0 + k0), b1 = *(const bf16x8*)(wb0 + 16 * 2048 + k0);
        const bf16x8 a0 = *(const LAS bf16x8*)(span + (16 * row16 + l) * SP + 32 * dq + quad * 8);
        const bf16x8 a1 = *(const LAS bf16x8*)(span + (16 * (16 + row16) + l) * SP + 32 * dq + quad * 8);
        acc[0][0] = MFMA16(a0, b0, acc[0][0]); acc[0][1] = MFMA16(a0, b1, acc[0][1]); acc[1][0] = MFMA16(a1, b0, acc[1][0]); acc[1][1] = MFMA16(a1, b1, acc[1][1]); }
#pragma unroll
    for (int mi = 0; mi < 2; ++mi)
#pragma unroll
        for (int ni = 0; ni < 2; ++ni) { const int n = 32 * w + 16 * ni + row16; const float bs = bias[n];
#pragma unroll
            for (int j = 0; j < 4; ++j) Hs[(16 * mi + quad * 4 + j) * HP + n] = f2bf(gelu_tanh(acc[mi][ni][j] + bs)); }
    __syncthreads();
    { const int mt = w >> 2, nt = w & 3; f32x4 a2 = {0.f, 0.f, 0.f, 0.f};
#pragma unroll
      for (int ks = 0; ks < 8; ++ks) { const bf16x8 av = *(const LAS bf16x8*)(Hs + (16 * mt + row16) * HP + 32 * ks + quad * 8);
          const bf16x8 bv = *(const bf16x8*)(W2t + (size_t)(16 * nt + row16) * 256 + 32 * ks + quad * 8); a2 = MFMA16(av, bv, a2); }
#pragma unroll
      for (int j = 0; j < 4; ++j) Os[(16 * mt + quad * 4 + j) * 64 + 16 * nt + row16] = a2[j]; }
    __syncthreads();
    { const int c = tid >> 4, cglob = 32 * cgp + c; bf16_t* op = outp + (size_t)(b * 128 + cglob) * 64;
#pragma unroll
      for (int e = 0; e < 2; ++e) { const int i = (tid & 15) * 2 + e; float x1 = Os[c * 64 + i], x2 = Os[c * 64 + i + 32];
          if (cglob >= 127) { x1 = 0.f; x2 = 0.f; }
          else if (kv == 0) { const int pos = 16 * cglob + 31; const float cs = cos64[pos * 32 + i], sn = sin64[pos * 32 + i]; const float y1 = x1 * cs - x2 * sn, y2 = x2 * cs + x1 * sn; x1 = y1; x2 = y2; }
          op[i] = f2bf(x1); op[i + 32] = f2bf(x2); } }
    __syncthreads();
}

DI void attn_prep_phase(const Ctx& C, ARGP a, int L) {
    bf16_t* proj = (bf16_t*)(C.ws + WS_BIG);
    const float* tb = (const float*)(C.ws + WS_TBL);
    const float* cos64 = tb + TB_COS64 / 4; const float* sin64 = tb + TB_SIN64 / 4; const float* cos32 = tb + TB_COS32 / 4; const float* sin32 = tb + TB_SIN32 / 4;
    unsigned char* wb = C.ws + WS_W + (size_t)L * W_LAYER;
    for (int u = C.bid; u < BATCH * 4 * 2; u += C.G) { const int kv = u & 1, cgp = (u >> 1) & 3, b = u >> 3;
        cmp_mlp_unit(C, proj, b, cgp, kv, (const bf16_t*)(wb + (kv ? W_V1 : W_K1)), (const bf16_t*)(wb + (kv ? W_V2 : W_K2)),
                     (const float*)(C.ws + WS_TBL + TB_CBIAS) + (L * 2 + kv) * 256, (bf16_t*)(C.ws + (kv ? WS_VC : WS_KC)), cos64, sin64); }
    const int gw = C.bid * 8 + C.wave, NGW = C.G * 8, lane = C.lane;
    for (int m = gw; m < MTOK; m += NGW) { const int pos = m & (SEQ - 1); bf16_t* row = proj + (size_t)m * NPROJ;
#pragma unroll
        for (int k = 0; k < 7; ++k) { const int pi = lane + 64 * k; int c0, half; float cs, sn;
            if (pi < 192) { int i; if (pi < 128) { c0 = C_NQ + (pi >> 5) * 64; i = pi & 31; } else if (pi < 160) { c0 = C_NKV + 128; i = pi - 128; } else { c0 = C_NKV + 256; i = pi - 160; }
                c0 += i; half = 32; cs = cos64[pos * 32 + i]; sn = sin64[pos * 32 + i]; }
            else { const int q = pi - 192; const int s = (q >> 4) & 7, i = q & 15; c0 = (q < 128 ? C_DQ : C_DK) + 32 * s + i; half = 16; cs = cos32[pos * 16 + i]; sn = sin32[pos * 16 + i]; }
            const float x1 = bf2f(row[c0]), x2 = bf2f(row[c0 + half]);
            row[c0] = f2bf(x1 * cs - x2 * sn); row[c0 + half] = f2bf(x2 * cs + x1 * sn); } }
    for (int u = gw; u < BATCH * 8; u += NGW) { const int b = u >> 3, h = u & 7; const float bf = a->in[11][L * 8 + h];
        float* ck = (float*)(C.ws + WS_CKL) + (size_t)u * SEQ + lane * 32; const bf16_t* fp = proj + (size_t)(b * SEQ + lane * 32) * NPROJ + C_FF + h;
        float run = 0.f; float loc[32];
#pragma unroll
        for (int i = 0; i < 32; ++i) { const float x = bf2f(fp[(size_t)i * NPROJ]) + bf; const float ls = fminf(x, 0.f) - log1pf(expf(-fabsf(x))); run += ls; loc[i] = run; }
        float incl = run;
#pragma unroll
        for (int o = 1; o < 64; o <<= 1) { const float t = __shfl_up(incl, o); if (lane >= o) incl += t; }
        const float base = incl - run;
#pragma unroll
        for (int i = 0; i < 32; ++i) ck[i] = (base + loc[i]) * LOG2E; }
}

constexpr int KP = 72;
DI void cmp_attn_phase(const Ctx& C, int L) {
    const bf16_t* proj = (const bf16_t*)(C.ws + WS_BIG);
    LAS bf16_t* Ks = (LAS bf16_t*)C.lds;
    LAS bf16_t* Vs = (LAS bf16_t*)(C.lds + 128 * KP * 2);
    LAS float* Ps = (LAS float*)(C.lds + 2 * 128 * KP * 2 + C.wave * 5120);
    LAS float* Sc = Ps + 8 * 128;
    const int tid = C.tid, lane = C.lane, w = C.wave, r = lane & 31, hh = lane >> 5;
    const float c1 = 0.125f * LOG2E;
    for (int ug = C.bid; ug < BATCH * 8; ug += C.G) {
        const int b = ug >> 3;
        __syncthreads();
        for (int idx = tid; idx < 128 * 8 * 2; idx += 512) { const int kvs = idx >> 10, rem = idx & 1023, c = rem >> 3, ch = rem & 7;
            const u32x4 v = *(const u32x4*)((const bf16_t*)(C.ws + (kvs ? WS_VC : WS_KC)) + (size_t)(b * 128 + c) * 64 + ch * 8);
            *(LAS u32x4*)((kvs ? Vs : Ks) + c * KP + ch * 8) = v; }
        __syncthreads();
        for (int uu = 0; uu < 4; ++uu) {
            const int t0 = ((ug & 7) * 4 + uu) * 64; const int tok = t0 + 8 * w + (r >> 2), g = r & 3; const size_t m = (size_t)b * SEQ + tok;
            bf16x8 qf[4];
#pragma unroll
            for (int s = 0; s < 4; ++s) qf[s] = *(const bf16x8*)(proj + m * NPROJ + C_NQ + g * 64 + 16 * s + 8 * hh);
            f32x16 p[4];
#pragma unroll
            for (int kt = 0; kt < 4; ++kt) { f32x16 acc;
#pragma unroll
                for (int i = 0; i < 16; ++i) acc[i] = 0.f;
#pragma unroll
                for (int s = 0; s < 4; ++s) { const bf16x8 kf = *(const LAS bf16x8*)(Ks + (32 * kt + r) * KP + 16 * s + 8 * hh); acc = MFMA32(kf, qf[s], acc); }
                p[kt] = acc; }
            float mx = -1e30f; const int climh = ((tok - 31) >> 4) - 4 * hh;
#pragma unroll
            for (int kt = 0; kt < 4; ++kt)
#pragma unroll
                for (int i = 0; i < 16; ++i) { const bool ok = (32 * kt + (i & 3) + 8 * (i >> 2)) <= climh; p[kt][i] = ok ? p[kt][i] : -INFINITY; mx = fmaxf(mx, p[kt][i]); }
            mx = fmaxf(mx, __shfl_xor(mx, 32));
            float sum = 0.f; const float off = mx * c1;
#pragma unroll
            for (int kt = 0; kt < 4; ++kt)
#pragma unroll
                for (int i = 0; i < 16; ++i) { const float e = __builtin_amdgcn_exp2f(p[kt][i] * c1 - off); p[kt][i] = e; sum += e; }
            sum += __shfl_xor(sum, 32);
            const float inv = (tok >= 31) ? 1.0f / sum : 0.f;
#pragma unroll
            for (int kt = 0; kt < 4; ++kt)
#pragma unroll
                for (int i = 0; i < 16; ++i) p[kt][i] *= inv;
            __builtin_amdgcn_sched_barrier(0);
            f32x16 o[2];
#pragma unroll
            for (int dt = 0; dt < 2; ++dt)
#pragma unroll
                for (int i = 0; i < 16; ++i) o[dt][i] = 0.f;
            const int i16 = lane & 15, q4 = i16 >> 2, pp = i16 & 3, blk = (lane >> 4) & 1;
            const LAS bf16_t* vb = Vs + (4 * hh + q4) * KP + 16 * blk + 4 * pp;
#pragma unroll
            for (int kt = 0; kt < 4; ++kt)
#pragma unroll
                for (int s = 0; s < 2; ++s) { u32x4 pw; pw.x = pk2(p[kt][8 * s], p[kt][8 * s + 1]); pw.y = pk2(p[kt][8 * s + 2], p[kt][8 * s + 3]); pw.z = pk2(p[kt][8 * s + 4], p[kt][8 * s + 5]); pw.w = pk2(p[kt][8 * s + 6], p[kt][8 * s + 7]);
                    const bf16x8 pf = __builtin_bit_cast(bf16x8, pw);
#pragma unroll
                    for (int dt = 0; dt < 2; ++dt) { const s16x4 lo = __builtin_amdgcn_ds_read_tr16_b64_v4i16((LAS s16x4*)(vb + (32 * kt + 16 * s) * KP + 32 * dt));
                        const s16x4 hi = __builtin_amdgcn_ds_read_tr16_b64_v4i16((LAS s16x4*)(vb + (32 * kt + 16 * s + 8) * KP + 32 * dt));
                        const bf16x8 vf = __builtin_shufflevector(lo, hi, 0, 1, 2, 3, 4, 5, 6, 7); o[dt] = MFMA32(vf, pf, o[dt]); } __builtin_amdgcn_sched_barrier(0); }
            __builtin_amdgcn_sched_barrier(0);
            { const float gl = bf2f(proj[m * NPROJ + C_NG + g * 3 + 0]); const float gate = 1.0f / (1.0f + __expf(-gl));
              float* op = (float*)(C.ws + WS_OCMP) + m * 256 + g * 64;
#pragma unroll
              for (int dt = 0; dt < 2; ++dt)
#pragma unroll
                  for (int g4 = 0; g4 < 4; ++g4) { f32x4 v; v[0] = o[dt][4 * g4] * gate; v[1] = o[dt][4 * g4 + 1] * gate; v[2] = o[dt][4 * g4 + 2] * gate; v[3] = o[dt][4 * g4 + 3] * gate;
                      *(f32x4*)(op + 32 * dt + 8 * g4 + 4 * hh) = v; } }
            __builtin_amdgcn_sched_barrier(0);
#pragma unroll
            for (int kt = 0; kt < 4; ++kt)
#pragma unroll
                for (int i = 0; i < 16; ++i) { float v = p[kt][i]; v += __shfl_xor(v, 1); v += __shfl_xor(v, 2); p[kt][i] = v; }
            __builtin_amdgcn_sched_barrier(0);
            if (g == 0) {
#pragma unroll
                for (int kt = 0; kt < 4; ++kt)
#pragma unroll
                    for (int g4 = 0; g4 < 4; ++g4) { f32x4 v; v[0] = p[kt][4 * g4]; v[1] = p[kt][4 * g4 + 1]; v[2] = p[kt][4 * g4 + 2]; v[3] = p[kt][4 * g4 + 3];
                        *(LAS f32x4*)(Ps + (r >> 2) * 128 + 32 * kt + 8 * g4 + 4 * hh) = v; } }
            LDS_WAIT();
            { const int tk = lane >> 3, jg = lane & 7; const int t = t0 + 8 * w + tk; const int blk_t = t >> 6;
              float sc[4];
#pragma unroll
              for (int jj = 0; jj < 4; ++jj) { const int j = 4 * jg + jj; float imp = 0.f;
#pragma unroll
                  for (int cc = -1; cc < 4; ++cc) { const int c = 4 * j + cc; if (c >= 0) imp += Ps[tk * 128 + c]; }
                  const bool forced = (j == 0) || (j == blk_t) || (j == blk_t - 1); const bool valid = (j * 64) <= t;
                  sc[jj] = forced ? 1e9f : (valid ? imp : -1.0f); Sc[tk * 32 + j] = sc[jj]; }
              LDS_WAIT();
              unsigned bits = 0u;
#pragma unroll
              for (int jj = 0; jj < 4; ++jj) { const int j = 4 * jg + jj; int cnt = 0;
                  for (int j2 = 0; j2 < 32; ++j2) { const float o2 = Sc[tk * 32 + j2]; cnt += (o2 > sc[jj] || (o2 == sc[jj] && j2 < j)) ? 1 : 0; }
                  if (cnt < 16) bits |= 1u << j; }
              bits |= __shfl_xor(bits, 1); bits |= __shfl_xor(bits, 2); bits |= __shfl_xor(bits, 4);
              if (jg == 0) ((unsigned*)(C.ws + WS_SEL))[(size_t)b * SEQ + t] = bits; }
            LDS_WAIT();
        }
    }
}
constexpr int AT_KBUF = 64 * KP * 2;
constexpr int AT_K0 = 0, AT_V0 = 2 * AT_KBUF, AT_C0 = 4 * AT_KBUF, AT_MISC = AT_C0 + 2 * 256;

template <bool BIAS, bool SEL, int NS>
DI void tile_step(const LAS bf16_t* Kl, const LAS bf16_t* Vl, const LAS float* Cl, const bf16x8 (&qf)[NS], f32x16 (&o)[2], float& m, float& l,
                  const float c1, const int mmode, const int key0, const int trow, const bool kill, const int hh) {
    f32x16 p[2];
#pragma unroll
    for (int kt = 0; kt < 2; ++kt) { f32x16 acc;
#pragma unroll
        for (int i = 0; i < 16; ++i) acc[i] = 0.f;
#pragma unroll
        for (int s = 0; s < NS; ++s) { const bf16x8 kf = *(const LAS bf16x8*)(Kl + 32 * kt * KP + 16 * s); acc = MFMA32(kf, qf[s], acc); }
        p[kt] = acc; }
    if (BIAS) {
        const f32x2 c1v = {c1, c1};
#pragma unroll
        for (int kt = 0; kt < 2; ++kt)
#pragma unroll
            for (int g4 = 0; g4 < 4; ++g4) { const f32x4 cv = *(const LAS f32x4*)(Cl + 32 * kt + 8 * g4);
                f32x2 a0 = {p[kt][4 * g4], p[kt][4 * g4 + 1]}, a1 = {p[kt][4 * g4 + 2], p[kt][4 * g4 + 3]};
                a0 = a0 * c1v - (f32x2){cv[0], cv[1]}; a1 = a1 * c1v - (f32x2){cv[2], cv[3]};
                p[kt][4 * g4] = a0[0]; p[kt][4 * g4 + 1] = a0[1]; p[kt][4 * g4 + 2] = a1[0]; p[kt][4 * g4 + 3] = a1[1]; }
    }
    const int lim = trow - key0 - 4 * hh;
    if (mmode == 1) {
#pragma unroll
        for (int kt = 0; kt < 2; ++kt)
#pragma unroll
            for (int i = 0; i < 16; ++i) p[kt][i] = ((32 * kt + (i & 3) + 8 * (i >> 2)) > lim) ? -INFINITY : p[kt][i];
    } else if (mmode == 2) {
#pragma unroll
        for (int kt = 0; kt < 2; ++kt)
#pragma unroll
            for (int i = 0; i < 16; ++i) p[kt][i] = ((32 * kt + (i & 3) + 8 * (i >> 2)) <= lim - 512) ? -INFINITY : p[kt][i];
    }
    if (SEL) { if (kill) {
#pragma unroll
        for (int kt = 0; kt < 2; ++kt)
#pragma unroll
            for (int i = 0; i < 16; ++i) p[kt][i] = -INFINITY; } }
    float mx = p[0][0];
#pragma unroll
    for (int kt = 0; kt < 2; ++kt)
#pragma unroll
        for (int i = 0; i < 16; ++i) mx = fmaxf(mx, p[kt][i]);
    mx = fmaxf(mx, __shfl_xor(mx, 32));
    const float mn = fmaxf(m, mx);
    float alpha, off, sc;
    if (BIAS) { alpha = __builtin_amdgcn_exp2f(m - mn); off = mn; sc = 1.0f; } else { alpha = __builtin_amdgcn_exp2f((m - mn) * c1); off = mn * c1; sc = c1; }
    m = mn;
    f32x2 rs2 = {0.f, 0.f}; const f32x2 scv = {sc, sc}, offv = {off, off};
#pragma unroll
    for (int kt = 0; kt < 2; ++kt)
#pragma unroll
        for (int i = 0; i < 16; i += 2) { f32x2 a = {p[kt][i], p[kt][i + 1]}; a = a * scv - offv; f32x2 e; e[0] = __builtin_amdgcn_exp2f(a[0]); e[1] = __builtin_amdgcn_exp2f(a[1]);
            p[kt][i] = e[0]; p[kt][i + 1] = e[1]; rs2 += e; }
    l = l * alpha + (rs2[0] + rs2[1]);
    const f32x2 av = {alpha, alpha};
#pragma unroll
    for (int dt = 0; dt < 2; ++dt)
#pragma unroll
        for (int i = 0; i < 16; i += 2) { f32x2 a = {o[dt][i], o[dt][i + 1]}; a = a * av; o[dt][i] = a[0]; o[dt][i + 1] = a[1]; }
#pragma unroll
    for (int kt = 0; kt < 2; ++kt)
#pragma unroll
        for (int s = 0; s < 2; ++s) { u32x4 pw; pw.x = pk2(p[kt][8 * s], p[kt][8 * s + 1]); pw.y = pk2(p[kt][8 * s + 2], p[kt][8 * s + 3]); pw.z = pk2(p[kt][8 * s + 4], p[kt][8 * s + 5]); pw.w = pk2(p[kt][8 * s + 6], p[kt][8 * s + 7]);
            const bf16x8 pf = __builtin_bit_cast(bf16x8, pw);
#pragma unroll
            for (int dt = 0; dt < 2; ++dt) { const s16x4 lo = __builtin_amdgcn_ds_read_tr16_b64_v4i16((LAS s16x4*)(Vl + (32 * kt + 16 * s) * KP + 32 * dt));
                const s16x4 hi = __builtin_amdgcn_ds_read_tr16_b64_v4i16((LAS s16x4*)(Vl + (32 * kt + 16 * s + 8) * KP + 32 * dt));
                const bf16x8 vf = __builtin_shufflevector(lo, hi, 0, 1, 2, 3, 4, 5, 6, 7); o[dt] = MFMA32(vf, pf, o[dt]); } }
}

struct TileRegs { u32x4 k, v; float c; };
template <bool BIAS>
DI void tile_gload(TileRegs& R, const bf16_t* kbase, const bf16_t* vbase, const float* cbase, int key0, int tid) {
    const size_t off = (size_t)(key0 + (tid >> 3)) * NPROJ + (tid & 7) * 8;
    R.k = *(const u32x4*)(kbase + off); R.v = *(const u32x4*)(vbase + off);
    if (BIAS) { if (tid < 64) R.c = cbase[key0 + tid]; }
}
template <bool BIAS>
DI void tile_lstore(const TileRegs& R, LAS unsigned char* lds, int buf, int tid) {
    const int o = ((tid >> 3) * KP + (tid & 7) * 8) * 2;
    *(LAS u32x4*)(lds + AT_K0 + buf * AT_KBUF + o) = R.k; *(LAS u32x4*)(lds + AT_V0 + buf * AT_KBUF + o) = R.v;
    if (BIAS) { if (tid < 64) *(LAS float*)(lds + AT_C0 + buf * 256 + tid * 4) = R.c; }
}

template <bool BIAS, bool SEL, int NS, int NMAP>
DI void flash_pass(const Ctx& C, const bf16_t* kbase, const bf16_t* vbase, const float* cbase, int j0, int j1, int wave_last, int lowtile,
                   const bf16x8 (&qf)[NMAP][NS], f32x16 (&o)[NMAP][2], float (&m)[NMAP], float (&l)[NMAP], float c1, int trow, unsigned selbits, int hh) {
    const int tid = C.tid, lane = C.lane, r = lane & 31;
    const int i16 = lane & 15, q4 = i16 >> 2, pp = i16 & 3, blk = (lane >> 4) & 1;
    TileRegs R;
    tile_gload<BIAS>(R, kbase, vbase, cbase, 64 * j0, tid);
    tile_lstore<BIAS>(R, C.lds, 0, tid);
    __syncthreads();
    int cur = 0;
    for (int j = j0; j <= j1; ++j) {
        if (j < j1) tile_gload<BIAS>(R, kbase, vbase, cbase, 64 * (j + 1), tid);
        if (j <= wave_last) {
            const LAS bf16_t* Kt = (const LAS bf16_t*)(C.lds + AT_K0 + cur * AT_KBUF);
            const LAS bf16_t* Vl = (const LAS bf16_t*)(C.lds + AT_V0 + cur * AT_KBUF) + (4 * hh + q4) * KP + 16 * blk + 4 * pp;
            const LAS float* Cl = (const LAS float*)(C.lds + AT_C0 + cur * 256) + 4 * hh;
            const int mmode = (j == wave_last) ? 1 : ((j == lowtile) ? 2 : 0);
            const bool kill = SEL ? (((selbits >> j) & 1u) == 0u) : false;
#pragma unroll
            for (int mp = 0; mp < NMAP; ++mp)
                tile_step<BIAS, SEL, NS>(Kt + r * KP + 8 * hh + mp * 32, Vl, Cl, qf[mp], o[mp], m[mp], l[mp], c1, mmode, 64 * j, trow, kill, hh);
        }
        if (j < j1) tile_lstore<BIAS>(R, C.lds, cur ^ 1, tid);
        __syncthreads();
        cur ^= 1;
    }
}

DI void store_row64(bf16_t* dst, const f32x16 (&v)[2], int hh) {
#pragma unroll
    for (int dt = 0; dt < 2; ++dt)
#pragma unroll
        for (int g4 = 0; g4 < 4; ++g4) { u32x2 w; w.x = pk2(v[dt][4 * g4], v[dt][4 * g4 + 1]); w.y = pk2(v[dt][4 * g4 + 2], v[dt][4 * g4 + 3]); *(u32x2*)(dst + 32 * dt + 8 * g4 + 4 * hh) = w; }
}

DI void attn_phase(const Ctx& C, ARGP a, int L) {
    const bf16_t* proj = (const bf16_t*)(C.ws + WS_BIG);
    bf16_t* mix = (bf16_t*)(C.ws + WS_MIX);
    unsigned* qctr = (unsigned*)(C.ws + WS_CTL) + CW_QUEUE + 64 * L;
    volatile LAS int* slot = (volatile LAS int*)(C.lds + AT_MISC);
    const int tid = C.tid, lane = C.lane, w = C.wave, r = lane & 31, hh = lane >> 5;
    for (;;) {
        __syncthreads();
        if (tid == 0) slot[0] = (int)atomicAdd(qctr, 1u);
        __syncthreads();
        const int idx = slot[0];
        if (idx >= 4096) break;
        const int qb8 = 7 - (idx >> 9), rem = idx & 511;
        if (rem >= 256) {
            const int r3 = rem - 256, b = r3 >> 3, h = r3 & 7; const int tok = 256 * qb8 + 32 * w + r; const size_t mrow = (size_t)b * SEQ + tok;
            bf16x8 qf[1][4];
#pragma unroll
            for (int s = 0; s < 4; ++s) qf[0][s] = *(const bf16x8*)(proj + mrow * NPROJ + C_FQ + h * 64 + 16 * s + 8 * hh);
            f32x16 o[1][2]; float m[1] = {-1e30f}, l[1] = {0.f};
#pragma unroll
            for (int dt = 0; dt < 2; ++dt)
#pragma unroll
                for (int i = 0; i < 16; ++i) o[0][dt][i] = 0.f;
            const bf16_t* kb = proj + (size_t)b * SEQ * NPROJ + C_FK + h * 64; const bf16_t* vb = proj + (size_t)b * SEQ * NPROJ + C_FV + h * 64;
            const float* cb = (const float*)(C.ws + WS_CKL) + (size_t)(b * 8 + h) * SEQ;
            flash_pass<true, false, 4, 1>(C, kb, vb, cb, 0, 4 * qb8 + 3, 4 * qb8 + (w >> 1), -1, qf, o, m, l, 0.125f * LOG2E, tok, 0xffffffffu, hh);
            const float lt = l[0] + __shfl_xor(l[0], 32); const float inv = 1.0f / lt;
#pragma unroll
            for (int dt = 0; dt < 2; ++dt)
#pragma unroll
                for (int i = 0; i < 16; ++i) o[0][dt][i] *= inv;
            store_row64(mix + mrow * DM + 512 + h * 64, o[0], hh);
        } else if (rem < 128) {
            const int b = rem >> 2, h = rem & 3; const int tok = 256 * qb8 + 32 * w + r; const size_t mrow = (size_t)b * SEQ + tok;
            bf16x8 qf[2][2];
#pragma unroll
            for (int mp = 0; mp < 2; ++mp)
#pragma unroll
                for (int s = 0; s < 2; ++s) qf[mp][s] = *(const bf16x8*)(proj + mrow * NPROJ + C_DQ + h * 64 + mp * 32 + 16 * s + 8 * hh);
            f32x16 o[2][2]; float m[2] = {-1e30f, -1e30f}, l[2] = {0.f, 0.f};
#pragma unroll
            for (int mp = 0; mp < 2; ++mp)
#pragma unroll
                for (int dt = 0; dt < 2; ++dt)
#pragma unroll
                    for (int i = 0; i < 16; ++i) o[mp][dt][i] = 0.f;
            const bf16_t* kb = proj + (size_t)b * SEQ * NPROJ + C_DK + h * 64; const bf16_t* vb = proj + (size_t)b * SEQ * NPROJ + C_DV + h * 64;
            flash_pass<false, false, 2, 2>(C, kb, vb, nullptr, 0, 4 * qb8 + 3, 4 * qb8 + (w >> 1), -1, qf, o, m, l, 0.17677669529f * LOG2E, tok, 0xffffffffu, hh);
            const float lam = ((const float*)(C.ws + WS_TBL + TB_LAM))[L]; const float li = 0.8f - 0.6f * expf(-0.3f * (float)L);
            const float i0 = 1.0f / (l[0] + __shfl_xor(l[0], 32)), i1 = lam / (l[1] + __shfl_xor(l[1], 32));
            float ss = 0.f;
#pragma unroll
            for (int dt = 0; dt < 2; ++dt)
#pragma unroll
                for (int i = 0; i < 16; ++i) { const float v = o[0][dt][i] * i0 - o[1][dt][i] * i1; o[0][dt][i] = v; ss += v * v; }
            ss += __shfl_xor(ss, 32);
            const float rms = (1.0f / sqrtf(ss * (1.0f / 64.0f) + LN_EPS)) * (1.0f - li);
            const float* sg = a->in[19] + L * 64;
#pragma unroll
            for (int dt = 0; dt < 2; ++dt)
#pragma unroll
                for (int g4 = 0; g4 < 4; ++g4) { const f32x4 gv = *(const f32x4*)(sg + 32 * dt + 8 * g4 + 4 * hh);
#pragma unroll
                    for (int e = 0; e < 4; ++e) o[0][dt][4 * g4 + e] *= rms * gv[e]; }
            store_row64(mix + mrow * DM + 256 + h * 64, o[0], hh);
        } else {
            const int r2 = rem - 128, b = r2 & 31, qb = 4 * qb8 + 3 - (r2 >> 5); const int tok = 64 * qb + 8 * w + (r >> 2), g = r & 3; const size_t mrow = (size_t)b * SEQ + tok;
            bf16x8 qf[1][4];
#pragma unroll
            for (int s = 0; s < 4; ++s) qf[0][s] = *(const bf16x8*)(proj + mrow * NPROJ + C_NQ + g * 64 + 16 * s + 8 * hh);
            const unsigned sel = ((const unsigned*)(C.ws + WS_SEL))[mrow];
            const bf16_t* pb = proj + (size_t)b * SEQ * NPROJ + C_NKV;
            f32x16 o[1][2], keep[2]; float m[1] = {-1e30f}, l[1] = {0.f};
#pragma unroll
            for (int dt = 0; dt < 2; ++dt)
#pragma unroll
                for (int i = 0; i < 16; ++i) o[0][dt][i] = 0.f;
            flash_pass<false, true, 4, 1>(C, pb + 128, pb + 192, nullptr, 0, qb, qb, -1, qf, o, m, l, 0.125f * LOG2E, tok, sel, hh);
            { const float g1 = 1.0f / (1.0f + __expf(-bf2f(proj[mrow * NPROJ + C_NG + g * 3 + 1]))); const float inv = g1 / (l[0] + __shfl_xor(l[0], 32));
              const float* oc = (const float*)(C.ws + WS_OCMP) + mrow * 256 + g * 64;
#pragma unroll
              for (int dt = 0; dt < 2; ++dt)
#pragma unroll
                  for (int g4 = 0; g4 < 4; ++g4) { const f32x4 cv = *(const f32x4*)(oc + 32 * dt + 8 * g4 + 4 * hh);
#pragma unroll
                      for (int e = 0; e < 4; ++e) { keep[dt][4 * g4 + e] = o[0][dt][4 * g4 + e] * inv + cv[e]; o[0][dt][4 * g4 + e] = 0.f; } } }
            m[0] = -1e30f; l[0] = 0.f;
            const int jlo = qb >= 8 ? qb - 8 : 0;
            flash_pass<false, false, 4, 1>(C, pb + 256, pb + 320, nullptr, jlo, qb, qb, qb >= 8 ? qb - 8 : -1, qf, o, m, l, 0.125f * LOG2E, tok, 0xffffffffu, hh);
            { const float g2 = 1.0f / (1.0f + __expf(-bf2f(proj[mrow * NPROJ + C_NG + g * 3 + 2]))); const float inv = g2 / (l[0] + __shfl_xor(l[0], 32));
#pragma unroll
              for (int dt = 0; dt < 2; ++dt)
#pragma unroll
                  for (int i = 0; i < 16; ++i) keep[dt][i] += o[0][dt][i] * inv; }
            store_row64(mix + mrow * DM + g * 64, keep, hh);
        }
    }
}
constexpr int LDS_BYTES = 147456;
constexpr int N_PHASES = 1 + 13 * DEPTH;

template <class Epi>
DI void run_gemm(const Ctx& C, const bf16_t* A, const bf16_t* Bt, int N, int K, const Epi& E) {
    pg8::Gemm g{A, Bt, MTOK, N, K}; pg8::StaticOrder S; S.init(MTOK, N, C.G, C.bid);
    pg8::gemm_phase<Epi, pg8::StaticOrder, true, true>((LAS unsigned char*)C.lds, g, S, E, C.tid);
}

__global__ void __launch_bounds__(512, 2) mega_fwd(Args args_k) {
    const ARGP ap0 = (ARGP)__builtin_amdgcn_kernarg_segment_ptr();
    extern __shared__ __attribute__((aligned(16))) unsigned char lds_raw[];
    Ctx C; const int wave_s = __builtin_amdgcn_readfirstlane((int)threadIdx.x >> 6); C.wave = wave_s; C.lane = 0; C.tid = 0; C.bid = blockIdx.x; C.G = gridDim.x;
    C.ws = args_k.ws; C.lds = (LAS unsigned char*)lds_raw;
    cg::grid_group grid = cg::this_grid();
#define BST ((volatile LAS unsigned*)(C.lds + 131072 + 256))
    if (threadIdx.x < 2) BST[threadIdx.x] = 0u;
    __syncthreads();
    (void)xcd_barrier_post((unsigned*)(C.ws + WS_CTL) + 4096, BST);
    const int lo = args_k.ph_lo, hi = args_k.ph_hi;
    float* X = args_k.out;
    bf16_t* XB = (bf16_t*)(C.ws + WS_XB); bf16_t* BIG = (bf16_t*)(C.ws + WS_BIG); bf16_t* MIX = (bf16_t*)(C.ws + WS_MIX);
#define PH_BEGIN(k) if (lo <= (k) && (k) < hi) { ARGP args = ap0; asm volatile("" : "+s"(args)); { int l_ = (int)__builtin_amdgcn_mbcnt_hi(~0u, __builtin_amdgcn_mbcnt_lo(~0u, 0u)); asm volatile("" : "+v"(l_)); C.lane = l_; C.tid = wave_s * 64 + l_; }
#define PH_END(k) asm volatile("s_waitcnt vmcnt(0)" ::: "memory"); if ((k) + 1 < hi) { if ((k) == 0) grid.sync(); else { XcdBarrier xb_; xb_.bar = (unsigned*)(C.ws + WS_CTL) + 4096; xb_.x = xb_xcc_id(); xb_.st = BST; xcd_barrier(xb_); } } }
    PH_BEGIN(0) prep_phase(C, args); PH_END(0)
    for (int L = 0; L < DEPTH; ++L) {
        const int pb = 1 + 13 * L;
        unsigned char* wb = C.ws + WS_W + (size_t)L * W_LAYER;
        PH_BEGIN(pb + 0) { pg8::EpiSwiGLU E{BIG, DFFP}; run_gemm(C, L == 0 ? XB : MIX, (const bf16_t*)(wb + W_UP1), NUP, DM, E); } PH_END(pb + 0)
        PH_BEGIN(pb + 1) { pg8::EpiResid E{L == 0 ? args->in[0] : X, X, DN_ALPHA, 0.5f, nullptr, nullptr, nullptr}; run_gemm(C, BIG, (const bf16_t*)(wb + W_DN1), DM, DFFP, E); } PH_END(pb + 1)
        PH_BEGIN(pb + 2) ln_phase(C, X, XB, args->in[2] + (size_t)(L * 3 + 0) * DM, args->in[3] + (size_t)(L * 3 + 0) * DM); PH_END(pb + 2)
        PH_BEGIN(pb + 3) { pg8::EpiBf16 E{BIG, NPROJ}; run_gemm(C, XB, (const bf16_t*)(wb + W_IN), NPROJ, DM, E); } PH_END(pb + 3)
        PH_BEGIN(pb + 4) attn_prep_phase(C, args, L); PH_END(pb + 4)
        PH_BEGIN(pb + 5) cmp_attn_phase(C, L); PH_END(pb + 5)
        PH_BEGIN(pb + 6) attn_phase(C, args, L); PH_END(pb + 6)
        PH_BEGIN(pb + 7) { pg8::EpiResid E{X, X, DN_ALPHA, 1.0f, (const float*)(C.ws + WS_LNST), args->in[2] + (size_t)(L * 3 + 0) * DM, args->in[3] + (size_t)(L * 3 + 0) * DM}; run_gemm(C, MIX, (const bf16_t*)(wb + W_OUT), DM, DM, E); } PH_END(pb + 7)
        PH_BEGIN(pb + 8) ln_phase(C, X, XB, args->in[2] + (size_t)(L * 3 + 1) * DM, args->in[3] + (size_t)(L * 3 + 1) * DM); PH_END(pb + 8)
        PH_BEGIN(pb + 9) { pg8::EpiSwiGLU E{BIG, DFFP}; run_gemm(C, XB, (const bf16_t*)(wb + W_UP2), NUP, DM, E); } PH_END(pb + 9)
        PH_BEGIN(pb + 10) { pg8::EpiResid E{X, X, DN_ALPHA, 0.5f, (const float*)(C.ws + WS_LNST), args->in[2] + (size_t)(L * 3 + 1) * DM, args->in[3] + (size_t)(L * 3 + 1) * DM}; run_gemm(C, BIG, (const bf16_t*)(wb + W_DN2), DM, DFFP, E); } PH_END(pb + 10)
        PH_BEGIN(pb + 11) { ln_phase(C, X, XB, args->in[2] + (size_t)(L * 3 + 2) * DM, args->in[3] + (size_t)(L * 3 + 2) * DM); __syncthreads();
            pg8::EpiBf16 E{BIG, DM}; run_gemm(C, (const bf16_t*)(C.ws + WS_PB) + (size_t)L * MTOK * PLED, (const bf16_t*)(wb + W_PLEP), DM, PLED, E); } PH_END(pb + 11)
        PH_BEGIN(pb + 12) { pg8::EpiPle E{X, X, MIX, args->in[22] + (size_t)L * DM, BIG, (const float*)(C.ws + WS_LNST), args->in[2] + (size_t)(L * 3 + 2) * DM, args->in[3] + (size_t)(L * 3 + 2) * DM}; run_gemm(C, XB, (const bf16_t*)(wb + W_PLEG), DM, DM, E); } PH_END(pb + 12)
    }
}

#ifndef MK_SPLIT
#define MK_SPLIT 0
#endif
extern "C" void kernel_launch(void* const* d_in, const int* in_sizes, int n_in, void* d_out, int out_size, void* d_ws, size_t ws_size, hipStream_t stream) {
    static int grid = 0;
    if (grid == 0) {
        if (n_in != 24 || out_size != MTOK * DM || ws_size < WS_END) { fprintf(stderr, "kernel_launch: unexpected shapes (n_in %d out %d ws %zu)\n", n_in, out_size, ws_size); grid = -1; return; }
        if (hipFuncSetAttribute((const void*)mega_fwd, hipFuncAttributeMaxDynamicSharedMemorySize, LDS_BYTES) != hipSuccess) { fprintf(stderr, "kernel_launch: hipFuncSetAttribute failed\n"); grid = -1; return; }
        int dev = 0, cus = 0, per_cu = 0; hipGetDevice(&dev); hipDeviceGetAttribute(&cus, hipDeviceAttributeMultiprocessorCount, dev);
        hipOccupancyMaxActiveBlocksPerMultiprocessor(&per_cu, (const void*)mega_fwd, 512, LDS_BYTES);
        if (per_cu < 1) { fprintf(stderr, "kernel_launch: occupancy query says %d blocks/CU\n", per_cu); per_cu = 1; }
        (void)hipGetLastError();
        grid = cus;
    }
    if (grid < 0) return;
    hipMemsetAsync((char*)d_ws + WS_CTL, 0, 1 * MiB, stream);
    Args a{};
    for (int i = 0; i < 24; ++i) a.in[i] = (const float*)d_in[i];
    a.out = (float*)d_out; a.ws = (unsigned char*)d_ws;
#if MK_SPLIT
    for (int p = 0; p < N_PHASES; ++p) { a.ph_lo = p; a.ph_hi = p + 1; hipLaunchKernelGGL(mega_fwd, dim3(grid), dim3(512), LDS_BYTES, stream, a); }
#else
    a.ph_lo = 0; a.ph_hi = N_PHASES;
    void* kargs[] = {&a};
    hipError_t e = hipLaunchCooperativeKernel((const void*)mega_fwd, dim3(grid), dim3(512), kargs, LDS_BYTES, stream);
    if (e != hipSuccess) fprintf(stderr, "cooperative launch failed: %s (grid %d)\n", hipGetErrorString(e), grid);
#endif
}
```

```cpp
#include <hip/hip_runtime.h>
#include <hip/hip_cooperative_groups.h>
#include <cstdio>
#include <cstdint>
#include <cmath>
namespace cg = cooperative_groups;

constexpr size_t K_WS_BIG = (size_t)484 << 20, K_WS_TBL = (size_t)1 << 20, K_TB_COS64 = 0, K_TB_SIN64 = 256 * 1024, K_TB_COS32 = 512 * 1024, K_TB_SIN32 = 640 * 1024;

namespace pg8 {
#define PG8_LAS __attribute__((address_space(3)))
typedef unsigned short bf16_t;
typedef short bf16x8 __attribute__((ext_vector_type(8)));
typedef float f32x4 __attribute__((ext_vector_type(4)));
typedef unsigned u32x4 __attribute__((ext_vector_type(4)));
constexpr int BM = 256, BK = 64, HALF = 128, HTB = HALF * BK * 2  , STAGE_BYTES = 8 * HTB, NXCD = 8, WGM = 8;

__host__ __device__ __forceinline__ int lds_byte(int r, int c) { const int st = (r >> 4) * 2 + (c >> 5), rr = r & 15, cc = c & 31, ob = rr * 64 + cc * 2; return st * 1024 + (ob ^ (((ob >> 9) & 1) << 5)); }
__host__ __device__ __forceinline__ void stage_rc(int b, int& R, int& C) { const int st = b / 1024, sb = b % 1024, swz = sb ^ (((sb >> 9) & 1) << 5); R = (st >> 1) * 16 + swz / 64; C = (st & 1) * 32 + (swz % 64) / 2; }
__host__ __device__ __forceinline__ int perm32(int rho) { const int n = rho >> 4, i = rho & 15; return 8 * (i >> 2) + 4 * n + (i & 3); }

struct Unit { int pm, pn; };
struct Gemm { const bf16_t* A; const bf16_t* Bt; int M, N, K; };

struct StaticOrder {
    int nM, nN, nwg, G, c;
    __host__ __device__ void init(int M, int N, int G_, int c_) { nM = M / BM; nN = N / BM; nwg = nM * nN; G = G_; c = c_; }
    __host__ __device__ bool next(int i, Unit& u) const {
        const long L = (long)i * G + c; if (L >= nwg) return false;
        int wgid = (int)L; { const int q = nwg / NXCD, r = nwg % NXCD, xcd = wgid % NXCD, off = wgid / NXCD; wgid = (xcd < r ? xcd * (q + 1) : r * (q + 1) + (xcd - r) * q) + off; }
        const int nig = WGM * nN, gid = wgid / nig, fm = gid * WGM, gsz = (nM - fm) < WGM ? (nM - fm) : WGM;
        u.pm = fm + ((wgid % nig) % gsz); u.pn = (wgid % nig) / gsz; return true;
    }
    __device__ __forceinline__ void a_ready(const Unit&) const {}
    __device__ __forceinline__ void done(const Unit&) const {}
};

__device__ __forceinline__ unsigned cvt_pk_bf16(float lo, float hi) { unsigned r; asm volatile("v_cvt_pk_bf16_f32 %0, %1, %2" : "=v"(r) : "v"(lo), "v"(hi)); return r; }
typedef unsigned u32x2 __attribute__((ext_vector_type(2)));
typedef float f32x2 __attribute__((ext_vector_type(2)));
struct EpiBf16 {
    static constexpr bool PERM = true, AFTER_DRAIN = false;
    bf16_t* O; int ldc;
    __device__ __forceinline__ void operator()(const f32x4 (&acc)[2][2][4][2], const Unit& u, int wr, int wc, int fr, int fq) const {
        const int row0 = u.pm * BM + wr * 64 + fr; const int col0 = u.pn * BM + wc * 32 + 8 * fq;
#pragma unroll
        for (int ai = 0; ai < 2; ++ai)
#pragma unroll
            for (int m = 0; m < 4; ++m) { bf16_t* rowp = O + (size_t)(row0 + ai * HALF + m * 16) * ldc + col0;
#pragma unroll
                for (int bj = 0; bj < 2; ++bj) { const f32x4 v0 = acc[ai][bj][m][0], v1 = acc[ai][bj][m][1];
                    u32x4 w; w.x = cvt_pk_bf16(v0[0], v0[1]); w.y = cvt_pk_bf16(v0[2], v0[3]); w.z = cvt_pk_bf16(v1[0], v1[1]); w.w = cvt_pk_bf16(v1[2], v1[3]);
                    *(u32x4*)(rowp + bj * HALF) = w; } __builtin_amdgcn_sched_barrier(0); }
    }
};
__device__ __forceinline__ int proj_seg_type(int s) { return (s < 4 || s == 6 || s == 8) ? 1 : ((s >= 10 && s < 18) ? 2 : 0); }
struct EpiProjRope {
    static constexpr bool PERM = true, AFTER_DRAIN = false;
    unsigned char* ws; int ldc;
    __device__ __forceinline__ void operator()(const f32x4 (&acc)[2][2][4][2], const Unit& u, int wr, int wc, int fr, int fq) const {
        asm volatile("" : "+v"(fr), "+v"(fq));
        unsigned char* w_ = ws; asm volatile("" : "+s"(w_));
        bf16_t* O = (bf16_t*)(w_ + ::K_WS_BIG); const float* cos64 = (const float*)(w_ + ::K_WS_TBL + ::K_TB_COS64); const float* sin64 = (const float*)(w_ + ::K_WS_TBL + ::K_TB_SIN64);
        const float* cos32 = (const float*)(w_ + ::K_WS_TBL + ::K_TB_COS32); const float* sin32 = (const float*)(w_ + ::K_WS_TBL + ::K_TB_SIN32);
        const int s = u.pn * 4 + wc, ty = proj_seg_type(s);
        const int row0 = u.pm * BM + wr * 64 + fr;
        const int d0 = (ty == 2) ? 64 * s + 32 * (fq >> 1) + 8 * (fq & 1) : 64 * s + 8 * fq;
        const int dstep = (ty == 2) ? 16 : 32;
        const float* ct = (ty == 2) ? cos32 : cos64; const float* st = (ty == 2) ? sin32 : sin64;
        const int tw = (ty == 2) ? 16 : 32, i0 = (ty == 2) ? 8 * (fq & 1) : 8 * fq;
#pragma unroll
        for (int ai = 0; ai < 2; ++ai)
#pragma unroll
            for (int m = 0; m < 4; ++m) { const int row = row0 + ai * HALF + m * 16; bf16_t* rowp = O + (size_t)row * ldc + d0; const int pos = row & 2047;
#pragma unroll
                for (int n = 0; n < 2; ++n) { f32x4 x1 = acc[ai][0][m][n], x2 = acc[ai][1][m][n];
                    if (ty != 0) { const f32x4 cv = *(const f32x4*)(ct + pos * tw + i0 + 4 * n), sv = *(const f32x4*)(st + pos * tw + i0 + 4 * n);
                        const f32x4 y1 = x1 * cv - x2 * sv, y2 = x2 * cv + x1 * sv; x1 = y1; x2 = y2; }
                    u32x2 w; w.x = cvt_pk_bf16(x1[0], x1[1]); w.y = cvt_pk_bf16(x1[2], x1[3]); *(u32x2*)(rowp + 4 * n) = w;
                    w.x = cvt_pk_bf16(x2[0], x2[1]); w.y = cvt_pk_bf16(x2[2], x2[3]); *(u32x2*)(rowp + dstep + 4 * n) = w;
                    __builtin_amdgcn_sched_barrier(0); } }
    }
};
__device__ __forceinline__ float silu_mul(float g, float uu) { return g * uu * __builtin_amdgcn_rcpf(1.0f + __builtin_amdgcn_exp2f(-1.44269504f * g)); }
struct EpiSwiGLU {
    static constexpr bool PERM = true, AFTER_DRAIN = false;
    bf16_t* H; int ldh;
    __device__ __forceinline__ void operator()(const f32x4 (&acc)[2][2][4][2], const Unit& u, int wr, int wc, int fr, int fq) const {
        const int row0 = u.pm * BM + wr * 64 + fr; const int col0 = u.pn * HALF + wc * 32 + 8 * fq;
#pragma unroll
        for (int ai = 0; ai < 2; ++ai)
#pragma unroll
            for (int m = 0; m < 4; ++m) { bf16_t* rowp = H + (size_t)(row0 + ai * HALF + m * 16) * ldh + col0;
                const f32x4 g0 = acc[ai][0][m][0], g1 = acc[ai][0][m][1], u0 = acc[ai][1][m][0], u1 = acc[ai][1][m][1];
                u32x4 w; w.x = cvt_pk_bf16(silu_mul(g0[0], u0[0]), silu_mul(g0[1], u0[1])); w.y = cvt_pk_bf16(silu_mul(g0[2], u0[2]), silu_mul(g0[3], u0[3]));
                w.z = cvt_pk_bf16(silu_mul(g1[0], u1[0]), silu_mul(g1[1], u1[1])); w.w = cvt_pk_bf16(silu_mul(g1[2], u1[2]), silu_mul(g1[3], u1[3]));
                *(u32x4*)rowp = w; __builtin_amdgcn_sched_barrier(0); }
    }
};
struct EpiResid {
    static constexpr bool PERM = false, AFTER_DRAIN = false;
    const float* X; float* Y; float alpha, s; const float* ST; const float* g; const float* b;
    __device__ __forceinline__ void operator()(const f32x4 (&acc)[2][2][4][2], const Unit& u, int wr, int wc, int fr, int fq) const {
        const int col0 = u.pn * BM + wc * 32 + 4 * fq;
#pragma unroll
        for (int ai = 0; ai < 2; ++ai)
#pragma unroll
            for (int m = 0; m < 4; ++m) { const int row = u.pm * BM + ai * HALF + wr * 64 + m * 16 + fr; const size_t off = (size_t)row * 1024 + col0;
                f32x2 st = {0.f, 1.f}; if (ST) st = *(const f32x2*)(ST + 2 * (size_t)row);
#pragma unroll
                for (int bj = 0; bj < 2; ++bj)
#pragma unroll
                    for (int n = 0; n < 2; ++n) { f32x4 xv = *(const f32x4*)(X + off + bj * HALF + n * 16);
                        if (ST) { const f32x4 gv = *(const f32x4*)(g + col0 + bj * HALF + n * 16), bv = *(const f32x4*)(b + col0 + bj * HALF + n * 16); xv = (xv - st[0]) * st[1] * gv + bv; }
                        *(f32x4*)(Y + off + bj * HALF + n * 16) = xv * alpha + acc[ai][bj][m][n] * s; } }
    }
};
struct EpiPle {
    static constexpr bool PERM = false, AFTER_DRAIN = false;
    const float* X; float* OUT; bf16_t* XB; const float* bias; const bf16_t* PP; const float* ST; const float* g; const float* b;
    __device__ __forceinline__ void operator()(const f32x4 (&acc)[2][2][4][2], const Unit& u, int wr, int wc, int fr, int fq) const {
        const int col0 = u.pn * BM + wc * 32 + 4 * fq;
#pragma unroll
        for (int ai = 0; ai < 2; ++ai)
#pragma unroll
            for (int m = 0; m < 4; ++m) { const int row = u.pm * BM + ai * HALF + wr * 64 + m * 16 + fr; const size_t off = (size_t)row * 1024 + col0;
                const f32x2 st = *(const f32x2*)(ST + 2 * (size_t)row);
#pragma unroll
                for (int bj = 0; bj < 2; ++bj)
#pragma unroll
                    for (int n = 0; n < 2; ++n) { const int co = bj * HALF + n * 16;
                        f32x4 xv = *(const f32x4*)(X + off + co); const f32x4 bv = *(const f32x4*)(bias + col0 + co);
                        { const f32x4 gv = *(const f32x4*)(g + col0 + co), lb = *(const f32x4*)(b + col0 + co); xv = (xv - st[0]) * st[1] * gv + lb; }
                        const u32x2 pw = *(const u32x2*)(PP + off + co);
                        f32x4 pv; pv[0] = __uint_as_float(pw.x << 16); pv[1] = __uint_as_float(pw.x & 0xffff0000u); pv[2] = __uint_as_float(pw.y << 16); pv[3] = __uint_as_float(pw.y & 0xffff0000u);
                        f32x4 o;
#pragma unroll
                        for (int e = 0; e < 4; ++e) { const float z = acc[ai][bj][m][n][e] + bv[e]; const float sg = __builtin_amdgcn_rcpf(1.0f + __builtin_amdgcn_exp2f(-1.44269504f * z)); o[e] = xv[e] + sg * pv[e]; }
                        *(f32x4*)(OUT + off + co) = o;
                        if (XB) { u32x2 w; w.x = cvt_pk_bf16(o[0], o[1]); w.y = cvt_pk_bf16(o[2], o[3]); *(u32x2*)(XB + off + co) = w; } } }
    }
};
template <class Epi, class Sched, bool ALIGN_EPI = false, bool SP2 = false>
__device__ __forceinline__ void gemm_phase(PG8_LAS unsigned char* lds, const Gemm g, const Sched& S, const Epi& E, const int tid_in) {
    int tid_ = tid_in; asm volatile("" : "+v"(tid_));
    const int tid = tid_, wid = __builtin_amdgcn_readfirstlane(tid >> 6), lane = tid & 63, wr = wid >> 2, wc = wid & 3, fr = lane & 15, fq = lane >> 4;
    const int K = g.K, nt = K / BK;
    unsigned voffA[2], voffB[2];
#pragma unroll
    for (int i = 0; i < 2; ++i) { int R, C; stage_rc(tid * 16 + i * 8192, R, C); const int Rb = Epi::PERM ? ((R & ~31) + perm32(R & 31)) : R;
        voffA[i] = (unsigned)(R * K + C) * 2u; voffB[i] = (unsigned)(Rb * K + C) * 2u; }
    const size_t kstep = (size_t)(BK * 2);
    const size_t hstep = (size_t)HALF * K * 2;
    const size_t tstep = 2 * hstep;
    const unsigned ldsw = (unsigned)wid * 1024u;
    const int aoff = lds_byte(wr * 64 + fr, fq * 8), boff = lds_byte(wc * 32 + fr, fq * 8);
#define PG8_SA(b, h) (((b) * 2 + (h)) * HTB)
#define PG8_SB(b, h) ((4 + (b) * 2 + (h)) * HTB)
#define PG8_STAGE(bufoff, gbase, voff) do { _Pragma("unroll") for (int _i = 0; _i < 2; ++_i) \
        __builtin_amdgcn_global_load_lds((const unsigned*)((const char*)(gbase) + (voff)[_i]), (PG8_LAS unsigned*)(lds + (bufoff) + ldsw + _i * 8192), 16, 0, 0); } while (0)
#define PG8_LDA(dst, b, h) do { _Pragma("unroll") for (int m = 0; m < 4; ++m) _Pragma("unroll") for (int k = 0; k < 2; ++k) dst[m][k] = *(const PG8_LAS bf16x8*)(lds + PG8_SA(b, h) + aoff + m * 2048 + k * 1024); } while (0)
#define PG8_LDB(dst, b, h) do { _Pragma("unroll") for (int n = 0; n < 2; ++n) _Pragma("unroll") for (int k = 0; k < 2; ++k) dst[n][k] = *(const PG8_LAS bf16x8*)(lds + PG8_SB(b, h) + boff + n * 2048 + k * 1024); } while (0)
#define PG8_MMA(ai, bj, At, Bt) do { __builtin_amdgcn_s_setprio(1); _Pragma("unroll") for (int m = 0; m < 4; ++m) _Pragma("unroll") for (int n = 0; n < 2; ++n) _Pragma("unroll") for (int k = 0; k < 2; ++k) \
        acc[ai][bj][m][n] = __builtin_amdgcn_mfma_f32_16x16x32_bf16(Bt[n][k], At[m][k], acc[ai][bj][m][n], 0, 0, 0); __builtin_amdgcn_s_setprio(0); } while (0)
#define PG8_WAIT_V(n) asm volatile("s_waitcnt vmcnt(" #n ")" ::: "memory")
#define PG8_WAIT_L(n) asm volatile("s_waitcnt lgkmcnt(" #n ")" ::: "memory")
#define PG8_BAR __builtin_amdgcn_s_barrier()
#define PG8_SCHED __builtin_amdgcn_sched_barrier(0)
    Unit cur, nxt; int ui = 0;
    if (!S.next(0, cur)) return;
    f32x4 acc[2][2][4][2];
#pragma unroll
    for (int a = 0; a < 2; ++a)
#pragma unroll
        for (int b = 0; b < 2; ++b)
#pragma unroll
            for (int m = 0; m < 4; ++m)
#pragma unroll
                for (int n = 0; n < 2; ++n) acc[a][b][m][n] = (f32x4){0.f, 0.f, 0.f, 0.f};
    bf16x8 At[4][2], B0[2][2], B1[2][2];
    const char* cA = (const char*)g.A + (size_t)cur.pm * tstep; const char* cB = (const char*)g.Bt + (size_t)cur.pn * tstep;
    S.a_ready(cur);
    if constexpr (SP2) {
        PG8_STAGE(PG8_SB(0, 0), cB, voffB); PG8_STAGE(PG8_SB(0, 1), cB + hstep, voffB); PG8_STAGE(PG8_SA(0, 0), cA, voffA); PG8_STAGE(PG8_SA(0, 1), cA + hstep, voffA);
        if (wr == 1) PG8_BAR;
        PG8_WAIT_V(2); PG8_BAR;
        PG8_STAGE(PG8_SB(1, 0), cB + kstep, voffB); PG8_STAGE(PG8_SA(1, 0), cA + kstep, voffA); PG8_STAGE(PG8_SB(1, 1), cB + hstep + kstep, voffB);
        PG8_WAIT_V(6); PG8_BAR;
    } else {
        PG8_STAGE(PG8_SB(0, 0), cB, voffB); PG8_STAGE(PG8_SA(0, 0), cA, voffA); PG8_STAGE(PG8_SB(0, 1), cB + hstep, voffB); PG8_STAGE(PG8_SA(0, 1), cA + hstep, voffA);
        if (wr == 1) PG8_BAR;
        PG8_WAIT_V(4); PG8_BAR;
        PG8_STAGE(PG8_SB(1, 0), cB + kstep, voffB); PG8_STAGE(PG8_SA(1, 0), cA + kstep, voffA); PG8_STAGE(PG8_SB(1, 1), cB + hstep + kstep, voffB);
        PG8_WAIT_V(6); PG8_BAR;
    }
    for (;;) {
        const bool has_next = S.next(ui + 1, nxt);
        const char* nA = has_next ? (const char*)g.A + (size_t)nxt.pm * tstep : cA; const char* nB = has_next ? (const char*)g.Bt + (size_t)nxt.pn * tstep : cB;
        for (int t = 0; t < nt; t += 2) {
            const bool last = (t == nt - 2);
            const char* a1 = cA + (size_t)(t + 1) * kstep;
            const char* a2 = last ? nA : cA + (size_t)(t + 2) * kstep; const char* b2 = last ? nB : cB + (size_t)(t + 2) * kstep;
            const char* a3 = a2 + kstep; const char* b3 = b2 + kstep;
            if (last && has_next) S.a_ready(nxt);
            if constexpr (SP2) {
            PG8_LDB(B0, 0, 0); PG8_LDB(B1, 0, 1); PG8_SCHED; PG8_LDA(At, 0, 0); PG8_STAGE(PG8_SA(1, 1), a1 + hstep, voffA);
            PG8_WAIT_V(8); PG8_WAIT_L(0); PG8_BAR; PG8_MMA(0, 0, At, B0); PG8_MMA(0, 1, At, B1); PG8_BAR; PG8_SCHED;
            PG8_LDA(At, 0, 1); PG8_STAGE(PG8_SB(0, 0), b2, voffB); PG8_STAGE(PG8_SB(0, 1), b2 + hstep, voffB); PG8_STAGE(PG8_SA(0, 0), a2, voffA);
            PG8_WAIT_V(8); PG8_WAIT_L(0); PG8_BAR; PG8_MMA(1, 0, At, B0); PG8_MMA(1, 1, At, B1); PG8_BAR; PG8_SCHED;
            PG8_LDB(B0, 1, 0); PG8_LDB(B1, 1, 1); PG8_SCHED; PG8_LDA(At, 1, 0); PG8_STAGE(PG8_SA(0, 1), a2 + hstep, voffA);
            PG8_WAIT_V(8); PG8_WAIT_L(0); PG8_BAR; PG8_MMA(0, 0, At, B0); PG8_MMA(0, 1, At, B1); PG8_BAR; PG8_SCHED;
            PG8_LDA(At, 1, 1); PG8_STAGE(PG8_SB(1, 0), b3, voffB); PG8_STAGE(PG8_SB(1, 1), b3 + hstep, voffB); PG8_STAGE(PG8_SA(1, 0), a3, voffA);
            PG8_WAIT_V(8); PG8_WAIT_L(0); PG8_BAR; PG8_MMA(1, 0, At, B0); PG8_MMA(1, 1, At, B1); PG8_BAR; PG8_SCHED;
            } else {
            PG8_LDB(B0, 0, 0); PG8_SCHED; PG8_LDA(At, 0, 0); PG8_STAGE(PG8_SA(1, 1), a1 + hstep, voffA);
            PG8_WAIT_L(8); PG8_BAR; PG8_WAIT_L(0); PG8_MMA(0, 0, At, B0); PG8_BAR; PG8_SCHED;
            PG8_LDB(B1, 0, 1); PG8_STAGE(PG8_SB(0, 0), b2, voffB);
            PG8_BAR; PG8_WAIT_L(0); PG8_MMA(0, 1, At, B1); PG8_BAR;
            PG8_LDA(At, 0, 1); PG8_STAGE(PG8_SA(0, 0), a2, voffA);
            PG8_BAR; PG8_WAIT_L(0); PG8_MMA(1, 0, At, B0); PG8_BAR; PG8_SCHED;
            PG8_STAGE(PG8_SB(0, 1), b2 + hstep, voffB);
            PG8_WAIT_V(6); PG8_BAR; PG8_MMA(1, 1, At, B1); PG8_BAR;
            PG8_LDB(B0, 1, 0); PG8_SCHED; PG8_LDA(At, 1, 0); PG8_STAGE(PG8_SA(0, 1), a2 + hstep, voffA);
            PG8_WAIT_L(8); PG8_BAR; PG8_WAIT_L(0); PG8_MMA(0, 0, At, B0); PG8_BAR; PG8_SCHED;
            PG8_LDB(B1, 1, 1); PG8_STAGE(PG8_SB(1, 0), b3, voffB);
            PG8_BAR; PG8_WAIT_L(0); PG8_MMA(0, 1, At, B1); PG8_BAR;
            PG8_LDA(At, 1, 1); PG8_STAGE(PG8_SA(1, 0), a3, voffA);
            PG8_BAR; PG8_WAIT_L(0); PG8_MMA(1, 0, At, B0); PG8_BAR; PG8_SCHED;
            PG8_STAGE(PG8_SB(1, 1), b3 + hstep, voffB);
            PG8_WAIT_V(6); PG8_BAR; PG8_MMA(1, 1, At, B1); PG8_BAR;
            }
        }
        if constexpr (ALIGN_EPI) { if (wr == 0) PG8_BAR; }
        if constexpr (!Epi::AFTER_DRAIN) { E(acc, cur, wr, wc, fr, fq); S.done(cur); }
        if (!has_next) break;
#pragma unroll
        for (int a = 0; a < 2; ++a)
#pragma unroll
            for (int b = 0; b < 2; ++b)
#pragma unroll
                for (int m = 0; m < 4; ++m)
#pragma unroll
                    for (int n = 0; n < 2; ++n) acc[a][b][m][n] = (f32x4){0.f, 0.f, 0.f, 0.f};
        cur = nxt; cA = nA; cB = nB; ++ui;
        if constexpr (ALIGN_EPI) { if (wr == 1) PG8_BAR; }
    }
    PG8_WAIT_V(0);
    if constexpr (!ALIGN_EPI) { if (wr == 0) PG8_BAR; }
    PG8_BAR;
    if constexpr (Epi::AFTER_DRAIN) { E.fused(acc, cur, wr, wc, fr, fq, lds, wid, lane); S.done(cur); }
#undef PG8_SA
#undef PG8_SB
#undef PG8_STAGE
#undef PG8_LDA
#undef PG8_LDB
#undef PG8_MMA
#undef PG8_WAIT_V
#undef PG8_WAIT_L
#undef PG8_BAR
#undef PG8_SCHED
}
}
#define DI __device__ __forceinline__
#define LAS __attribute__((address_space(3)))
typedef unsigned short bf16_t;
typedef short bf16x8 __attribute__((ext_vector_type(8)));
typedef short s16x4 __attribute__((ext_vector_type(4)));
typedef float f32x2 __attribute__((ext_vector_type(2)));
typedef float f32x4 __attribute__((ext_vector_type(4)));
typedef float f32x16 __attribute__((ext_vector_type(16)));
typedef unsigned u32x2 __attribute__((ext_vector_type(2)));
typedef unsigned u32x4 __attribute__((ext_vector_type(4)));
typedef __bf16 bf16x2_t __attribute__((ext_vector_type(2)));

constexpr int DM = 1024, BATCH = 32, SEQ = 2048, DEPTH = 2, MTOK = BATCH * SEQ, DFF = 2752, DFFP = 2816, NUP = 2 * DFFP, NPROJ = 3072, PLED = 256;
constexpr int IN_COLS = 2964;
constexpr int C_NQ = 0, C_NKV = 256, C_DQ = 640, C_DK = 896, C_DV = 1152, C_FQ = 1408, C_FK = 1920, C_FV = 2432, C_NG = 2944, C_FF = 2956;
constexpr float LN_EPS = 1e-5f;
constexpr float DN_ALPHA = 1.41421356237f;
constexpr float LOG2E = 1.44269504089f;

constexpr size_t MiB = 1u << 20;
constexpr size_t WS_CTL = 0;
constexpr size_t WS_TBL = 1 * MiB;
constexpr size_t TB_COS64 = 0, TB_SIN64 = 256 * 1024, TB_COS32 = 512 * 1024, TB_SIN32 = 640 * 1024, TB_CBIAS = 768 * 1024, TB_LAM = 772 * 1024;
constexpr size_t WS_KC = 2 * MiB, WS_VC = 2 * MiB + 512 * 1024;
constexpr size_t WS_SEL = 3 * MiB;
constexpr size_t WS_CKL = 4 * MiB;
constexpr size_t WS_W = 8 * MiB, W_LAYER = 46 * MiB;
constexpr size_t W_UP1 = 0, W_DN1 = 11 * MiB, W_UP2 = W_DN1 + 5632 * 1024, W_DN2 = W_UP2 + 11 * MiB, W_IN = W_DN2 + 5632 * 1024, W_OUT = W_IN + 6 * MiB,
                 W_PLEG = W_OUT + 2 * MiB, W_PLEP = W_PLEG + 2 * MiB, W_K1 = W_PLEP + 512 * 1024, W_V1 = W_K1 + 1 * MiB, W_K2 = W_V1 + 1 * MiB, W_V2 = W_K2 + 32 * 1024;
static_assert(W_V2 + 32 * 1024 <= W_LAYER, "weights fit");
constexpr size_t WS_XB = 100 * MiB;
constexpr size_t WS_PB = 228 * MiB;
constexpr size_t WS_OCMP = 292 * MiB;
constexpr size_t WS_MIX = 356 * MiB;
constexpr size_t WS_BIG = 484 * MiB;
constexpr size_t WS_END = 868 * MiB;
constexpr size_t WS_LNST = 6 * MiB;
static_assert(K_WS_BIG == WS_BIG && K_WS_TBL == WS_TBL && K_TB_COS64 == TB_COS64 && K_TB_SIN64 == TB_SIN64 && K_TB_COS32 == TB_COS32 && K_TB_SIN32 == TB_SIN32, "epilogue offsets");
constexpr int CW_QUEUE = 64;

DI unsigned pk2(float lo, float hi) { f32x2 v = {lo, hi}; return __builtin_bit_cast(unsigned, __builtin_convertvector(v, bf16x2_t)); }
DI float bf2f(bf16_t h) { return __uint_as_float((unsigned)h << 16); }
DI bf16_t f2bf(float f) { return (bf16_t)(pk2(f, 0.f) & 0xffffu); }
DI float wave_sum(float v) {
#pragma unroll
    for (int o = 1; o < 64; o <<= 1) v += __shfl_xor(v, o);
    return v;
}
DI int crow(int i, int hh) { return (i & 3) + 8 * (i >> 2) + 4 * hh; }
#define MFMA32(a, b, c) __builtin_amdgcn_mfma_f32_32x32x16_bf16((a), (b), (c), 0, 0, 0)
#define MFMA16(a, b, c) __builtin_amdgcn_mfma_f32_16x16x32_bf16((a), (b), (c), 0, 0, 0)
#define LDS_WAIT() asm volatile("s_waitcnt lgkmcnt(0)" ::: "memory")

struct Args {
    const float* in[24]; float* out; unsigned char* ws; int ph_lo, ph_hi;
};
typedef const __attribute__((address_space(4))) Args* ARGP;
struct Ctx {
    int tid, lane, wave, bid, G;
    unsigned char* ws; LAS unsigned char* lds;
};

DI void tr_item(const float* W, int ldn, int Ksrc, int srccol, bf16_t* WT, int ldk, int k0, int nrow0, LAS float* scr, int lane) {
#pragma unroll
    for (int i = 0; i < 32; ++i) { const int kk = 2 * i + (lane >> 5), k = k0 + kk; float v = 0.f; if (srccol >= 0 && k < Ksrc) v = W[(size_t)k * ldn + srccol]; scr[kk * 33 + (lane & 31)] = v; }
    LDS_WAIT();
    const int c = lane & 7;
#pragma unroll
    for (int j = 0; j < 4; ++j) { const int n = (lane >> 3) + 8 * j; const LAS float* s = scr + (8 * c) * 33 + n;
        u32x4 o; o.x = pk2(s[0 * 33], s[1 * 33]); o.y = pk2(s[2 * 33], s[3 * 33]); o.z = pk2(s[4 * 33], s[5 * 33]); o.w = pk2(s[6 * 33], s[7 * 33]);
        *(u32x4*)(WT + (size_t)(nrow0 + n) * ldk + k0 + 8 * c) = o; }
    LDS_WAIT();
}
DI int proj_col_of_row(int n) { const int tile = n >> 8, bj = (n >> 7) & 1, wc = (n >> 5) & 3, j = n & 31, sg = tile * 4 + wc;
    return (sg >= 10 && sg < 18) ? 64 * sg + 32 * (j >> 4) + 16 * bj + (j & 15) : 64 * sg + 32 * bj + j; }
DI int win_map(int n) { return n < 640 ? n : (n < 2944 ? n + 12 : (n < 2956 ? n - 2944 + 640 : (n < 2964 ? n : -1))); }

DI void prep_phase(const Ctx& C, ARGP a) {
    LAS float* scr = (LAS float*)(C.lds + C.wave * 16384);
    const int gw = C.bid * 8 + C.wave, NGW = C.G * 8, lane = C.lane;
    constexpr int I_UP = 16 * 176, I_DN = 44 * 32, I_IN = 16 * 96, I_SQ = 16 * 32, I_PP = 4 * 32, I_P1 = 32 * 8, I_P2 = 4 * 2;
    constexpr int PER_LAYER = 2 * I_UP + 2 * I_DN + I_IN + 2 * I_SQ + I_PP + 2 * I_P1 + 2 * I_P2;
    for (int it = gw; it < DEPTH * PER_LAYER; it += NGW) {
        const int L = it / PER_LAYER; int r = it % PER_LAYER;
        unsigned char* wb = C.ws + WS_W + (size_t)L * W_LAYER;
        if (r < 2 * I_UP) { const int f = r / I_UP; r %= I_UP; const int kb = r / 176, nb = r % 176; const int n = 32 * nb + (lane & 31);
            const int pn = n >> 8, bj = (n >> 7) & 1, hid = 128 * pn + (n & 127);
            const float* src = a->in[(f ? 7 : 4) + bj] + (size_t)L * DM * DFF;
            tr_item(src, DFF, DM, hid < DFF ? hid : -1, (bf16_t*)(wb + (f ? W_UP2 : W_UP1)), DM, 64 * kb, 32 * nb, scr, lane); continue; }
        r -= 2 * I_UP;
        if (r < 2 * I_DN) { const int f = r / I_DN; r %= I_DN; const int kb = r / 32, nb = r % 32;
            const float* src = a->in[f ? 9 : 6] + (size_t)L * DFF * DM;
            tr_item(src, DM, DFF, 32 * nb + (lane & 31), (bf16_t*)(wb + (f ? W_DN2 : W_DN1)), DFFP, 64 * kb, 32 * nb, scr, lane); continue; }
        r -= 2 * I_DN;
        if (r < I_IN) { const int kb = r / 96, nb = r % 96;
            tr_item(a->in[10] + (size_t)L * DM * IN_COLS, IN_COLS, DM, win_map(proj_col_of_row(32 * nb + (lane & 31))), (bf16_t*)(wb + W_IN), DM, 64 * kb, 32 * nb, scr, lane); continue; }
        r -= I_IN;
        if (r < 2 * I_SQ) { const int f = r / I_SQ; r %= I_SQ; const int kb = r / 32, nb = r % 32;
            tr_item(a->in[f ? 21 : 20] + (size_t)L * DM * DM, DM, DM, 32 * nb + (lane & 31), (bf16_t*)(wb + (f ? W_PLEG : W_OUT)), DM, 64 * kb, 32 * nb, scr, lane); continue; }
        r -= 2 * I_SQ;
        if (r < I_PP) { const int kb = r / 32, nb = r % 32;
            tr_item(a->in[23] + (size_t)L * PLED * DM, DM, PLED, 32 * nb + (lane & 31), (bf16_t*)(wb + W_PLEP), PLED, 64 * kb, 32 * nb, scr, lane); continue; }
        r -= I_PP;
        if (r < 2 * I_P1) { const int f = r / I_P1; r %= I_P1; const int kb = r / 8, nb = r % 8;
            tr_item(a->in[f ? 16 : 14] + (size_t)L * 2048 * 256, 256, 2048, 32 * nb + (lane & 31), (bf16_t*)(wb + (f ? W_V1 : W_K1)), 2048, 64 * kb, 32 * nb, scr, lane); continue; }
        r -= 2 * I_P1;
        { const int f = r / I_P2; r %= I_P2; const int kb = r / 2, nb = r % 2;
            tr_item(a->in[f ? 17 : 15] + (size_t)L * 256 * 64, 64, 256, 32 * nb + (lane & 31), (bf16_t*)(wb + (f ? W_V2 : W_K2)), 256, 64 * kb, 32 * nb, scr, lane); }
    }
    const size_t gt = (size_t)C.bid * 512 + C.tid, NT = (size_t)C.G * 512;
    { const float* x = a->in[0]; bf16_t* xb = (bf16_t*)(C.ws + WS_XB); const float* p = a->in[1]; bf16_t* pb = (bf16_t*)(C.ws + WS_PB);
      constexpr size_t NX = (size_t)MTOK * DM / 8, NP = (size_t)DEPTH * MTOK * PLED / 8;
      for (size_t i0 = gt; i0 < NX + NP; i0 += 4 * NT) { f32x4 v[4][2];
#pragma unroll
          for (int q = 0; q < 4; ++q) { size_t i = i0 + q * NT; if (i >= NX + NP) i = gt; const float* src = i < NX ? x + i * 8 : p + (i - NX) * 8; v[q][0] = *(const f32x4*)src; v[q][1] = *(const f32x4*)(src + 4); }
#pragma unroll
          for (int q = 0; q < 4; ++q) { size_t i = i0 + q * NT; if (i >= NX + NP) i = gt; bf16_t* dst = i < NX ? xb + i * 8 : pb + (i - NX) * 8;
              u32x4 o; o.x = pk2(v[q][0][0], v[q][0][1]); o.y = pk2(v[q][0][2], v[q][0][3]); o.z = pk2(v[q][1][0], v[q][1][1]); o.w = pk2(v[q][1][2], v[q][1][3]); *(u32x4*)dst = o; } } }
    { float* tb = (float*)(C.ws + WS_TBL);
      for (size_t i = gt; i < (size_t)SEQ * 48; i += NT) {
          int pos, k; float inv; const bool big = i < (size_t)SEQ * 32; size_t j;
          if (big) { j = i; pos = (int)(i >> 5); k = (int)(i & 31); inv = exp2f(-(float)k * (13.2877123795f / 32.0f)); }
          else { j = i - (size_t)SEQ * 32; pos = (int)(j >> 4); k = (int)(j & 15); inv = exp2f(-(float)k * (13.2877123795f / 16.0f)); }
          const float ang = (float)pos * inv; double rv = (double)ang * 0.15915494309189535; rv -= floor(rv); const float fr = (float)rv;
          const float cs = __builtin_amdgcn_cosf(fr), sn = __builtin_amdgcn_sinf(fr);
          if (big) { tb[TB_COS64 / 4 + j] = cs; tb[TB_SIN64 / 4 + j] = sn; } else { tb[TB_COS32 / 4 + j] = cs; tb[TB_SIN32 / 4 + j] = sn; } } }
    { float* cb = (float*)(C.ws + WS_TBL + TB_CBIAS);
      for (int o = gw; o < DEPTH * 2 * 256; o += NGW) { const int L = o >> 9, kv = (o >> 8) & 1, n = o & 255;
          const float* pe = a->in[kv ? 13 : 12] + (size_t)L * 2048; const float* w1 = a->in[kv ? 16 : 14] + (size_t)L * 2048 * 256;
          float s = 0.f; for (int k = lane; k < 2048; k += 64) s += pe[k] * w1[(size_t)k * 256 + n];
          s = wave_sum(s); if (lane == 0) cb[o] = s; } }
    if (C.bid == 0 && C.tid < DEPTH) { const int L = C.tid; const float* lp = a->in[18] + L * 128; float s1 = 0.f, s2 = 0.f;
        for (int k = 0; k < 32; ++k) { s1 += lp[k] * lp[32 + k]; s2 += lp[64 + k] * lp[96 + k]; }
        const float li = 0.8f - 0.6f * expf(-0.3f * (float)L);
        ((float*)(C.ws + WS_TBL + TB_LAM))[L] = expf(s1) - expf(s2) + li; }
}

DI void ln_phase(const Ctx& C, const float* X, bf16_t* XB, const float* g, const float* b) {
    const int gw = C.bid * 8 + C.wave, NGW = C.G * 8, lane = C.lane;
    f32x4 gv[4], bv[4];
#pragma unroll
    for (int j = 0; j < 4; ++j) { gv[j] = *(const f32x4*)(g + 4 * lane + 256 * j); bv[j] = *(const f32x4*)(b + 4 * lane + 256 * j); }
    for (int m = gw; m < MTOK; m += NGW) {
        const float* xr = X + (size_t)m * DM + 4 * lane; f32x4 v[4]; float s = 0.f;
#pragma unroll
        for (int j = 0; j < 4; ++j) { v[j] = *(const f32x4*)(xr + 256 * j); s += (v[j][0] + v[j][1]) + (v[j][2] + v[j][3]); }
        const float mean = wave_sum(s) * (1.f / DM); float s2 = 0.f;
#pragma unroll
        for (int j = 0; j < 4; ++j) { v[j] = v[j] - mean; s2 += (v[j][0] * v[j][0] + v[j][1] * v[j][1]) + (v[j][2] * v[j][2] + v[j][3] * v[j][3]); }
        const float rstd = 1.0f / sqrtf(wave_sum(s2) * (1.f / DM) + LN_EPS);
        bf16_t* xo = XB + (size_t)m * DM + 4 * lane;
#pragma unroll
        for (int j = 0; j < 4; ++j) { const f32x4 o = v[j] * rstd * gv[j] + bv[j];
            u32x2 w; w.x = pk2(o[0], o[1]); w.y = pk2(o[2], o[3]); *(u32x2*)(xo + 256 * j) = w; }
        if (lane == 0) { f32x2 st; st[0] = mean; st[1] = rstd; *(f32x2*)((float*)(C.ws + WS_LNST) + 2 * (size_t)m) = st; }
    }
}
#define XLAS __attribute__((address_space(3)))
#define XB_TMO      128
#define XB_XCNT(j)  (256  + 64 * (j))
#define XB_XSUB(j)  (1280 + 64 * (j))
#define XB_XGEN(j)  (2304 + 64 * (j))
#define XB_TOP      3328
#define XB_TOPGEN   3392
#define XCD_BAR_WORDS 3456
#define XB_SPIN_CAP (1u << 18)

__device__ __forceinline__ unsigned xb_ld(unsigned* p)              { return __hip_atomic_load(p, __ATOMIC_RELAXED, __HIP_MEMORY_SCOPE_AGENT); }
__device__ __forceinline__ unsigned xb_add(unsigned* p, unsigned v) { return __hip_atomic_fetch_add(p, v, __ATOMIC_RELAXED, __HIP_MEMORY_SCOPE_AGENT); }
__device__ __forceinline__ unsigned xb_xcc_id() { return (unsigned)__builtin_amdgcn_s_getreg((3 << 11) | 20) & 0xFu; }
#define XB_SPIN(cond, bar) do { unsigned _sp = 0; while (cond) { __builtin_amdgcn_s_sleep(1); \
    if ((++_sp & 255u) == 0u) { if (xb_ld(&(bar)[XB_TMO])) break; if (_sp > XB_SPIN_CAP) { atomicAdd(&(bar)[XB_TMO], 1u); break; } } } } while (0)

struct XcdBarrier {
    unsigned* bar; unsigned x;
    volatile XLAS unsigned* st;
};

__device__ __forceinline__ XcdBarrier xcd_barrier_post(unsigned* bar, volatile XLAS unsigned* st) {
    XcdBarrier b; b.bar = bar; b.x = xb_xcc_id(); b.st = st;
    if (threadIdx.x == 0) (void)xb_add(&bar[XB_XCNT(b.x)], 1u);
    return b;
}
__device__ __forceinline__ void xcd_barrier_complete(unsigned* bar, unsigned x, unsigned& nloc, unsigned& nx) {
    const unsigned G = gridDim.x * gridDim.y * gridDim.z;
    unsigned sum, cnt, mine, sp = 0u;
    for (;;) {
        sum = 0u; cnt = 0u; mine = 0u;
#pragma unroll
        for (unsigned j = 0; j < 16; ++j) { const unsigned c = xb_ld(&bar[XB_XCNT(j)]); sum += c; cnt += (c > 0u) ? 1u : 0u; mine = (j == x) ? c : mine; }
        if (sum == G) break;
        __builtin_amdgcn_s_sleep(1);
        if ((++sp & 255u) == 0u) { if (xb_ld(&bar[XB_TMO])) break; if (sp > XB_SPIN_CAP) { atomicAdd(&bar[XB_TMO], 1u); break; } }
    }
    nloc = mine > 0u ? mine : 1u; nx = cnt > 0u ? cnt : 1u;
}

__device__ __forceinline__ void xcd_barrier(const XcdBarrier& b) {
    asm volatile("s_waitcnt vmcnt(0)" ::: "memory");
    __syncthreads();
    if (threadIdx.x == 0) {
        unsigned* bar = b.bar;
        __builtin_amdgcn_s_waitcnt(0);
        unsigned nloc = b.st[0], nx = b.st[1];
        if (nloc == 0u) { xcd_barrier_complete(bar, b.x, nloc, nx); b.st[0] = nloc; b.st[1] = nx; }
        const unsigned old = xb_add(&bar[XB_XSUB(b.x)], 1u);
        const unsigned gen = old / nloc;
        if (old + 1u == (gen + 1u) * nloc) {
            __builtin_amdgcn_fence(__ATOMIC_RELEASE, "agent");
            asm volatile("s_waitcnt vmcnt(0)" ::: "memory");
            const unsigned og = xb_add(&bar[XB_TOP], 1u);
            const unsigned tg = og / nx;
            if (og + 1u == (tg + 1u) * nx) xb_add(&bar[XB_TOPGEN], 1u);
            else XB_SPIN(xb_ld(&bar[XB_TOPGEN]) == tg, bar);
            __builtin_amdgcn_fence(__ATOMIC_ACQUIRE, "agent");
            xb_add(&bar[XB_XGEN(b.x)], 1u);
            asm volatile("s_waitcnt vmcnt(0)" ::: "memory");
        } else {
            XB_SPIN(xb_ld(&bar[XB_XGEN(b.x)]) == gen, bar);
            __builtin_amdgcn_fence(__ATOMIC_ACQUIRE, "agent");
            asm volatile("s_waitcnt vmcnt(0)" ::: "memory");
        }
    }
    __syncthreads();
}
DI float gelu_tanh(float x) { const float z = 0.7978845608f * (x + 0.044715f * x * x * x); const float e = __builtin_amdgcn_exp2f(2.0f * LOG2E * z); return 0.5f * x * (2.0f - 2.0f * __builtin_amdgcn_rcpf(e + 1.0f)); }

DI void cmp_mlp_unit(const Ctx& C, const bf16_t* proj, int b, int cgp, int kv, const bf16_t* W1t, const bf16_t* W2t, const float* bias, bf16_t* outp, const float* cos64, const float* sin64) {
    constexpr int SP = 72, HP = 264;
    LAS bf16_t* span = (LAS bf16_t*)C.lds;
    LAS bf16_t* Hs = (LAS bf16_t*)(C.lds + 528 * SP * 2);
    LAS float* Os = (LAS float*)(C.lds + 528 * SP * 2 + 32 * HP * 2);
    const int tid = C.tid, lane = C.lane, w = C.wave, row16 = lane & 15, quad = lane >> 4;
    const int t0 = 512 * cgp;
    for (int idx = tid; idx < 528 * 8; idx += 512) { const int tr = idx >> 3, ch = idx & 7, t = t0 + tr; u32x4 v = {0u, 0u, 0u, 0u};
        if (t < SEQ) v = *(const u32x4*)(proj + (size_t)(b * SEQ + t) * NPROJ + C_NKV + kv * 64 + ch * 8);
        *(LAS u32x4*)(span + tr * SP + ch * 8) = v; }
    __syncthreads();
    f32x4 acc[2][2];
#pragma unroll
    for (int i = 0; i < 2; ++i)
#pragma unroll
        for (int j = 0; j < 2; ++j) acc[i][j] = (f32x4){0.f, 0.f, 0.f, 0.f};
    const bf16_t* wb0 = W1t + (size_t)(32 * w + row16) * 2048 + quad * 8;
#pragma unroll 4
    for (int ks = 0; ks < 64; ++ks) { const int l = ks >> 1, dq = ks & 1, k0 = l * 64 + 32 * dq;
        const bf16x8 b0 = *(const bf16x8*)(wb0 + k0), b1 = *(const bf16x8*)(wb0 + 16 * 2048 + k0);
        const bf16x8 a0 = *(const LAS bf16x8*)(span + (16 * row16 + l) * SP + 32 * dq + quad * 8);
        const bf16x8 a1 = *(const LAS bf16x8*)(span + (16 * (16 + row16) + l) * SP + 32 * dq + quad * 8);
        acc[0][0] = MFMA16(a0, b0, acc[0][0]); acc[0][1] = MFMA16(a0, b1, acc[0][1]); acc[1][0] = MFMA16(a1, b0, acc[1][0]); acc[1][1] = MFMA16(a1, b1, acc[1][1]); }
#pragma unroll
    for (int mi = 0; mi < 2; ++mi)
#pragma unroll
        for (int ni = 0; ni < 2; ++ni) { const int n = 32 * w + 16 * ni + row16; const float bs = bias[n];
#pragma unroll
            for (int j = 0; j < 4; ++j) Hs[(16 * mi + quad * 4 + j) * HP + n] = f2bf(gelu_tanh(acc[mi][ni][j] + bs)); }
    __syncthreads();
    { const int mt = w >> 2, nt = w & 3; f32x4 a2 = {0.f, 0.f, 0.f, 0.f};
#pragma unroll
      for (int ks = 0; ks < 8; ++ks) { const bf16x8 av = *(const LAS bf16x8*)(Hs + (16 * mt + row16) * HP + 32 * ks + quad * 8);
          const bf16x8 bv = *(const bf16x8*)(W2t + (size_t)(16 * nt + row16) * 256 + 32 * ks + quad * 8); a2 = MFMA16(av, bv, a2); }
#pragma unroll
      for (int j = 0; j < 4; ++j) Os[(16 * mt + quad * 4 + j) * 64 + 16 * nt + row16] = a2[j]; }
    __syncthreads();
    { const int c = tid >> 4, cglob = 32 * cgp + c; bf16_t* op = outp + (size_t)(b * 128 + cglob) * 64;
#pragma unroll
      for (int e = 0; e < 2; ++e) { const int i = (tid & 15) * 2 + e; float x1 = Os[c * 64 + i], x2 = Os[c * 64 + i + 32];
          if (cglob >= 127) { x1 = 0.f; x2 = 0.f; }
          else if (kv == 0) { const int pos = 16 * cglob + 31; const float cs = cos64[pos * 32 + i], sn = sin64[pos * 32 + i]; const float y1 = x1 * cs - x2 * sn, y2 = x2 * cs + x1 * sn; x1 = y1; x2 = y2; }
          op[i] = f2bf(x1); op[i + 32] = f2bf(x2); } }
    __syncthreads();
}

DI void attn_prep_phase(const Ctx& C, ARGP a, int L) {
    bf16_t* proj = (bf16_t*)(C.ws + WS_BIG);
    const float* tb = (const float*)(C.ws + WS_TBL);
    const float* cos64 = tb + TB_COS64 / 4; const float* sin64 = tb + TB_SIN64 / 4; const float* cos32 = tb + TB_COS32 / 4; const float* sin32 = tb + TB_SIN32 / 4;
    unsigned char* wb = C.ws + WS_W + (size_t)L * W_LAYER;
    for (int u = C.bid; u < BATCH * 4 * 2; u += C.G) { const int kv = u & 1, cgp = (u >> 1) & 3, b = u >> 3;
        cmp_mlp_unit(C, proj, b, cgp, kv, (const bf16_t*)(wb + (kv ? W_V1 : W_K1)), (const bf16_t*)(wb + (kv ? W_V2 : W_K2)),
                     (const float*)(C.ws + WS_TBL + TB_CBIAS) + (L * 2 + kv) * 256, (bf16_t*)(C.ws + (kv ? WS_VC : WS_KC)), cos64, sin64); }
    const int gw = C.bid * 8 + C.wave, NGW = C.G * 8, lane = C.lane;
    for (int u = gw; u < BATCH * 8; u += NGW) { const int b = u >> 3, h = u & 7; const float bf = a->in[11][L * 8 + h];
        float* ck = (float*)(C.ws + WS_CKL) + (size_t)u * SEQ + lane * 32; const bf16_t* fp = proj + (size_t)(b * SEQ + lane * 32) * NPROJ + C_FF + h;
        float run = 0.f; float loc[32];
#pragma unroll
        for (int i = 0; i < 32; ++i) { const float x = bf2f(fp[(size_t)i * NPROJ]) + bf; const float ls = fminf(x, 0.f) - log1pf(expf(-fabsf(x))); run += ls; loc[i] = run; }
        float incl = run;
#pragma unroll
        for (int o = 1; o < 64; o <<= 1) { const float t = __shfl_up(incl, o); if (lane >= o) incl += t; }
        const float base = incl - run;
#pragma unroll
        for (int i = 0; i < 32; ++i) ck[i] = (base + loc[i]) * LOG2E; }
}

constexpr int KP = 72;
DI void cmp_attn_phase(const Ctx& C, int L) {
    const bf16_t* proj = (const bf16_t*)(C.ws + WS_BIG);
    LAS bf16_t* Ks = (LAS bf16_t*)C.lds;
    LAS bf16_t* Vs = (LAS bf16_t*)(C.lds + 128 * KP * 2);
    LAS float* Ps = (LAS float*)(C.lds + 2 * 128 * KP * 2 + C.wave * 5120);
    LAS float* Sc = Ps + 8 * 128;
    const int tid = C.tid, lane = C.lane, w = C.wave, r = lane & 31, hh = lane >> 5;
    const float c1 = 0.125f * LOG2E;
    for (int ug = C.bid; ug < BATCH * 8; ug += C.G) {
        const int b = ug >> 3;
        __syncthreads();
        for (int idx = tid; idx < 128 * 8 * 2; idx += 512) { const int kvs = idx >> 10, rem = idx & 1023, c = rem >> 3, ch = rem & 7;
            const u32x4 v = *(const u32x4*)((const bf16_t*)(C.ws + (kvs ? WS_VC : WS_KC)) + (size_t)(b * 128 + c) * 64 + ch * 8);
            *(LAS u32x4*)((kvs ? Vs : Ks) + c * KP + ch * 8) = v; }
        __syncthreads();
        for (int uu = 0; uu < 4; ++uu) {
            const int t0 = ((ug & 7) * 4 + uu) * 64; const int tok = t0 + 8 * w + (r >> 2), g = r & 3; const size_t m = (size_t)b * SEQ + tok;
            bf16x8 qf[4];
#pragma unroll
            for (int s = 0; s < 4; ++s) qf[s] = *(const bf16x8*)(proj + m * NPROJ + C_NQ + g * 64 + 16 * s + 8 * hh);
            f32x16 p[4];
#pragma unroll
            for (int kt = 0; kt < 4; ++kt) { f32x16 acc;
#pragma unroll
                for (int i = 0; i < 16; ++i) acc[i] = 0.f;
#pragma unroll
                for (int s = 0; s < 4; ++s) { const bf16x8 kf = *(const LAS bf16x8*)(Ks + (32 * kt + r) * KP + 16 * s + 8 * hh); acc = MFMA32(kf, qf[s], acc); }
                p[kt] = acc; }
            float mx = -1e30f; const int climh = ((tok - 31) >> 4) - 4 * hh;
#pragma unroll
            for (int kt = 0; kt < 4; ++kt)
#pragma unroll
                for (int i = 0; i < 16; ++i) { const bool ok = (32 * kt + (i & 3) + 8 * (i >> 2)) <= climh; p[kt][i] = ok ? p[kt][i] : -INFINITY; mx = fmaxf(mx, p[kt][i]); }
            mx = fmaxf(mx, __shfl_xor(mx, 32));
            float sum = 0.f; const float off = mx * c1;
#pragma unroll
            for (int kt = 0; kt < 4; ++kt)
#pragma unroll
                for (int i = 0; i < 16; ++i) { const float e = __builtin_amdgcn_exp2f(p[kt][i] * c1 - off); p[kt][i] = e; sum += e; }
            sum += __shfl_xor(sum, 32);
            const float inv = (tok >= 31) ? 1.0f / sum : 0.f;
#pragma unroll
            for (int kt = 0; kt < 4; ++kt)
#pragma unroll
                for (int i = 0; i < 16; ++i) p[kt][i] *= inv;
            __builtin_amdgcn_sched_barrier(0);
            f32x16 o[2];
#pragma unroll
            for (int dt = 0; dt < 2; ++dt)
#pragma unroll
                for (int i = 0; i < 16; ++i) o[dt][i] = 0.f;
            const int i16 = lane & 15, q4 = i16 >> 2, pp = i16 & 3, blk = (lane >> 4) & 1;
            const LAS bf16_t* vb = Vs + (4 * hh + q4) * KP + 16 * blk + 4 * pp;
#pragma unroll
            for (int kt = 0; kt < 4; ++kt)
#pragma unroll
                for (int s = 0; s < 2; ++s) { u32x4 pw; pw.x = pk2(p[kt][8 * s], p[kt][8 * s + 1]); pw.y = pk2(p[kt][8 * s + 2], p[kt][8 * s + 3]); pw.z = pk2(p[kt][8 * s + 4], p[kt][8 * s + 5]); pw.w = pk2(p[kt][8 * s + 6], p[kt][8 * s + 7]);
                    const bf16x8 pf = __builtin_bit_cast(bf16x8, pw);
#pragma unroll
                    for (int dt = 0; dt < 2; ++dt) { const s16x4 lo = __builtin_amdgcn_ds_read_tr16_b64_v4i16((LAS s16x4*)(vb + (32 * kt + 16 * s) * KP + 32 * dt));
                        const s16x4 hi = __builtin_amdgcn_ds_read_tr16_b64_v4i16((LAS s16x4*)(vb + (32 * kt + 16 * s + 8) * KP + 32 * dt));
                        const bf16x8 vf = __builtin_shufflevector(lo, hi, 0, 1, 2, 3, 4, 5, 6, 7); o[dt] = MFMA32(vf, pf, o[dt]); } __builtin_amdgcn_sched_barrier(0); }
            __builtin_amdgcn_sched_barrier(0);
            { const float gl = bf2f(proj[m * NPROJ + C_NG + g * 3 + 0]); const float gate = 1.0f / (1.0f + __expf(-gl));
              float* op = (float*)(C.ws + WS_OCMP) + m * 256 + g * 64;
#pragma unroll
              for (int dt = 0; dt < 2; ++dt)
#pragma unroll
                  for (int g4 = 0; g4 < 4; ++g4) { f32x4 v; v[0] = o[dt][4 * g4] * gate; v[1] = o[dt][4 * g4 + 1] * gate; v[2] = o[dt][4 * g4 + 2] * gate; v[3] = o[dt][4 * g4 + 3] * gate;
                      *(f32x4*)(op + 32 * dt + 8 * g4 + 4 * hh) = v; } }
            __builtin_amdgcn_sched_barrier(0);
#pragma unroll
            for (int kt = 0; kt < 4; ++kt)
#pragma unroll
                for (int i = 0; i < 16; ++i) { float v = p[kt][i]; v += __shfl_xor(v, 1); v += __shfl_xor(v, 2); p[kt][i] = v; }
            __builtin_amdgcn_sched_barrier(0);
            if (g == 0) {
#pragma unroll
                for (int kt = 0; kt < 4; ++kt)
#pragma unroll
                    for (int g4 = 0; g4 < 4; ++g4) { f32x4 v; v[0] = p[kt][4 * g4]; v[1] = p[kt][4 * g4 + 1]; v[2] = p[kt][4 * g4 + 2]; v[3] = p[kt][4 * g4 + 3];
                        *(LAS f32x4*)(Ps + (r >> 2) * 128 + 32 * kt + 8 * g4 + 4 * hh) = v; } }
            LDS_WAIT();
            { const int tk = lane >> 3, jg = lane & 7; const int t = t0 + 8 * w + tk; const int blk_t = t >> 6;
              float sc[4];
#pragma unroll
              for (int jj = 0; jj < 4; ++jj) { const int j = 4 * jg + jj; float imp = 0.f;
#pragma unroll
                  for (int cc = -1; cc < 4; ++cc) { const int c = 4 * j + cc; if (c >= 0) imp += Ps[tk * 128 + c]; }
                  const bool forced = (j == 0) || (j == blk_t) || (j == blk_t - 1); const bool valid = (j * 64) <= t;
                  sc[jj] = forced ? 1e9f : (valid ? imp : -1.0f); Sc[tk * 32 + j] = sc[jj]; }
              LDS_WAIT();
              unsigned bits = 0u;
#pragma unroll
              for (int jj = 0; jj < 4; ++jj) { const int j = 4 * jg + jj; int cnt = 0;
                  for (int j2 = 0; j2 < 32; ++j2) { const float o2 = Sc[tk * 32 + j2]; cnt += (o2 > sc[jj] || (o2 == sc[jj] && j2 < j)) ? 1 : 0; }
                  if (cnt < 16) bits |= 1u << j; }
              bits |= __shfl_xor(bits, 1); bits |= __shfl_xor(bits, 2); bits |= __shfl_xor(bits, 4);
              if (jg == 0) ((unsigned*)(C.ws + WS_SEL))[(size_t)b * SEQ + t] = bits; }
            LDS_WAIT();
        }
    }
}
constexpr int AT_KBUF = 64 * KP * 2;
constexpr int AT_K0 = 0, AT_V0 = 2 * AT_KBUF, AT_C0 = 4 * AT_KBUF, AT_MISC = AT_C0 + 2 * 256;

template <bool BIAS, bool SEL, int NS>
DI void tile_step(const LAS bf16_t* Kl, const LAS bf16_t* Vl, const LAS float* Cl, const bf16x8 (&qf)[NS], f32x16 (&o)[2], float& m, float& l,
                  const float c1, const int mmode, const int key0, const int trow, const bool kill, const int hh) {
    f32x16 p[2];
#pragma unroll
    for (int kt = 0; kt < 2; ++kt) { f32x16 acc;
#pragma unroll
        for (int i = 0; i < 16; ++i) acc[i] = 0.f;
#pragma unroll
        for (int s = 0; s < NS; ++s) { const bf16x8 kf = *(const LAS bf16x8*)(Kl + 32 * kt * KP + 16 * s); acc = MFMA32(kf, qf[s], acc); }
        p[kt] = acc; }
    if (BIAS) {
        const f32x2 c1v = {c1, c1};
#pragma unroll
        for (int kt = 0; kt < 2; ++kt)
#pragma unroll
            for (int g4 = 0; g4 < 4; ++g4) { const f32x4 cv = *(const LAS f32x4*)(Cl + 32 * kt + 8 * g4);
                f32x2 a0 = {p[kt][4 * g4], p[kt][4 * g4 + 1]}, a1 = {p[kt][4 * g4 + 2], p[kt][4 * g4 + 3]};
                a0 = a0 * c1v - (f32x2){cv[0], cv[1]}; a1 = a1 * c1v - (f32x2){cv[2], cv[3]};
                p[kt][4 * g4] = a0[0]; p[kt][4 * g4 + 1] = a0[1]; p[kt][4 * g4 + 2] = a1[0]; p[kt][4 * g4 + 3] = a1[1]; }
    }
    const int lim = trow - key0 - 4 * hh;
    if (mmode == 1) {
#pragma unroll
        for (int kt = 0; kt < 2; ++kt)
#pragma unroll
            for (int i = 0; i < 16; ++i) p[kt][i] = ((32 * kt + (i & 3) + 8 * (i >> 2)) > lim) ? -INFINITY : p[kt][i];
    } else if (mmode == 2) {
#pragma unroll
        for (int kt = 0; kt < 2; ++kt)
#pragma unroll
            for (int i = 0; i < 16; ++i) p[kt][i] = ((32 * kt + (i & 3) + 8 * (i >> 2)) <= lim - 512) ? -INFINITY : p[kt][i];
    }
    if (SEL) { if (kill) {
#pragma unroll
        for (int kt = 0; kt < 2; ++kt)
#pragma unroll
            for (int i = 0; i < 16; ++i) p[kt][i] = -INFINITY; } }
    float mx = p[0][0];
#pragma unroll
    for (int kt = 0; kt < 2; ++kt)
#pragma unroll
        for (int i = 0; i < 16; ++i) mx = fmaxf(mx, p[kt][i]);
    mx = fmaxf(mx, __shfl_xor(mx, 32));
    const float mn = fmaxf(m, mx);
    float alpha, off, sc;
    if (BIAS) { alpha = __builtin_amdgcn_exp2f(m - mn); off = mn; sc = 1.0f; } else { alpha = __builtin_amdgcn_exp2f((m - mn) * c1); off = mn * c1; sc = c1; }
    m = mn;
    f32x2 rs2 = {0.f, 0.f}; const f32x2 scv = {sc, sc}, offv = {off, off};
#pragma unroll
    for (int kt = 0; kt < 2; ++kt)
#pragma unroll
        for (int i = 0; i < 16; i += 2) { f32x2 a = {p[kt][i], p[kt][i + 1]}; a = a * scv - offv; f32x2 e; e[0] = __builtin_amdgcn_exp2f(a[0]); e[1] = __builtin_amdgcn_exp2f(a[1]);
            p[kt][i] = e[0]; p[kt][i + 1] = e[1]; rs2 += e; }
    l = l * alpha + (rs2[0] + rs2[1]);
    const f32x2 av = {alpha, alpha};
#pragma unroll
    for (int dt = 0; dt < 2; ++dt)
#pragma unroll
        for (int i = 0; i < 16; i += 2) { f32x2 a = {o[dt][i], o[dt][i + 1]}; a = a * av; o[dt][i] = a[0]; o[dt][i + 1] = a[1]; }
#pragma unroll
    for (int kt = 0; kt < 2; ++kt)
#pragma unroll
        for (int s = 0; s < 2; ++s) { u32x4 pw; pw.x = pk2(p[kt][8 * s], p[kt][8 * s + 1]); pw.y = pk2(p[kt][8 * s + 2], p[kt][8 * s + 3]); pw.z = pk2(p[kt][8 * s + 4], p[kt][8 * s + 5]); pw.w = pk2(p[kt][8 * s + 6], p[kt][8 * s + 7]);
            const bf16x8 pf = __builtin_bit_cast(bf16x8, pw);
#pragma unroll
            for (int dt = 0; dt < 2; ++dt) { const s16x4 lo = __builtin_amdgcn_ds_read_tr16_b64_v4i16((LAS s16x4*)(Vl + (32 * kt + 16 * s) * KP + 32 * dt));
                const s16x4 hi = __builtin_amdgcn_ds_read_tr16_b64_v4i16((LAS s16x4*)(Vl + (32 * kt + 16 * s + 8) * KP + 32 * dt));
                const bf16x8 vf = __builtin_shufflevector(lo, hi, 0, 1, 2, 3, 4, 5, 6, 7); o[dt] = MFMA32(vf, pf, o[dt]); } }
}

struct TileRegs { u32x4 k, v; float c; };
template <bool BIAS>
DI void tile_gload(TileRegs& R, const bf16_t* kbase, const bf16_t* vbase, const float* cbase, int key0, int tid) {
    const size_t off = (size_t)(key0 + (tid >> 3)) * NPROJ + (tid & 7) * 8;
    R.k = *(const u32x4*)(kbase + off); R.v = *(const u32x4*)(vbase + off);
    if (BIAS) { if (tid < 64) R.c = cbase[key0 + tid]; }
}
template <bool BIAS>
DI void tile_lstore(const TileRegs& R, LAS unsigned char* lds, int buf, int tid) {
    const int o = ((tid >> 3) * KP + (tid & 7) * 8) * 2;
    *(LAS u32x4*)(lds + AT_K0 + buf * AT_KBUF + o) = R.k; *(LAS u32x4*)(lds + AT_V0 + buf * AT_KBUF + o) = R.v;
    if (BIAS) { if (tid < 64) *(LAS float*)(lds + AT_C0 + buf * 256 + tid * 4) = R.c; }
}

template <bool BIAS, bool SEL, int NS, int NMAP>
DI void flash_pass(const Ctx& C, const bf16_t* kbase, const bf16_t* vbase, const float* cbase, int j0, int j1, int wave_last, int lowtile,
                   const bf16x8 (&qf)[NMAP][NS], f32x16 (&o)[NMAP][2], float (&m)[NMAP], float (&l)[NMAP], float c1, int trow, unsigned selbits, int hh) {
    const int tid = C.tid, lane = C.lane, r = lane & 31;
    const int i16 = lane & 15, q4 = i16 >> 2, pp = i16 & 3, blk = (lane >> 4) & 1;
    TileRegs R;
    tile_gload<BIAS>(R, kbase, vbase, cbase, 64 * j0, tid);
    tile_lstore<BIAS>(R, C.lds, 0, tid);
    __syncthreads();
    int cur = 0;
    for (int j = j0; j <= j1; ++j) {
        if (j < j1) tile_gload<BIAS>(R, kbase, vbase, cbase, 64 * (j + 1), tid);
        if (j <= wave_last) {
            const LAS bf16_t* Kt = (const LAS bf16_t*)(C.lds + AT_K0 + cur * AT_KBUF);
            const LAS bf16_t* Vl = (const LAS bf16_t*)(C.lds + AT_V0 + cur * AT_KBUF) + (4 * hh + q4) * KP + 16 * blk + 4 * pp;
            const LAS float* Cl = (const LAS float*)(C.lds + AT_C0 + cur * 256) + 4 * hh;
            const int mmode = (j == wave_last) ? 1 : ((j == lowtile) ? 2 : 0);
            const bool kill = SEL ? (((selbits >> j) & 1u) == 0u) : false;
#pragma unroll
            for (int mp = 0; mp < NMAP; ++mp)
                tile_step<BIAS, SEL, NS>(Kt + r * KP + 8 * hh + mp * 32, Vl, Cl, qf[mp], o[mp], m[mp], l[mp], c1, mmode, 64 * j, trow, kill, hh);
        }
        if (j < j1) tile_lstore<BIAS>(R, C.lds, cur ^ 1, tid);
        __syncthreads();
        cur ^= 1;
    }
}

DI void store_row64(bf16_t* dst, const f32x16 (&v)[2], int hh) {
#pragma unroll
    for (int dt = 0; dt < 2; ++dt)
#pragma unroll
        for (int g4 = 0; g4 < 4; ++g4) { u32x2 w; w.x = pk2(v[dt][4 * g4], v[dt][4 * g4 + 1]); w.y = pk2(v[dt][4 * g4 + 2], v[dt][4 * g4 + 3]); *(u32x2*)(dst + 32 * dt + 8 * g4 + 4 * hh) = w; }
}

DI void attn_phase(const Ctx& C, ARGP a, int L) {
    const bf16_t* proj = (const bf16_t*)(C.ws + WS_BIG);
    bf16_t* mix = (bf16_t*)(C.ws + WS_MIX);
    unsigned* qctr = (unsigned*)(C.ws + WS_CTL) + CW_QUEUE + 64 * L;
    volatile LAS int* slot = (volatile LAS int*)(C.lds + AT_MISC);
    const int tid = C.tid, lane = C.lane, w = C.wave, r = lane & 31, hh = lane >> 5;
    for (;;) {
        __syncthreads();
        if (tid == 0) slot[0] = (int)atomicAdd(qctr, 1u);
        __syncthreads();
        const int idx = slot[0];
        if (idx >= 4096) break;
        const int qb8 = 7 - (idx >> 9), rem = idx & 511;
        if (rem >= 256) {
            const int r3 = rem - 256, b = r3 >> 3, h = r3 & 7; const int tok = 256 * qb8 + 32 * w + r; const size_t mrow = (size_t)b * SEQ + tok;
            bf16x8 qf[1][4];
#pragma unroll
            for (int s = 0; s < 4; ++s) qf[0][s] = *(const bf16x8*)(proj + mrow * NPROJ + C_FQ + h * 64 + 16 * s + 8 * hh);
            f32x16 o[1][2]; float m[1] = {-1e30f}, l[1] = {0.f};
#pragma unroll
            for (int dt = 0; dt < 2; ++dt)
#pragma unroll
                for (int i = 0; i < 16; ++i) o[0][dt][i] = 0.f;
            const bf16_t* kb = proj + (size_t)b * SEQ * NPROJ + C_FK + h * 64; const bf16_t* vb = proj + (size_t)b * SEQ * NPROJ + C_FV + h * 64;
            const float* cb = (const float*)(C.ws + WS_CKL) + (size_t)(b * 8 + h) * SEQ;
            flash_pass<true, false, 4, 1>(C, kb, vb, cb, 0, 4 * qb8 + 3, 4 * qb8 + (w >> 1), -1, qf, o, m, l, 0.125f * LOG2E, tok, 0xffffffffu, hh);
            const float lt = l[0] + __shfl_xor(l[0], 32); const float inv = 1.0f / lt;
#pragma unroll
            for (int dt = 0; dt < 2; ++dt)
#pragma unroll
                for (int i = 0; i < 16; ++i) o[0][dt][i] *= inv;
            store_row64(mix + mrow * DM + 512 + h * 64, o[0], hh);
        } else if (rem < 128) {
            const int b = rem >> 2, h = rem & 3; const int tok = 256 * qb8 + 32 * w + r; const size_t mrow = (size_t)b * SEQ + tok;
            bf16x8 qf[2][2];
#pragma unroll
            for (int mp = 0; mp < 2; ++mp)
#pragma unroll
                for (int s = 0; s < 2; ++s) qf[mp][s] = *(const bf16x8*)(proj + mrow * NPROJ + C_DQ + h * 64 + mp * 32 + 16 * s + 8 * hh);
            f32x16 o[2][2]; float m[2] = {-1e30f, -1e30f}, l[2] = {0.f, 0.f};
#pragma unroll
            for (int mp = 0; mp < 2; ++mp)
#pragma unroll
                for (int dt = 0; dt < 2; ++dt)
#pragma unroll
                    for (int i = 0; i < 16; ++i) o[mp][dt][i] = 0.f;
            const bf16_t* kb = proj + (size_t)b * SEQ * NPROJ + C_DK + h * 64; const bf16_t* vb = proj + (size_t)b * SEQ * NPROJ + C_DV + h * 64;
            flash_pass<false, false, 2, 2>(C, kb, vb, nullptr, 0, 4 * qb8 + 3, 4 * qb8 + (w >> 1), -1, qf, o, m, l, 0.17677669529f * LOG2E, tok, 0xffffffffu, hh);
            const float lam = ((const float*)(C.ws + WS_TBL + TB_LAM))[L]; const float li = 0.8f - 0.6f * expf(-0.3f * (float)L);
            const float i0 = 1.0f / (l[0] + __shfl_xor(l[0], 32)), i1 = lam / (l[1] + __shfl_xor(l[1], 32));
            float ss = 0.f;
#pragma unroll
            for (int dt = 0; dt < 2; ++dt)
#pragma unroll
                for (int i = 0; i < 16; ++i) { const float v = o[0][dt][i] * i0 - o[1][dt][i] * i1; o[0][dt][i] = v; ss += v * v; }
            ss += __shfl_xor(ss, 32);
            const float rms = (1.0f / sqrtf(ss * (1.0f / 64.0f) + LN_EPS)) * (1.0f - li);
            const float* sg = a->in[19] + L * 64;
#pragma unroll
            for (int dt = 0; dt < 2; ++dt)
#pragma unroll
                for (int g4 = 0; g4 < 4; ++g4) { const f32x4 gv = *(const f32x4*)(sg + 32 * dt + 8 * g4 + 4 * hh);
#pragma unroll
                    for (int e = 0; e < 4; ++e) o[0][dt][4 * g4 + e] *= rms * gv[e]; }
            store_row64(mix + mrow * DM + 256 + h * 64, o[0], hh);
        } else {
            const int r2 = rem - 128, b = r2 & 31, qb = 4 * qb8 + 3 - (r2 >> 5); const int tok = 64 * qb + 8 * w + (r >> 2), g = r & 3; const size_t mrow = (size_t)b * SEQ + tok;
            bf16x8 qf[1][4];
#pragma unroll
            for (int s = 0; s < 4; ++s) qf[0][s] = *(const bf16x8*)(proj + mrow * NPROJ + C_NQ + g * 64 + 16 * s + 8 * hh);
            const unsigned sel = ((const unsigned*)(C.ws + WS_SEL))[mrow];
            const bf16_t* pb = proj + (size_t)b * SEQ * NPROJ + C_NKV;
            f32x16 o[1][2], keep[2]; float m[1] = {-1e30f}, l[1] = {0.f};
#pragma unroll
            for (int dt = 0; dt < 2; ++dt)
#pragma unroll
                for (int i = 0; i < 16; ++i) o[0][dt][i] = 0.f;
            flash_pass<false, true, 4, 1>(C, pb + 128, pb + 192, nullptr, 0, qb, qb, -1, qf, o, m, l, 0.125f * LOG2E, tok, sel, hh);
            { const float g1 = 1.0f / (1.0f + __expf(-bf2f(proj[mrow * NPROJ + C_NG + g * 3 + 1]))); const float inv = g1 / (l[0] + __shfl_xor(l[0], 32));
              const float* oc = (const float*)(C.ws + WS_OCMP) + mrow * 256 + g * 64;
#pragma unroll
              for (int dt = 0; dt < 2; ++dt)
#pragma unroll
                  for (int g4 = 0; g4 < 4; ++g4) { const f32x4 cv = *(const f32x4*)(oc + 32 * dt + 8 * g4 + 4 * hh);
#pragma unroll
                      for (int e = 0; e < 4; ++e) { keep[dt][4 * g4 + e] = o[0][dt][4 * g4 + e] * inv + cv[e]; o[0][dt][4 * g4 + e] = 0.f; } } }
            m[0] = -1e30f; l[0] = 0.f;
            const int jlo = qb >= 8 ? qb - 8 : 0;
            flash_pass<false, false, 4, 1>(C, pb + 256, pb + 320, nullptr, jlo, qb, qb, qb >= 8 ? qb - 8 : -1, qf, o, m, l, 0.125f * LOG2E, tok, 0xffffffffu, hh);
            { const float g2 = 1.0f / (1.0f + __expf(-bf2f(proj[mrow * NPROJ + C_NG + g * 3 + 2]))); const float inv = g2 / (l[0] + __shfl_xor(l[0], 32));
#pragma unroll
              for (int dt = 0; dt < 2; ++dt)
#pragma unroll
                  for (int i = 0; i < 16; ++i) keep[dt][i] += o[0][dt][i] * inv; }
            store_row64(mix + mrow * DM + g * 64, keep, hh);
        }
    }
}
constexpr int LDS_BYTES = 147456;
constexpr int N_PHASES = 1 + 13 * DEPTH;

template <class Epi>
DI void run_gemm(const Ctx& C, const bf16_t* A, const bf16_t* Bt, int N, int K, const Epi& E, const bool opaque = false) {
    if (opaque) asm volatile("" : "+s"(K), "+s"(N));
    pg8::Gemm g{A, Bt, MTOK, N, K}; pg8::StaticOrder S; S.init(MTOK, N, C.G, C.bid);
    pg8::gemm_phase<Epi, pg8::StaticOrder, true, true>((LAS unsigned char*)C.lds, g, S, E, C.tid);
}

__global__ void __launch_bounds__(512, 2) mega_fwd(Args args_k) {
    const ARGP ap0 = (ARGP)__builtin_amdgcn_kernarg_segment_ptr();
    extern __shared__ __attribute__((aligned(16))) unsigned char lds_raw[];
    Ctx C; const int wave_s = __builtin_amdgcn_readfirstlane((int)threadIdx.x >> 6); C.wave = wave_s; C.lane = 0; C.tid = 0; C.bid = blockIdx.x; C.G = gridDim.x;
    C.ws = args_k.ws; C.lds = (LAS unsigned char*)lds_raw;
    cg::grid_group grid = cg::this_grid();
#define BST ((volatile LAS unsigned*)(C.lds + 131072 + 256))
    if (threadIdx.x < 2) BST[threadIdx.x] = 0u;
    __syncthreads();
    (void)xcd_barrier_post((unsigned*)(C.ws + WS_CTL) + 4096, BST);
    const int lo = args_k.ph_lo, hi = args_k.ph_hi;
    float* X = args_k.out;
    bf16_t* XB = (bf16_t*)(C.ws + WS_XB); bf16_t* BIG = (bf16_t*)(C.ws + WS_BIG); bf16_t* MIX = (bf16_t*)(C.ws + WS_MIX);
#define PH_BEGIN(k) if (lo <= (k) && (k) < hi) { ARGP args = ap0; asm volatile("" : "+s"(args)); { int l_ = (int)__builtin_amdgcn_mbcnt_hi(~0u, __builtin_amdgcn_mbcnt_lo(~0u, 0u)); asm volatile("" : "+v"(l_)); C.lane = l_; C.tid = wave_s * 64 + l_; }
#define PH_END(k) asm volatile("s_waitcnt vmcnt(0)" ::: "memory"); if ((k) + 1 < hi) { if ((k) == 0) grid.sync(); else { XcdBarrier xb_; xb_.bar = (unsigned*)(C.ws + WS_CTL) + 4096; xb_.x = xb_xcc_id(); xb_.st = BST; xcd_barrier(xb_); } } }
    PH_BEGIN(0) prep_phase(C, args); PH_END(0)
    for (int L = 0; L < DEPTH; ++L) {
        const int pb = 1 + 13 * L;
        unsigned char* wb = C.ws + WS_W + (size_t)L * W_LAYER;
        PH_BEGIN(pb + 0) { pg8::EpiSwiGLU E{BIG, DFFP}; run_gemm(C, L == 0 ? XB : MIX, (const bf16_t*)(wb + W_UP1), NUP, DM, E); } PH_END(pb + 0)
        PH_BEGIN(pb + 1) { pg8::EpiResid E{L == 0 ? args->in[0] : X, X, DN_ALPHA, 0.5f, nullptr, nullptr, nullptr}; run_gemm(C, BIG, (const bf16_t*)(wb + W_DN1), DM, DFFP, E); } PH_END(pb + 1)
        PH_BEGIN(pb + 2) ln_phase(C, X, XB, args->in[2] + (size_t)(L * 3 + 0) * DM, args->in[3] + (size_t)(L * 3 + 0) * DM); PH_END(pb + 2)
        PH_BEGIN(pb + 3) { pg8::EpiProjRope E{C.ws, NPROJ}; run_gemm(C, XB, (const bf16_t*)(wb + W_IN), NPROJ, DM, E); } PH_END(pb + 3)
        PH_BEGIN(pb + 4) attn_prep_phase(C, args, L); PH_END(pb + 4)
        PH_BEGIN(pb + 5) cmp_attn_phase(C, L); PH_END(pb + 5)
        PH_BEGIN(pb + 6) attn_phase(C, args, L); PH_END(pb + 6)
        PH_BEGIN(pb + 7) { pg8::EpiResid E{X, X, DN_ALPHA, 1.0f, (const float*)(C.ws + WS_LNST), args->in[2] + (size_t)(L * 3 + 0) * DM, args->in[3] + (size_t)(L * 3 + 0) * DM}; run_gemm(C, MIX, (const bf16_t*)(wb + W_OUT), DM, DM, E); } PH_END(pb + 7)
        PH_BEGIN(pb + 8) ln_phase(C, X, XB, args->in[2] + (size_t)(L * 3 + 1) * DM, args->in[3] + (size_t)(L * 3 + 1) * DM); PH_END(pb + 8)
        PH_BEGIN(pb + 9) { pg8::EpiSwiGLU E{BIG, DFFP}; run_gemm(C, XB, (const bf16_t*)(wb + W_UP2), NUP, DM, E); } PH_END(pb + 9)
        PH_BEGIN(pb + 10) { pg8::EpiResid E{X, X, DN_ALPHA, 0.5f, (const float*)(C.ws + WS_LNST), args->in[2] + (size_t)(L * 3 + 1) * DM, args->in[3] + (size_t)(L * 3 + 1) * DM}; run_gemm(C, BIG, (const bf16_t*)(wb + W_DN2), DM, DFFP, E); } PH_END(pb + 10)
        PH_BEGIN(pb + 11) { ln_phase(C, X, XB, args->in[2] + (size_t)(L * 3 + 2) * DM, args->in[3] + (size_t)(L * 3 + 2) * DM); __syncthreads();
            pg8::EpiBf16 E{BIG, DM}; run_gemm(C, (const bf16_t*)(C.ws + WS_PB) + (size_t)L * MTOK * PLED, (const bf16_t*)(wb + W_PLEP), DM, PLED, E, true); } PH_END(pb + 11)
        PH_BEGIN(pb + 12) { pg8::EpiPle E{X, X, L == DEPTH - 1 ? (bf16_t*)nullptr : MIX, args->in[22] + (size_t)L * DM, BIG, (const float*)(C.ws + WS_LNST), args->in[2] + (size_t)(L * 3 + 2) * DM, args->in[3] + (size_t)(L * 3 + 2) * DM}; run_gemm(C, XB, (const bf16_t*)(wb + W_PLEG), DM, DM, E); } PH_END(pb + 12)
    }
}

#ifndef MK_SPLIT
#define MK_SPLIT 0
#endif
extern "C" void kernel_launch(void* const* d_in, const int* in_sizes, int n_in, void* d_out, int out_size, void* d_ws, size_t ws_size, hipStream_t stream) {
    static int grid = 0;
    if (grid == 0) {
        if (n_in != 24 || out_size != MTOK * DM || ws_size < WS_END) { fprintf(stderr, "kernel_launch: unexpected shapes (n_in %d out %d ws %zu)\n", n_in, out_size, ws_size); grid = -1; return; }
        if (hipFuncSetAttribute((const void*)mega_fwd, hipFuncAttributeMaxDynamicSharedMemorySize, LDS_BYTES) != hipSuccess) { fprintf(stderr, "kernel_launch: hipFuncSetAttribute failed\n"); grid = -1; return; }
        int dev = 0, cus = 0, per_cu = 0; hipGetDevice(&dev); hipDeviceGetAttribute(&cus, hipDeviceAttributeMultiprocessorCount, dev);
        hipOccupancyMaxActiveBlocksPerMultiprocessor(&per_cu, (const void*)mega_fwd, 512, LDS_BYTES);
        if (per_cu < 1) { fprintf(stderr, "kernel_launch: occupancy query says %d blocks/CU\n", per_cu); per_cu = 1; }
        (void)hipGetLastError();
        grid = cus;
    }
    if (grid < 0) return;
    hipMemsetAsync((char*)d_ws + WS_CTL, 0, 1 * MiB, stream);
    Args a{};
    for (int i = 0; i < 24; ++i) a.in[i] = (const float*)d_in[i];
    a.out = (float*)d_out; a.ws = (unsigned char*)d_ws;
#if MK_SPLIT
    for (int p = 0; p < N_PHASES; ++p) { a.ph_lo = p; a.ph_hi = p + 1; hipLaunchKernelGGL(mega_fwd, dim3(grid), dim3(512), LDS_BYTES, stream, a); }
#else
    a.ph_lo = 0; a.ph_hi = N_PHASES;
    void* kargs[] = {&a};
    hipError_t e = hipLaunchCooperativeKernel((const void*)mega_fwd, dim3(grid), dim3(512), kargs, LDS_BYTES, stream);
    if (e != hipSuccess) fprintf(stderr, "cooperative launch failed: %s (grid %d)\n", hipGetErrorString(e), grid);
#endif
}
```

```cpp
#include <hip/hip_runtime.h>
#include <hip/hip_cooperative_groups.h>
#include <cstdio>
#include <cstdint>
#include <cmath>
namespace cg = cooperative_groups;

constexpr size_t K_WS_BIG = (size_t)484 << 20, K_WS_TBL = (size_t)1 << 20, K_TB_COS64 = 0, K_TB_SIN64 = 256 * 1024, K_TB_COS32 = 512 * 1024, K_TB_SIN32 = 640 * 1024;

namespace pg8 {
#define PG8_LAS __attribute__((address_space(3)))
typedef unsigned short bf16_t;
typedef short bf16x8 __attribute__((ext_vector_type(8)));
typedef float f32x4 __attribute__((ext_vector_type(4)));
typedef unsigned u32x4 __attribute__((ext_vector_type(4)));
constexpr int BM = 256, BK = 64, HALF = 128, HTB = HALF * BK * 2  , STAGE_BYTES = 8 * HTB, NXCD = 8, WGM = 8;

__host__ __device__ __forceinline__ int lds_byte(int r, int c) { const int st = (r >> 4) * 2 + (c >> 5), rr = r & 15, cc = c & 31, ob = rr * 64 + cc * 2; return st * 1024 + (ob ^ (((ob >> 9) & 1) << 5)); }
__host__ __device__ __forceinline__ void stage_rc(int b, int& R, int& C) { const int st = b / 1024, sb = b % 1024, swz = sb ^ (((sb >> 9) & 1) << 5); R = (st >> 1) * 16 + swz / 64; C = (st & 1) * 32 + (swz % 64) / 2; }
__host__ __device__ __forceinline__ int perm32(int rho) { const int n = rho >> 4, i = rho & 15; return 8 * (i >> 2) + 4 * n + (i & 3); }

struct Unit { int pm, pn; };
struct Gemm { const bf16_t* A; const bf16_t* Bt; int M, N, K; };

struct StaticOrder {
    int nM, nN, nwg, G, c;
    __host__ __device__ void init(int M, int N, int G_, int c_) { nM = M / BM; nN = N / BM; nwg = nM * nN; G = G_; c = c_; }
    __host__ __device__ bool next(int i, Unit& u) const {
        const long L = (long)i * G + c; if (L >= nwg) return false;
        int wgid = (int)L; { const int q = nwg / NXCD, r = nwg % NXCD, xcd = wgid % NXCD, off = wgid / NXCD; wgid = (xcd < r ? xcd * (q + 1) : r * (q + 1) + (xcd - r) * q) + off; }
        const int nig = WGM * nN, gid = wgid / nig, fm = gid * WGM, gsz = (nM - fm) < WGM ? (nM - fm) : WGM;
        u.pm = fm + ((wgid % nig) % gsz); u.pn = (wgid % nig) / gsz; return true;
    }
    __device__ __forceinline__ void a_ready(const Unit&) const {}
    __device__ __forceinline__ void done(const Unit&) const {}
};

__device__ __forceinline__ unsigned cvt_pk_bf16(float lo, float hi) { unsigned r; asm volatile("v_cvt_pk_bf16_f32 %0, %1, %2" : "=v"(r) : "v"(lo), "v"(hi)); return r; }
typedef unsigned u32x2 __attribute__((ext_vector_type(2)));
typedef float f32x2 __attribute__((ext_vector_type(2)));
struct EpiBf16 {
    static constexpr bool PERM = true, AFTER_DRAIN = false;
    bf16_t* O; int ldc;
    __device__ __forceinline__ void operator()(const f32x4 (&acc)[2][2][4][2], const Unit& u, int wr, int wc, int fr, int fq) const {
        const int row0 = u.pm * BM + wr * 64 + fr; const int col0 = u.pn * BM + wc * 32 + 8 * fq;
#pragma unroll
        for (int ai = 0; ai < 2; ++ai)
#pragma unroll
            for (int m = 0; m < 4; ++m) { bf16_t* rowp = O + (size_t)(row0 + ai * HALF + m * 16) * ldc + col0;
#pragma unroll
                for (int bj = 0; bj < 2; ++bj) { const f32x4 v0 = acc[ai][bj][m][0], v1 = acc[ai][bj][m][1];
                    u32x4 w; w.x = cvt_pk_bf16(v0[0], v0[1]); w.y = cvt_pk_bf16(v0[2], v0[3]); w.z = cvt_pk_bf16(v1[0], v1[1]); w.w = cvt_pk_bf16(v1[2], v1[3]);
                    *(u32x4*)(rowp + bj * HALF) = w; } __builtin_amdgcn_sched_barrier(0); }
    }
};
__device__ __forceinline__ int proj_seg_type(int s) { return (s < 4 || s == 6 || s == 8) ? 1 : ((s >= 10 && s < 18) ? 2 : 0); }
struct EpiProjRope {
    static constexpr bool PERM = true, AFTER_DRAIN = false;
    unsigned char* ws; int ldc;
    __device__ __forceinline__ void operator()(const f32x4 (&acc)[2][2][4][2], const Unit& u, int wr, int wc, int fr, int fq) const {
        asm volatile("" : "+v"(fr), "+v"(fq));
        unsigned char* w_ = ws; asm volatile("" : "+s"(w_));
        bf16_t* O = (bf16_t*)(w_ + ::K_WS_BIG); const float* cos64 = (const float*)(w_ + ::K_WS_TBL + ::K_TB_COS64); const float* sin64 = (const float*)(w_ + ::K_WS_TBL + ::K_TB_SIN64);
        const float* cos32 = (const float*)(w_ + ::K_WS_TBL + ::K_TB_COS32); const float* sin32 = (const float*)(w_ + ::K_WS_TBL + ::K_TB_SIN32);
        const int s = u.pn * 4 + wc, ty = proj_seg_type(s);
        const int row0 = u.pm * BM + wr * 64 + fr;
        const int d0 = (ty == 2) ? 64 * s + 32 * (fq >> 1) + 8 * (fq & 1) : 64 * s + 8 * fq;
        const int dstep = (ty == 2) ? 16 : 32;
        const float* ct = (ty == 2) ? cos32 : cos64; const float* st = (ty == 2) ? sin32 : sin64;
        const int tw = (ty == 2) ? 16 : 32, i0 = (ty == 2) ? 8 * (fq & 1) : 8 * fq;
#pragma unroll
        for (int ai = 0; ai < 2; ++ai)
#pragma unroll
            for (int m = 0; m < 4; ++m) { const int row = row0 + ai * HALF + m * 16; bf16_t* rowp = O + (size_t)row * ldc + d0; const int pos = row & 2047;
#pragma unroll
                for (int n = 0; n < 2; ++n) { f32x4 x1 = acc[ai][0][m][n], x2 = acc[ai][1][m][n];
                    if (ty != 0) { const f32x4 cv = *(const f32x4*)(ct + pos * tw + i0 + 4 * n), sv = *(const f32x4*)(st + pos * tw + i0 + 4 * n);
                        const f32x4 y1 = x1 * cv - x2 * sv, y2 = x2 * cv + x1 * sv; x1 = y1; x2 = y2; }
                    u32x2 w; w.x = cvt_pk_bf16(x1[0], x1[1]); w.y = cvt_pk_bf16(x1[2], x1[3]); *(u32x2*)(rowp + 4 * n) = w;
                    w.x = cvt_pk_bf16(x2[0], x2[1]); w.y = cvt_pk_bf16(x2[2], x2[3]); *(u32x2*)(rowp + dstep + 4 * n) = w;
                    __builtin_amdgcn_sched_barrier(0); } }
    }
};
__device__ __forceinline__ float silu_mul(float g, float uu) { return g * uu * __builtin_amdgcn_rcpf(1.0f + __builtin_amdgcn_exp2f(-1.44269504f * g)); }
struct EpiSwiGLU {
    static constexpr bool PERM = true, AFTER_DRAIN = false;
    bf16_t* H; int ldh;
    __device__ __forceinline__ void operator()(const f32x4 (&acc)[2][2][4][2], const Unit& u, int wr, int wc, int fr, int fq) const {
        const int row0 = u.pm * BM + wr * 64 + fr; const int col0 = u.pn * HALF + wc * 32 + 8 * fq;
#pragma unroll
        for (int ai = 0; ai < 2; ++ai)
#pragma unroll
            for (int m = 0; m < 4; ++m) { bf16_t* rowp = H + (size_t)(row0 + ai * HALF + m * 16) * ldh + col0;
                const f32x4 g0 = acc[ai][0][m][0], g1 = acc[ai][0][m][1], u0 = acc[ai][1][m][0], u1 = acc[ai][1][m][1];
                u32x4 w; w.x = cvt_pk_bf16(silu_mul(g0[0], u0[0]), silu_mul(g0[1], u0[1])); w.y = cvt_pk_bf16(silu_mul(g0[2], u0[2]), silu_mul(g0[3], u0[3]));
                w.z = cvt_pk_bf16(silu_mul(g1[0], u1[0]), silu_mul(g1[1], u1[1])); w.w = cvt_pk_bf16(silu_mul(g1[2], u1[2]), silu_mul(g1[3], u1[3]));
                *(u32x4*)rowp = w; __builtin_amdgcn_sched_barrier(0); }
    }
};
struct EpiResid {
    static constexpr bool PERM = false, AFTER_DRAIN = false;
    const float* X; float* Y; float alpha, s; const bf16_t* XBs; const float* g; const float* b;
    const float* ST_unused = nullptr;
    __device__ __forceinline__ void operator()(const f32x4 (&acc)[2][2][4][2], const Unit& u, int wr, int wc, int fr, int fq) const {
        const int col0 = u.pn * BM + wc * 32 + 4 * fq;
#pragma unroll
        for (int ai = 0; ai < 2; ++ai)
#pragma unroll
            for (int m = 0; m < 4; ++m) { const int row = u.pm * BM + ai * HALF + wr * 64 + m * 16 + fr; const size_t off = (size_t)row * 1024 + col0;
#pragma unroll
                for (int bj = 0; bj < 2; ++bj)
#pragma unroll
                    for (int n = 0; n < 2; ++n) { f32x4 xv;
                        if (XBs) { const u32x2 pw = *(const u32x2*)(XBs + off + bj * HALF + n * 16); xv[0] = __uint_as_float(pw.x << 16); xv[1] = __uint_as_float(pw.x & 0xffff0000u); xv[2] = __uint_as_float(pw.y << 16); xv[3] = __uint_as_float(pw.y & 0xffff0000u); }
                        else xv = *(const f32x4*)(X + off + bj * HALF + n * 16);
                        *(f32x4*)(Y + off + bj * HALF + n * 16) = xv * alpha + acc[ai][bj][m][n] * s; } }
    }
};
struct EpiPle {
    static constexpr bool PERM = false, AFTER_DRAIN = false;
    const bf16_t* XBs; float* OUT; bf16_t* XB; const float* bias; const bf16_t* PP;
    __device__ __forceinline__ void operator()(const f32x4 (&acc)[2][2][4][2], const Unit& u, int wr, int wc, int fr, int fq) const {
        const int col0 = u.pn * BM + wc * 32 + 4 * fq;
#pragma unroll
        for (int ai = 0; ai < 2; ++ai)
#pragma unroll
            for (int m = 0; m < 4; ++m) { const int row = u.pm * BM + ai * HALF + wr * 64 + m * 16 + fr; const size_t off = (size_t)row * 1024 + col0;
#pragma unroll
                for (int bj = 0; bj < 2; ++bj)
#pragma unroll
                    for (int n = 0; n < 2; ++n) { const int co = bj * HALF + n * 16;
                        f32x4 xv; { const u32x2 xw = *(const u32x2*)(XBs + off + co); xv[0] = __uint_as_float(xw.x << 16); xv[1] = __uint_as_float(xw.x & 0xffff0000u); xv[2] = __uint_as_float(xw.y << 16); xv[3] = __uint_as_float(xw.y & 0xffff0000u); }
                        const f32x4 bv = *(const f32x4*)(bias + col0 + co);
                        const u32x2 pw = *(const u32x2*)(PP + off + co);
                        f32x4 pv; pv[0] = __uint_as_float(pw.x << 16); pv[1] = __uint_as_float(pw.x & 0xffff0000u); pv[2] = __uint_as_float(pw.y << 16); pv[3] = __uint_as_float(pw.y & 0xffff0000u);
                        f32x4 o;
#pragma unroll
                        for (int e = 0; e < 4; ++e) { const float z = acc[ai][bj][m][n][e] + bv[e]; const float sg = __builtin_amdgcn_rcpf(1.0f + __builtin_amdgcn_exp2f(-1.44269504f * z)); o[e] = xv[e] + sg * pv[e]; }
                        *(f32x4*)(OUT + off + co) = o;
                        if (XB) { u32x2 w; w.x = cvt_pk_bf16(o[0], o[1]); w.y = cvt_pk_bf16(o[2], o[3]); *(u32x2*)(XB + off + co) = w; } } }
    }
};
template <class Epi, class Sched, bool ALIGN_EPI = false, bool SP2 = false>
__device__ __forceinline__ void gemm_phase(PG8_LAS unsigned char* lds, const Gemm g, const Sched& S, const Epi& E, const int tid_in) {
    int tid_ = tid_in; asm volatile("" : "+v"(tid_));
    const int tid = tid_, wid = __builtin_amdgcn_readfirstlane(tid >> 6), lane = tid & 63, wr = wid >> 2, wc = wid & 3, fr = lane & 15, fq = lane >> 4;
    const int K = g.K, nt = K / BK;
    unsigned voffA[2], voffB[2];
#pragma unroll
    for (int i = 0; i < 2; ++i) { int R, C; stage_rc(tid * 16 + i * 8192, R, C); const int Rb = Epi::PERM ? ((R & ~31) + perm32(R & 31)) : R;
        voffA[i] = (unsigned)(R * K + C) * 2u; voffB[i] = (unsigned)(Rb * K + C) * 2u; }
    const size_t kstep = (size_t)(BK * 2);
    const size_t hstep = (size_t)HALF * K * 2;
    const size_t tstep = 2 * hstep;
    const unsigned ldsw = (unsigned)wid * 1024u;
    const int aoff = lds_byte(wr * 64 + fr, fq * 8), boff = lds_byte(wc * 32 + fr, fq * 8);
#define PG8_SA(b, h) (((b) * 2 + (h)) * HTB)
#define PG8_SB(b, h) ((4 + (b) * 2 + (h)) * HTB)
#define PG8_STAGE(bufoff, gbase, voff) do { _Pragma("unroll") for (int _i = 0; _i < 2; ++_i) \
        __builtin_amdgcn_global_load_lds((const unsigned*)((const char*)(gbase) + (voff)[_i]), (PG8_LAS unsigned*)(lds + (bufoff) + ldsw + _i * 8192), 16, 0, 0); } while (0)
#define PG8_LDA(dst, b, h) do { _Pragma("unroll") for (int m = 0; m < 4; ++m) _Pragma("unroll") for (int k = 0; k < 2; ++k) dst[m][k] = *(const PG8_LAS bf16x8*)(lds + PG8_SA(b, h) + aoff + m * 2048 + k * 1024); } while (0)
#define PG8_LDB(dst, b, h) do { _Pragma("unroll") for (int n = 0; n < 2; ++n) _Pragma("unroll") for (int k = 0; k < 2; ++k) dst[n][k] = *(const PG8_LAS bf16x8*)(lds + PG8_SB(b, h) + boff + n * 2048 + k * 1024); } while (0)
#define PG8_MMA(ai, bj, At, Bt) do { __builtin_amdgcn_s_setprio(1); _Pragma("unroll") for (int m = 0; m < 4; ++m) _Pragma("unroll") for (int n = 0; n < 2; ++n) _Pragma("unroll") for (int k = 0; k < 2; ++k) \
        acc[ai][bj][m][n] = __builtin_amdgcn_mfma_f32_16x16x32_bf16(Bt[n][k], At[m][k], acc[ai][bj][m][n], 0, 0, 0); __builtin_amdgcn_s_setprio(0); } while (0)
#define PG8_WAIT_V(n) asm volatile("s_waitcnt vmcnt(" #n ")" ::: "memory")
#define PG8_WAIT_L(n) asm volatile("s_waitcnt lgkmcnt(" #n ")" ::: "memory")
#define PG8_BAR __builtin_amdgcn_s_barrier()
#define PG8_SCHED __builtin_amdgcn_sched_barrier(0)
    Unit cur, nxt; int ui = 0;
    if (!S.next(0, cur)) return;
    f32x4 acc[2][2][4][2];
#pragma unroll
    for (int a = 0; a < 2; ++a)
#pragma unroll
        for (int b = 0; b < 2; ++b)
#pragma unroll
            for (int m = 0; m < 4; ++m)
#pragma unroll
                for (int n = 0; n < 2; ++n) acc[a][b][m][n] = (f32x4){0.f, 0.f, 0.f, 0.f};
    bf16x8 At[4][2], B0[2][2], B1[2][2];
    const char* cA = (const char*)g.A + (size_t)cur.pm * tstep; const char* cB = (const char*)g.Bt + (size_t)cur.pn * tstep;
    S.a_ready(cur);
    if constexpr (SP2) {
        PG8_STAGE(PG8_SB(0, 0), cB, voffB); PG8_STAGE(PG8_SB(0, 1), cB + hstep, voffB); PG8_STAGE(PG8_SA(0, 0), cA, voffA); PG8_STAGE(PG8_SA(0, 1), cA + hstep, voffA);
        if (wr == 1) PG8_BAR;
        PG8_WAIT_V(2); PG8_BAR;
        PG8_STAGE(PG8_SB(1, 0), cB + kstep, voffB); PG8_STAGE(PG8_SA(1, 0), cA + kstep, voffA); PG8_STAGE(PG8_SB(1, 1), cB + hstep + kstep, voffB);
        PG8_WAIT_V(6); PG8_BAR;
    } else {
        PG8_STAGE(PG8_SB(0, 0), cB, voffB); PG8_STAGE(PG8_SA(0, 0), cA, voffA); PG8_STAGE(PG8_SB(0, 1), cB + hstep, voffB); PG8_STAGE(PG8_SA(0, 1), cA + hstep, voffA);
        if (wr == 1) PG8_BAR;
        PG8_WAIT_V(4); PG8_BAR;
        PG8_STAGE(PG8_SB(1, 0), cB + kstep, voffB); PG8_STAGE(PG8_SA(1, 0), cA + kstep, voffA); PG8_STAGE(PG8_SB(1, 1), cB + hstep + kstep, voffB);
        PG8_WAIT_V(6); PG8_BAR;
    }
    for (;;) {
        const bool has_next = S.next(ui + 1, nxt);
        const char* nA = has_next ? (const char*)g.A + (size_t)nxt.pm * tstep : cA; const char* nB = has_next ? (const char*)g.Bt + (size_t)nxt.pn * tstep : cB;
        for (int t = 0; t < nt; t += 2) {
            const bool last = (t == nt - 2);
            const char* a1 = cA + (size_t)(t + 1) * kstep;
            const char* a2 = last ? nA : cA + (size_t)(t + 2) * kstep; const char* b2 = last ? nB : cB + (size_t)(t + 2) * kstep;
            const char* a3 = a2 + kstep; const char* b3 = b2 + kstep;
            if (last && has_next) S.a_ready(nxt);
            if constexpr (SP2) {
            PG8_LDB(B0, 0, 0); PG8_LDB(B1, 0, 1); PG8_SCHED; PG8_LDA(At, 0, 0); PG8_STAGE(PG8_SA(1, 1), a1 + hstep, voffA);
            PG8_WAIT_V(8); PG8_WAIT_L(0); PG8_BAR; PG8_MMA(0, 0, At, B0); PG8_MMA(0, 1, At, B1); PG8_BAR; PG8_SCHED;
            PG8_LDA(At, 0, 1); PG8_STAGE(PG8_SB(0, 0), b2, voffB); PG8_STAGE(PG8_SB(0, 1), b2 + hstep, voffB); PG8_STAGE(PG8_SA(0, 0), a2, voffA);
            PG8_WAIT_V(8); PG8_WAIT_L(0); PG8_BAR; PG8_MMA(1, 0, At, B0); PG8_MMA(1, 1, At, B1); PG8_BAR; PG8_SCHED;
            PG8_LDB(B0, 1, 0); PG8_LDB(B1, 1, 1); PG8_SCHED; PG8_LDA(At, 1, 0); PG8_STAGE(PG8_SA(0, 1), a2 + hstep, voffA);
            PG8_WAIT_V(8); PG8_WAIT_L(0); PG8_BAR; PG8_MMA(0, 0, At, B0); PG8_MMA(0, 1, At, B1); PG8_BAR; PG8_SCHED;
            PG8_LDA(At, 1, 1); PG8_STAGE(PG8_SB(1, 0), b3, voffB); PG8_STAGE(PG8_SB(1, 1), b3 + hstep, voffB); PG8_STAGE(PG8_SA(1, 0), a3, voffA);
            PG8_WAIT_V(8); PG8_WAIT_L(0); PG8_BAR; PG8_MMA(1, 0, At, B0); PG8_MMA(1, 1, At, B1); PG8_BAR; PG8_SCHED;
            } else {
            PG8_LDB(B0, 0, 0); PG8_SCHED; PG8_LDA(At, 0, 0); PG8_STAGE(PG8_SA(1, 1), a1 + hstep, voffA);
            PG8_WAIT_L(8); PG8_BAR; PG8_WAIT_L(0); PG8_MMA(0, 0, At, B0); PG8_BAR; PG8_SCHED;
            PG8_LDB(B1, 0, 1); PG8_STAGE(PG8_SB(0, 0), b2, voffB);
            PG8_BAR; PG8_WAIT_L(0); PG8_MMA(0, 1, At, B1); PG8_BAR;
            PG8_LDA(At, 0, 1); PG8_STAGE(PG8_SA(0, 0), a2, voffA);
            PG8_BAR; PG8_WAIT_L(0); PG8_MMA(1, 0, At, B0); PG8_BAR; PG8_SCHED;
            PG8_STAGE(PG8_SB(0, 1), b2 + hstep, voffB);
            PG8_WAIT_V(6); PG8_BAR; PG8_MMA(1, 1, At, B1); PG8_BAR;
            PG8_LDB(B0, 1, 0); PG8_SCHED; PG8_LDA(At, 1, 0); PG8_STAGE(PG8_SA(0, 1), a2 + hstep, voffA);
            PG8_WAIT_L(8); PG8_BAR; PG8_WAIT_L(0); PG8_MMA(0, 0, At, B0); PG8_BAR; PG8_SCHED;
            PG8_LDB(B1, 1, 1); PG8_STAGE(PG8_SB(1, 0), b3, voffB);
            PG8_BAR; PG8_WAIT_L(0); PG8_MMA(0, 1, At, B1); PG8_BAR;
            PG8_LDA(At, 1, 1); PG8_STAGE(PG8_SA(1, 0), a3, voffA);
            PG8_BAR; PG8_WAIT_L(0); PG8_MMA(1, 0, At, B0); PG8_BAR; PG8_SCHED;
            PG8_STAGE(PG8_SB(1, 1), b3 + hstep, voffB);
            PG8_WAIT_V(6); PG8_BAR; PG8_MMA(1, 1, At, B1); PG8_BAR;
            }
        }
        if constexpr (ALIGN_EPI) { if (wr == 0) PG8_BAR; }
        if constexpr (!Epi::AFTER_DRAIN) { E(acc, cur, wr, wc, fr, fq); S.done(cur); }
        if (!has_next) break;
#pragma unroll
        for (int a = 0; a < 2; ++a)
#pragma unroll
            for (int b = 0; b < 2; ++b)
#pragma unroll
                for (int m = 0; m < 4; ++m)
#pragma unroll
                    for (int n = 0; n < 2; ++n) acc[a][b][m][n] = (f32x4){0.f, 0.f, 0.f, 0.f};
        cur = nxt; cA = nA; cB = nB; ++ui;
        if constexpr (ALIGN_EPI) { if (wr == 1) PG8_BAR; }
    }
    PG8_WAIT_V(0);
    if constexpr (!ALIGN_EPI) { if (wr == 0) PG8_BAR; }
    PG8_BAR;
    if constexpr (Epi::AFTER_DRAIN) { E.fused(acc, cur, wr, wc, fr, fq, lds, wid, lane); S.done(cur); }
#undef PG8_SA
#undef PG8_SB
#undef PG8_STAGE
#undef PG8_LDA
#undef PG8_LDB
#undef PG8_MMA
#undef PG8_WAIT_V
#undef PG8_WAIT_L
#undef PG8_BAR
#undef PG8_SCHED
}
}
#define DI __device__ __forceinline__
#define LAS __attribute__((address_space(3)))
typedef unsigned short bf16_t;
typedef short bf16x8 __attribute__((ext_vector_type(8)));
typedef short s16x4 __attribute__((ext_vector_type(4)));
typedef float f32x2 __attribute__((ext_vector_type(2)));
typedef float f32x4 __attribute__((ext_vector_type(4)));
typedef float f32x16 __attribute__((ext_vector_type(16)));
typedef unsigned u32x2 __attribute__((ext_vector_type(2)));
typedef unsigned u32x4 __attribute__((ext_vector_type(4)));
typedef __bf16 bf16x2_t __attribute__((ext_vector_type(2)));

constexpr int DM = 1024, BATCH = 32, SEQ = 2048, DEPTH = 2, MTOK = BATCH * SEQ, DFF = 2752, DFFP = 2816, NUP = 2 * DFFP, NPROJ = 3072, PLED = 256;
constexpr int IN_COLS = 2964;
constexpr int C_NQ = 0, C_NKV = 256, C_DQ = 640, C_DK = 896, C_DV = 1152, C_FQ = 1408, C_FK = 1920, C_FV = 2432, C_NG = 2944, C_FF = 2956;
constexpr float LN_EPS = 1e-5f;
constexpr float DN_ALPHA = 1.41421356237f;
constexpr float LOG2E = 1.44269504089f;

constexpr size_t MiB = 1u << 20;
constexpr size_t WS_CTL = 0;
constexpr size_t WS_TBL = 1 * MiB;
constexpr size_t TB_COS64 = 0, TB_SIN64 = 256 * 1024, TB_COS32 = 512 * 1024, TB_SIN32 = 640 * 1024, TB_CBIAS = 768 * 1024, TB_LAM = 772 * 1024;
constexpr size_t WS_KC = 2 * MiB, WS_VC = 2 * MiB + 512 * 1024;
constexpr size_t WS_SEL = 3 * MiB;
constexpr size_t WS_CKL = 4 * MiB;
constexpr size_t WS_W = 8 * MiB, W_LAYER = 46 * MiB;
constexpr size_t W_UP1 = 0, W_DN1 = 11 * MiB, W_UP2 = W_DN1 + 5632 * 1024, W_DN2 = W_UP2 + 11 * MiB, W_IN = W_DN2 + 5632 * 1024, W_OUT = W_IN + 6 * MiB,
                 W_PLEG = W_OUT + 2 * MiB, W_PLEP = W_PLEG + 2 * MiB, W_K1 = W_PLEP + 512 * 1024, W_V1 = W_K1 + 1 * MiB, W_K2 = W_V1 + 1 * MiB, W_V2 = W_K2 + 32 * 1024;
static_assert(W_V2 + 32 * 1024 <= W_LAYER, "weights fit");
constexpr size_t WS_XB = 100 * MiB;
constexpr size_t WS_PB = 228 * MiB;
constexpr size_t WS_OCMP = 292 * MiB;
constexpr size_t WS_MIX = 356 * MiB;
constexpr size_t WS_BIG = 484 * MiB;
constexpr size_t WS_END = 868 * MiB;
constexpr size_t WS_LNST = 6 * MiB;
static_assert(K_WS_BIG == WS_BIG && K_WS_TBL == WS_TBL && K_TB_COS64 == TB_COS64 && K_TB_SIN64 == TB_SIN64 && K_TB_COS32 == TB_COS32 && K_TB_SIN32 == TB_SIN32, "epilogue offsets");
constexpr int CW_QUEUE = 64;

DI unsigned pk2(float lo, float hi) { f32x2 v = {lo, hi}; return __builtin_bit_cast(unsigned, __builtin_convertvector(v, bf16x2_t)); }
DI float bf2f(bf16_t h) { return __uint_as_float((unsigned)h << 16); }
DI bf16_t f2bf(float f) { return (bf16_t)(pk2(f, 0.f) & 0xffffu); }
DI float wave_sum(float v) {
#pragma unroll
    for (int o = 1; o < 64; o <<= 1) v += __shfl_xor(v, o);
    return v;
}
DI int crow(int i, int hh) { return (i & 3) + 8 * (i >> 2) + 4 * hh; }
#define MFMA32(a, b, c) __builtin_amdgcn_mfma_f32_32x32x16_bf16((a), (b), (c), 0, 0, 0)
#define MFMA16(a, b, c) __builtin_amdgcn_mfma_f32_16x16x32_bf16((a), (b), (c), 0, 0, 0)
#define LDS_WAIT() asm volatile("s_waitcnt lgkmcnt(0)" ::: "memory")

struct Args {
    const float* in[24]; float* out; unsigned char* ws; int ph_lo, ph_hi;
};
typedef const __attribute__((address_space(4))) Args* ARGP;
struct Ctx {
    int tid, lane, wave, bid, G;
    unsigned char* ws; LAS unsigned char* lds;
};

DI void tr_item(const float* W, int ldn, int Ksrc, int srccol, bf16_t* WT, int ldk, int k0, int nrow0, LAS float* scr, int lane) {
#pragma unroll
    for (int i = 0; i < 32; ++i) { const int kk = 2 * i + (lane >> 5), k = k0 + kk; float v = 0.f; if (srccol >= 0 && k < Ksrc) v = W[(size_t)k * ldn + srccol]; scr[kk * 33 + (lane & 31)] = v; }
    LDS_WAIT();
    const int c = lane & 7;
#pragma unroll
    for (int j = 0; j < 4; ++j) { const int n = (lane >> 3) + 8 * j; const LAS float* s = scr + (8 * c) * 33 + n;
        u32x4 o; o.x = pk2(s[0 * 33], s[1 * 33]); o.y = pk2(s[2 * 33], s[3 * 33]); o.z = pk2(s[4 * 33], s[5 * 33]); o.w = pk2(s[6 * 33], s[7 * 33]);
        *(u32x4*)(WT + (size_t)(nrow0 + n) * ldk + k0 + 8 * c) = o; }
    LDS_WAIT();
}
DI int proj_col_of_row(int n) { const int tile = n >> 8, bj = (n >> 7) & 1, wc = (n >> 5) & 3, j = n & 31, sg = tile * 4 + wc;
    return (sg >= 10 && sg < 18) ? 64 * sg + 32 * (j >> 4) + 16 * bj + (j & 15) : 64 * sg + 32 * bj + j; }
DI int win_map(int n) { return n < 640 ? n : (n < 2944 ? n + 12 : (n < 2956 ? n - 2944 + 640 : (n < 2964 ? n : -1))); }

DI void prep_phase(const Ctx& C, ARGP a) {
    LAS float* scr = (LAS float*)(C.lds + C.wave * 16384);
    const int gw = C.bid * 8 + C.wave, NGW = C.G * 8, lane = C.lane;
    constexpr int I_UP = 16 * 176, I_DN = 44 * 32, I_IN = 16 * 96, I_SQ = 16 * 32, I_PP = 4 * 32, I_P1 = 32 * 8, I_P2 = 4 * 2;
    constexpr int PER_LAYER = 2 * I_UP + 2 * I_DN + I_IN + 2 * I_SQ + I_PP + 2 * I_P1 + 2 * I_P2;
    for (int it = gw; it < DEPTH * PER_LAYER; it += NGW) {
        const int L = it / PER_LAYER; int r = it % PER_LAYER;
        unsigned char* wb = C.ws + WS_W + (size_t)L * W_LAYER;
        if (r < 2 * I_UP) { const int f = r / I_UP; r %= I_UP; const int kb = r / 176, nb = r % 176; const int n = 32 * nb + (lane & 31);
            const int pn = n >> 8, bj = (n >> 7) & 1, hid = 128 * pn + (n & 127);
            const float* src = a->in[(f ? 7 : 4) + bj] + (size_t)L * DM * DFF;
            tr_item(src, DFF, DM, hid < DFF ? hid : -1, (bf16_t*)(wb + (f ? W_UP2 : W_UP1)), DM, 64 * kb, 32 * nb, scr, lane); continue; }
        r -= 2 * I_UP;
        if (r < 2 * I_DN) { const int f = r / I_DN; r %= I_DN; const int kb = r / 32, nb = r % 32;
            const float* src = a->in[f ? 9 : 6] + (size_t)L * DFF * DM;
            tr_item(src, DM, DFF, 32 * nb + (lane & 31), (bf16_t*)(wb + (f ? W_DN2 : W_DN1)), DFFP, 64 * kb, 32 * nb, scr, lane); continue; }
        r -= 2 * I_DN;
        if (r < I_IN) { const int kb = r / 96, nb = r % 96;
            tr_item(a->in[10] + (size_t)L * DM * IN_COLS, IN_COLS, DM, win_map(proj_col_of_row(32 * nb + (lane & 31))), (bf16_t*)(wb + W_IN), DM, 64 * kb, 32 * nb, scr, lane); continue; }
        r -= I_IN;
        if (r < 2 * I_SQ) { const int f = r / I_SQ; r %= I_SQ; const int kb = r / 32, nb = r % 32;
            tr_item(a->in[f ? 21 : 20] + (size_t)L * DM * DM, DM, DM, 32 * nb + (lane & 31), (bf16_t*)(wb + (f ? W_PLEG : W_OUT)), DM, 64 * kb, 32 * nb, scr, lane); continue; }
        r -= 2 * I_SQ;
        if (r < I_PP) { const int kb = r / 32, nb = r % 32;
            tr_item(a->in[23] + (size_t)L * PLED * DM, DM, PLED, 32 * nb + (lane & 31), (bf16_t*)(wb + W_PLEP), PLED, 64 * kb, 32 * nb, scr, lane); continue; }
        r -= I_PP;
        if (r < 2 * I_P1) { const int f = r / I_P1; r %= I_P1; const int kb = r / 8, nb = r % 8;
            tr_item(a->in[f ? 16 : 14] + (size_t)L * 2048 * 256, 256, 2048, 32 * nb + (lane & 31), (bf16_t*)(wb + (f ? W_V1 : W_K1)), 2048, 64 * kb, 32 * nb, scr, lane); continue; }
        r -= 2 * I_P1;
        { const int f = r / I_P2; r %= I_P2; const int kb = r / 2, nb = r % 2;
            tr_item(a->in[f ? 17 : 15] + (size_t)L * 256 * 64, 64, 256, 32 * nb + (lane & 31), (bf16_t*)(wb + (f ? W_V2 : W_K2)), 256, 64 * kb, 32 * nb, scr, lane); }
    }
    const size_t gt = (size_t)C.bid * 512 + C.tid, NT = (size_t)C.G * 512;
    { const float* x = a->in[0]; bf16_t* xb = (bf16_t*)(C.ws + WS_XB); const float* p = a->in[1]; bf16_t* pb = (bf16_t*)(C.ws + WS_PB);
      constexpr size_t NX = (size_t)MTOK * DM / 8, NP = (size_t)DEPTH * MTOK * PLED / 8;
      for (size_t i0 = gt; i0 < NX + NP; i0 += 4 * NT) { f32x4 v[4][2];
#pragma unroll
          for (int q = 0; q < 4; ++q) { size_t i = i0 + q * NT; if (i >= NX + NP) i = gt; const float* src = i < NX ? x + i * 8 : p + (i - NX) * 8; v[q][0] = *(const f32x4*)src; v[q][1] = *(const f32x4*)(src + 4); }
#pragma unroll
          for (int q = 0; q < 4; ++q) { size_t i = i0 + q * NT; if (i >= NX + NP) i = gt; bf16_t* dst = i < NX ? xb + i * 8 : pb + (i - NX) * 8;
              u32x4 o; o.x = pk2(v[q][0][0], v[q][0][1]); o.y = pk2(v[q][0][2], v[q][0][3]); o.z = pk2(v[q][1][0], v[q][1][1]); o.w = pk2(v[q][1][2], v[q][1][3]); *(u32x4*)dst = o; } } }
    { float* tb = (float*)(C.ws + WS_TBL);
      for (size_t i = gt; i < (size_t)SEQ * 48; i += NT) {
          int pos, k; float inv; const bool big = i < (size_t)SEQ * 32; size_t j;
          if (big) { j = i; pos = (int)(i >> 5); k = (int)(i & 31); inv = exp2f(-(float)k * (13.2877123795f / 32.0f)); }
          else { j = i - (size_t)SEQ * 32; pos = (int)(j >> 4); k = (int)(j & 15); inv = exp2f(-(float)k * (13.2877123795f / 16.0f)); }
          const float ang = (float)pos * inv; double rv = (double)ang * 0.15915494309189535; rv -= floor(rv); const float fr = (float)rv;
          const float cs = __builtin_amdgcn_cosf(fr), sn = __builtin_amdgcn_sinf(fr);
          if (big) { tb[TB_COS64 / 4 + j] = cs; tb[TB_SIN64 / 4 + j] = sn; } else { tb[TB_COS32 / 4 + j] = cs; tb[TB_SIN32 / 4 + j] = sn; } } }
    { float* cb = (float*)(C.ws + WS_TBL + TB_CBIAS);
      for (int o = gw; o < DEPTH * 2 * 256; o += NGW) { const int L = o >> 9, kv = (o >> 8) & 1, n = o & 255;
          const float* pe = a->in[kv ? 13 : 12] + (size_t)L * 2048; const float* w1 = a->in[kv ? 16 : 14] + (size_t)L * 2048 * 256;
          float s = 0.f; for (int k = lane; k < 2048; k += 64) s += pe[k] * w1[(size_t)k * 256 + n];
          s = wave_sum(s); if (lane == 0) cb[o] = s; } }
    if (C.bid == 0 && C.tid < DEPTH) { const int L = C.tid; const float* lp = a->in[18] + L * 128; float s1 = 0.f, s2 = 0.f;
        for (int k = 0; k < 32; ++k) { s1 += lp[k] * lp[32 + k]; s2 += lp[64 + k] * lp[96 + k]; }
        const float li = 0.8f - 0.6f * expf(-0.3f * (float)L);
        ((float*)(C.ws + WS_TBL + TB_LAM))[L] = expf(s1) - expf(s2) + li; }
}

DI void ln_phase(const Ctx& C, const float* X, bf16_t* XB, const float* g, const float* b) {
    const int gw = C.bid * 8 + C.wave, NGW = C.G * 8, lane = C.lane;
    f32x4 gv[4], bv[4];
#pragma unroll
    for (int j = 0; j < 4; ++j) { gv[j] = *(const f32x4*)(g + 4 * lane + 256 * j); bv[j] = *(const f32x4*)(b + 4 * lane + 256 * j); }
    for (int m = gw; m < MTOK; m += NGW) {
        const float* xr = X + (size_t)m * DM + 4 * lane; f32x4 v[4]; float s = 0.f;
#pragma unroll
        for (int j = 0; j < 4; ++j) { v[j] = *(const f32x4*)(xr + 256 * j); s += (v[j][0] + v[j][1]) + (v[j][2] + v[j][3]); }
        const float mean = wave_sum(s) * (1.f / DM); float s2 = 0.f;
#pragma unroll
        for (int j = 0; j < 4; ++j) { v[j] = v[j] - mean; s2 += (v[j][0] * v[j][0] + v[j][1] * v[j][1]) + (v[j][2] * v[j][2] + v[j][3] * v[j][3]); }
        const float rstd = 1.0f / sqrtf(wave_sum(s2) * (1.f / DM) + LN_EPS);
        bf16_t* xo = XB + (size_t)m * DM + 4 * lane;
#pragma unroll
        for (int j = 0; j < 4; ++j) { const f32x4 o = v[j] * rstd * gv[j] + bv[j];
            u32x2 w; w.x = pk2(o[0], o[1]); w.y = pk2(o[2], o[3]); *(u32x2*)(xo + 256 * j) = w; }
    }
}
#define XLAS __attribute__((address_space(3)))
#define XB_TMO      128
#define XB_XCNT(j)  (256  + 64 * (j))
#define XB_XSUB(j)  (1280 + 64 * (j))
#define XB_XGEN(j)  (2304 + 64 * (j))
#define XB_TOP      3328
#define XB_TOPGEN   3392
#define XCD_BAR_WORDS 3456
#define XB_SPIN_CAP (1u << 18)

__device__ __forceinline__ unsigned xb_ld(unsigned* p)              { return __hip_atomic_load(p, __ATOMIC_RELAXED, __HIP_MEMORY_SCOPE_AGENT); }
__device__ __forceinline__ unsigned xb_add(unsigned* p, unsigned v) { return __hip_atomic_fetch_add(p, v, __ATOMIC_RELAXED, __HIP_MEMORY_SCOPE_AGENT); }
__device__ __forceinline__ unsigned xb_xcc_id() { return (unsigned)__builtin_amdgcn_s_getreg((3 << 11) | 20) & 0xFu; }
#define XB_SPIN(cond, bar) do { unsigned _sp = 0; while (cond) { __builtin_amdgcn_s_sleep(1); \
    if ((++_sp & 255u) == 0u) { if (xb_ld(&(bar)[XB_TMO])) break; if (_sp > XB_SPIN_CAP) { atomicAdd(&(bar)[XB_TMO], 1u); break; } } } } while (0)

struct XcdBarrier {
    unsigned* bar; unsigned x;
    volatile XLAS unsigned* st;
};

__device__ __forceinline__ XcdBarrier xcd_barrier_post(unsigned* bar, volatile XLAS unsigned* st) {
    XcdBarrier b; b.bar = bar; b.x = xb_xcc_id(); b.st = st;
    if (threadIdx.x == 0) (void)xb_add(&bar[XB_XCNT(b.x)], 1u);
    return b;
}
__device__ __forceinline__ void xcd_barrier_complete(unsigned* bar, unsigned x, unsigned& nloc, unsigned& nx) {
    const unsigned G = gridDim.x * gridDim.y * gridDim.z;
    unsigned sum, cnt, mine, sp = 0u;
    for (;;) {
        sum = 0u; cnt = 0u; mine = 0u;
#pragma unroll
        for (unsigned j = 0; j < 16; ++j) { const unsigned c = xb_ld(&bar[XB_XCNT(j)]); sum += c; cnt += (c > 0u) ? 1u : 0u; mine = (j == x) ? c : mine; }
        if (sum == G) break;
        __builtin_amdgcn_s_sleep(1);
        if ((++sp & 255u) == 0u) { if (xb_ld(&bar[XB_TMO])) break; if (sp > XB_SPIN_CAP) { atomicAdd(&bar[XB_TMO], 1u); break; } }
    }
    nloc = mine > 0u ? mine : 1u; nx = cnt > 0u ? cnt : 1u;
}

__device__ __forceinline__ void xcd_barrier(const XcdBarrier& b) {
    asm volatile("s_waitcnt vmcnt(0)" ::: "memory");
    __syncthreads();
    if (threadIdx.x == 0) {
        unsigned* bar = b.bar;
        __builtin_amdgcn_s_waitcnt(0);
        unsigned nloc = b.st[0], nx = b.st[1];
        if (nloc == 0u) { xcd_barrier_complete(bar, b.x, nloc, nx); b.st[0] = nloc; b.st[1] = nx; }
        const unsigned old = xb_add(&bar[XB_XSUB(b.x)], 1u);
        const unsigned gen = old / nloc;
        if (old + 1u == (gen + 1u) * nloc) {
            __builtin_amdgcn_fence(__ATOMIC_RELEASE, "agent");
            asm volatile("s_waitcnt vmcnt(0)" ::: "memory");
            const unsigned og = xb_add(&bar[XB_TOP], 1u);
            const unsigned tg = og / nx;
            if (og + 1u == (tg + 1u) * nx) xb_add(&bar[XB_TOPGEN], 1u);
            else XB_SPIN(xb_ld(&bar[XB_TOPGEN]) == tg, bar);
            __builtin_amdgcn_fence(__ATOMIC_ACQUIRE, "agent");
            xb_add(&bar[XB_XGEN(b.x)], 1u);
            asm volatile("s_waitcnt vmcnt(0)" ::: "memory");
        } else {
            XB_SPIN(xb_ld(&bar[XB_XGEN(b.x)]) == gen, bar);
            __builtin_amdgcn_fence(__ATOMIC_ACQUIRE, "agent");
            asm volatile("s_waitcnt vmcnt(0)" ::: "memory");
        }
    }
    __syncthreads();
}
DI float gelu_tanh(float x) { const float z = 0.7978845608f * (x + 0.044715f * x * x * x); const float e = __builtin_amdgcn_exp2f(2.0f * LOG2E * z); return 0.5f * x * (2.0f - 2.0f * __builtin_amdgcn_rcpf(e + 1.0f)); }

DI void cmp_mlp_unit(const Ctx& C, const bf16_t* proj, int b, int cgp, int kv, const bf16_t* W1t, const bf16_t* W2t, const float* bias, bf16_t* outp, const float* cos64, const float* sin64) {
    constexpr int SP = 72, HP = 264;
    LAS bf16_t* span = (LAS bf16_t*)C.lds;
    LAS bf16_t* Hs = (LAS bf16_t*)(C.lds + 528 * SP * 2);
    LAS float* Os = (LAS float*)(C.lds + 528 * SP * 2 + 32 * HP * 2);
    const int tid = C.tid, lane = C.lane, w = C.wave, row16 = lane & 15, quad = lane >> 4;
    const int t0 = 512 * cgp;
    for (int idx = tid; idx < 528 * 8; idx += 512) { const int tr = idx >> 3, ch = idx & 7, t = t0 + tr; u32x4 v = {0u, 0u, 0u, 0u};
        if (t < SEQ) v = *(const u32x4*)(proj + (size_t)(b * SEQ + t) * NPROJ + C_NKV + kv * 64 + ch * 8);
        *(LAS u32x4*)(span + tr * SP + ch * 8) = v; }
    __syncthreads();
    f32x4 acc[2][2];
#pragma unroll
    for (int i = 0; i < 2; ++i)
#pragma unroll
        for (int j = 0; j < 2; ++j) acc[i][j] = (f32x4){0.f, 0.f, 0.f, 0.f};
    const bf16_t* wb0 = W1t + (size_t)(32 * w + row16) * 2048 + quad * 8;
#pragma unroll 4
    for (int ks = 0; ks < 64; ++ks) { const int l = ks >> 1, dq = ks & 1, k0 = l * 64 + 32 * dq;
        const bf16x8 b0 = *(const bf16x8*)(wb0 + k0), b1 = *(const bf16x8*)(wb0 + 16 * 2048 + k0);
        const bf16x8 a0 = *(const LAS bf16x8*)(span + (16 * row16 + l) * SP + 32 * dq + quad * 8);
        const bf16x8 a1 = *(const LAS bf16x8*)(span + (16 * (16 + row16) + l) * SP + 32 * dq + quad * 8);
        acc[0][0] = MFMA16(a0, b0, acc[0][0]); acc[0][1] = MFMA16(a0, b1, acc[0][1]); acc[1][0] = MFMA16(a1, b0, acc[1][0]); acc[1][1] = MFMA16(a1, b1, acc[1][1]); }
#pragma unroll
    for (int mi = 0; mi < 2; ++mi)
#pragma unroll
        for (int ni = 0; ni < 2; ++ni) { const int n = 32 * w + 16 * ni + row16; const float bs = bias[n];
#pragma unroll
            for (int j = 0; j < 4; ++j) Hs[(16 * mi + quad * 4 + j) * HP + n] = f2bf(gelu_tanh(acc[mi][ni][j] + bs)); }
    __syncthreads();
    { const int mt = w >> 2, nt = w & 3; f32x4 a2 = {0.f, 0.f, 0.f, 0.f};
#pragma unroll
      for (int ks = 0; ks < 8; ++ks) { const bf16x8 av = *(const LAS bf16x8*)(Hs + (16 * mt + row16) * HP + 32 * ks + quad * 8);
          const bf16x8 bv = *(const bf16x8*)(W2t + (size_t)(16 * nt + row16) * 256 + 32 * ks + quad * 8); a2 = MFMA16(av, bv, a2); }
#pragma unroll
      for (int j = 0; j < 4; ++j) Os[(16 * mt + quad * 4 + j) * 64 + 16 * nt + row16] = a2[j]; }
    __syncthreads();
    { const int c = tid >> 4, cglob = 32 * cgp + c; bf16_t* op = outp + (size_t)(b * 128 + cglob) * 64;
#pragma unroll
      for (int e = 0; e < 2; ++e) { const int i = (tid & 15) * 2 + e; float x1 = Os[c * 64 + i], x2 = Os[c * 64 + i + 32];
          if (cglob >= 127) { x1 = 0.f; x2 = 0.f; }
          else if (kv == 0) { const int pos = 16 * cglob + 31; const float cs = cos64[pos * 32 + i], sn = sin64[pos * 32 + i]; const float y1 = x1 * cs - x2 * sn, y2 = x2 * cs + x1 * sn; x1 = y1; x2 = y2; }
          op[i] = f2bf(x1); op[i + 32] = f2bf(x2); } }
    __syncthreads();
}

DI void attn_prep_phase(const Ctx& C, ARGP a, int L) {
    bf16_t* proj = (bf16_t*)(C.ws + WS_BIG);
    const float* tb = (const float*)(C.ws + WS_TBL);
    const float* cos64 = tb + TB_COS64 / 4; const float* sin64 = tb + TB_SIN64 / 4; const float* cos32 = tb + TB_COS32 / 4; const float* sin32 = tb + TB_SIN32 / 4;
    unsigned char* wb = C.ws + WS_W + (size_t)L * W_LAYER;
    for (int u = C.bid; u < BATCH * 4 * 2; u += C.G) { const int kv = u & 1, cgp = (u >> 1) & 3, b = u >> 3;
        cmp_mlp_unit(C, proj, b, cgp, kv, (const bf16_t*)(wb + (kv ? W_V1 : W_K1)), (const bf16_t*)(wb + (kv ? W_V2 : W_K2)),
                     (const float*)(C.ws + WS_TBL + TB_CBIAS) + (L * 2 + kv) * 256, (bf16_t*)(C.ws + (kv ? WS_VC : WS_KC)), cos64, sin64); }
    const int gw = C.bid * 8 + C.wave, NGW = C.G * 8, lane = C.lane;
    for (int u = gw; u < BATCH * 8; u += NGW) { const int b = u >> 3, h = u & 7; const float bf = a->in[11][L * 8 + h];
        float* ck = (float*)(C.ws + WS_CKL) + (size_t)u * SEQ + lane * 32; const bf16_t* fp = proj + (size_t)(b * SEQ + lane * 32) * NPROJ + C_FF + h;
        float run = 0.f; float loc[32];
#pragma unroll
        for (int i = 0; i < 32; ++i) { const float x = bf2f(fp[(size_t)i * NPROJ]) + bf; const float ls = fminf(x, 0.f) - log1pf(expf(-fabsf(x))); run += ls; loc[i] = run; }
        float incl = run;
#pragma unroll
        for (int o = 1; o < 64; o <<= 1) { const float t = __shfl_up(incl, o); if (lane >= o) incl += t; }
        const float base = incl - run;
#pragma unroll
        for (int i = 0; i < 32; ++i) ck[i] = (base + loc[i]) * LOG2E; }
}

constexpr int KP = 72;
DI void cmp_attn_phase(const Ctx& C, int L) {
    const bf16_t* proj = (const bf16_t*)(C.ws + WS_BIG);
    LAS bf16_t* Ks = (LAS bf16_t*)C.lds;
    LAS bf16_t* Vs = (LAS bf16_t*)(C.lds + 128 * KP * 2);
    LAS float* Ps = (LAS float*)(C.lds + 2 * 128 * KP * 2 + C.wave * 5120);
    LAS float* Sc = Ps + 8 * 128;
    const int tid = C.tid, lane = C.lane, w = C.wave, r = lane & 31, hh = lane >> 5;
    const float c1 = 0.125f * LOG2E;
    for (int ug = C.bid; ug < BATCH * 8; ug += C.G) {
        const int b = ug >> 3;
        __syncthreads();
        for (int idx = tid; idx < 128 * 8 * 2; idx += 512) { const int kvs = idx >> 10, rem = idx & 1023, c = rem >> 3, ch = rem & 7;
            const u32x4 v = *(const u32x4*)((const bf16_t*)(C.ws + (kvs ? WS_VC : WS_KC)) + (size_t)(b * 128 + c) * 64 + ch * 8);
            *(LAS u32x4*)((kvs ? Vs : Ks) + c * KP + ch * 8) = v; }
        __syncthreads();
        for (int uu = 0; uu < 4; ++uu) {
            const int t0 = ((ug & 7) * 4 + uu) * 64; const int tok = t0 + 8 * w + (r >> 2), g = r & 3; const size_t m = (size_t)b * SEQ + tok;
            bf16x8 qf[4];
#pragma unroll
            for (int s = 0; s < 4; ++s) qf[s] = *(const bf16x8*)(proj + m * NPROJ + C_NQ + g * 64 + 16 * s + 8 * hh);
            f32x16 p[4];
#pragma unroll
            for (int kt = 0; kt < 4; ++kt) { f32x16 acc;
#pragma unroll
                for (int i = 0; i < 16; ++i) acc[i] = 0.f;
#pragma unroll
                for (int s = 0; s < 4; ++s) { const bf16x8 kf = *(const LAS bf16x8*)(Ks + (32 * kt + r) * KP + 16 * s + 8 * hh); acc = MFMA32(kf, qf[s], acc); }
                p[kt] = acc; }
            float mx = -1e30f; const int climh = ((tok - 31) >> 4) - 4 * hh;
#pragma unroll
            for (int kt = 0; kt < 4; ++kt)
#pragma unroll
                for (int i = 0; i < 16; ++i) { const bool ok = (32 * kt + (i & 3) + 8 * (i >> 2)) <= climh; p[kt][i] = ok ? p[kt][i] : -INFINITY; mx = fmaxf(mx, p[kt][i]); }
            mx = fmaxf(mx, __shfl_xor(mx, 32));
            float sum = 0.f; const float off = mx * c1;
#pragma unroll
            for (int kt = 0; kt < 4; ++kt)
#pragma unroll
                for (int i = 0; i < 16; ++i) { const float e = __builtin_amdgcn_exp2f(p[kt][i] * c1 - off); p[kt][i] = e; sum += e; }
            sum += __shfl_xor(sum, 32);
            const float inv = (tok >= 31) ? 1.0f / sum : 0.f;
#pragma unroll
            for (int kt = 0; kt < 4; ++kt)
#pragma unroll
                for (int i = 0; i < 16; ++i) p[kt][i] *= inv;
            __builtin_amdgcn_sched_barrier(0);
            f32x16 o[2];
#pragma unroll
            for (int dt = 0; dt < 2; ++dt)
#pragma unroll
                for (int i = 0; i < 16; ++i) o[dt][i] = 0.f;
            const int i16 = lane & 15, q4 = i16 >> 2, pp = i16 & 3, blk = (lane >> 4) & 1;
            const LAS bf16_t* vb = Vs + (4 * hh + q4) * KP + 16 * blk + 4 * pp;
#pragma unroll
            for (int kt = 0; kt < 4; ++kt)
#pragma unroll
                for (int s = 0; s < 2; ++s) { u32x4 pw; pw.x = pk2(p[kt][8 * s], p[kt][8 * s + 1]); pw.y = pk2(p[kt][8 * s + 2], p[kt][8 * s + 3]); pw.z = pk2(p[kt][8 * s + 4], p[kt][8 * s + 5]); pw.w = pk2(p[kt][8 * s + 6], p[kt][8 * s + 7]);
                    const bf16x8 pf = __builtin_bit_cast(bf16x8, pw);
#pragma unroll
                    for (int dt = 0; dt < 2; ++dt) { const s16x4 lo = __builtin_amdgcn_ds_read_tr16_b64_v4i16((LAS s16x4*)(vb + (32 * kt + 16 * s) * KP + 32 * dt));
                        const s16x4 hi = __builtin_amdgcn_ds_read_tr16_b64_v4i16((LAS s16x4*)(vb + (32 * kt + 16 * s + 8) * KP + 32 * dt));
                        const bf16x8 vf = __builtin_shufflevector(lo, hi, 0, 1, 2, 3, 4, 5, 6, 7); o[dt] = MFMA32(vf, pf, o[dt]); } __builtin_amdgcn_sched_barrier(0); }
            __builtin_amdgcn_sched_barrier(0);
            { const float gl = bf2f(proj[m * NPROJ + C_NG + g * 3 + 0]); const float gate = 1.0f / (1.0f + __expf(-gl));
              float* op = (float*)(C.ws + WS_OCMP) + m * 256 + g * 64;
#pragma unroll
              for (int dt = 0; dt < 2; ++dt)
#pragma unroll
                  for (int g4 = 0; g4 < 4; ++g4) { f32x4 v; v[0] = o[dt][4 * g4] * gate; v[1] = o[dt][4 * g4 + 1] * gate; v[2] = o[dt][4 * g4 + 2] * gate; v[3] = o[dt][4 * g4 + 3] * gate;
                      *(f32x4*)(op + 32 * dt + 8 * g4 + 4 * hh) = v; } }
            __builtin_amdgcn_sched_barrier(0);
#pragma unroll
            for (int kt = 0; kt < 4; ++kt)
#pragma unroll
                for (int i = 0; i < 16; ++i) { float v = p[kt][i]; v += __shfl_xor(v, 1); v += __shfl_xor(v, 2); p[kt][i] = v; }
            __builtin_amdgcn_sched_barrier(0);
            if (g == 0) {
#pragma unroll
                for (int kt = 0; kt < 4; ++kt)
#pragma unroll
                    for (int g4 = 0; g4 < 4; ++g4) { f32x4 v; v[0] = p[kt][4 * g4]; v[1] = p[kt][4 * g4 + 1]; v[2] = p[kt][4 * g4 + 2]; v[3] = p[kt][4 * g4 + 3];
                        *(LAS f32x4*)(Ps + (r >> 2) * 128 + 32 * kt + 8 * g4 + 4 * hh) = v; } }
            LDS_WAIT();
            { const int tk = lane >> 3, jg = lane & 7; const int t = t0 + 8 * w + tk; const int blk_t = t >> 6;
              float sc[4];
#pragma unroll
              for (int jj = 0; jj < 4; ++jj) { const int j = 4 * jg + jj; float imp = 0.f;
#pragma unroll
                  for (int cc = -1; cc < 4; ++cc) { const int c = 4 * j + cc; if (c >= 0) imp += Ps[tk * 128 + c]; }
                  const bool forced = (j == 0) || (j == blk_t) || (j == blk_t - 1); const bool valid = (j * 64) <= t;
                  sc[jj] = forced ? 1e9f : (valid ? imp : -1.0f); Sc[tk * 32 + j] = sc[jj]; }
              LDS_WAIT();
              unsigned bits = 0u;
#pragma unroll
              for (int jj = 0; jj < 4; ++jj) { const int j = 4 * jg + jj; int cnt = 0;
                  for (int j2 = 0; j2 < 32; ++j2) { const float o2 = Sc[tk * 32 + j2]; cnt += (o2 > sc[jj] || (o2 == sc[jj] && j2 < j)) ? 1 : 0; }
                  if (cnt < 16) bits |= 1u << j; }
              bits |= __shfl_xor(bits, 1); bits |= __shfl_xor(bits, 2); bits |= __shfl_xor(bits, 4);
              if (jg == 0) ((unsigned*)(C.ws + WS_SEL))[(size_t)b * SEQ + t] = bits; }
            LDS_WAIT();
        }
    }
}
constexpr int AT_KBUF = 64 * KP * 2;
constexpr int AT_K0 = 0, AT_V0 = 2 * AT_KBUF, AT_C0 = 4 * AT_KBUF, AT_MISC = AT_C0 + 2 * 256;

template <bool BIAS, bool SEL, int NS>
DI void tile_step(const LAS bf16_t* Kl, const LAS bf16_t* Vl, const LAS float* Cl, const bf16x8 (&qf)[NS], f32x16 (&o)[2], float& m, float& l,
                  const float c1, const int mmode, const int key0, const int trow, const bool kill, const int hh) {
    f32x16 p[2];
#pragma unroll
    for (int kt = 0; kt < 2; ++kt) { f32x16 acc;
#pragma unroll
        for (int i = 0; i < 16; ++i) acc[i] = 0.f;
#pragma unroll
        for (int s = 0; s < NS; ++s) { const bf16x8 kf = *(const LAS bf16x8*)(Kl + 32 * kt * KP + 16 * s); acc = MFMA32(kf, qf[s], acc); }
        p[kt] = acc; }
    if (BIAS) {
        const f32x2 c1v = {c1, c1};
#pragma unroll
        for (int kt = 0; kt < 2; ++kt)
#pragma unroll
            for (int g4 = 0; g4 < 4; ++g4) { const f32x4 cv = *(const LAS f32x4*)(Cl + 32 * kt + 8 * g4);
                f32x2 a0 = {p[kt][4 * g4], p[kt][4 * g4 + 1]}, a1 = {p[kt][4 * g4 + 2], p[kt][4 * g4 + 3]};
                a0 = a0 * c1v - (f32x2){cv[0], cv[1]}; a1 = a1 * c1v - (f32x2){cv[2], cv[3]};
                p[kt][4 * g4] = a0[0]; p[kt][4 * g4 + 1] = a0[1]; p[kt][4 * g4 + 2] = a1[0]; p[kt][4 * g4 + 3] = a1[1]; }
    }
    const int lim = trow - key0 - 4 * hh;
    if (mmode == 1) {
#pragma unroll
        for (int kt = 0; kt < 2; ++kt)
#pragma unroll
            for (int i = 0; i < 16; ++i) p[kt][i] = ((32 * kt + (i & 3) + 8 * (i >> 2)) > lim) ? -INFINITY : p[kt][i];
    } else if (mmode == 2) {
#pragma unroll
        for (int kt = 0; kt < 2; ++kt)
#pragma unroll
            for (int i = 0; i < 16; ++i) p[kt][i] = ((32 * kt + (i & 3) + 8 * (i >> 2)) <= lim - 512) ? -INFINITY : p[kt][i];
    }
    if (SEL) { if (kill) {
#pragma unroll
        for (int kt = 0; kt < 2; ++kt)
#pragma unroll
            for (int i = 0; i < 16; ++i) p[kt][i] = -INFINITY; } }
    float mx = p[0][0];
#pragma unroll
    for (int kt = 0; kt < 2; ++kt)
#pragma unroll
        for (int i = 0; i < 16; ++i) mx = fmaxf(mx, p[kt][i]);
    mx = fmaxf(mx, __shfl_xor(mx, 32));
    const float mn = fmaxf(m, mx);
    float alpha, off, sc;
    if (BIAS) { alpha = __builtin_amdgcn_exp2f(m - mn); off = mn; sc = 1.0f; } else { alpha = __builtin_amdgcn_exp2f((m - mn) * c1); off = mn * c1; sc = c1; }
    m = mn;
    f32x2 rs2 = {0.f, 0.f}; const f32x2 scv = {sc, sc}, offv = {off, off};
#pragma unroll
    for (int kt = 0; kt < 2; ++kt)
#pragma unroll
        for (int i = 0; i < 16; i += 2) { f32x2 a = {p[kt][i], p[kt][i + 1]}; a = a * scv - offv; f32x2 e; e[0] = __builtin_amdgcn_exp2f(a[0]); e[1] = __builtin_amdgcn_exp2f(a[1]);
            p[kt][i] = e[0]; p[kt][i + 1] = e[1]; rs2 += e; }
    l = l * alpha + (rs2[0] + rs2[1]);
    const f32x2 av = {alpha, alpha};
#pragma unroll
    for (int dt = 0; dt < 2; ++dt)
#pragma unroll
        for (int i = 0; i < 16; i += 2) { f32x2 a = {o[dt][i], o[dt][i + 1]}; a = a * av; o[dt][i] = a[0]; o[dt][i + 1] = a[1]; }
#pragma unroll
    for (int kt = 0; kt < 2; ++kt)
#pragma unroll
        for (int s = 0; s < 2; ++s) { u32x4 pw; pw.x = pk2(p[kt][8 * s], p[kt][8 * s + 1]); pw.y = pk2(p[kt][8 * s + 2], p[kt][8 * s + 3]); pw.z = pk2(p[kt][8 * s + 4], p[kt][8 * s + 5]); pw.w = pk2(p[kt][8 * s + 6], p[kt][8 * s + 7]);
            const bf16x8 pf = __builtin_bit_cast(bf16x8, pw);
#pragma unroll
            for (int dt = 0; dt < 2; ++dt) { const s16x4 lo = __builtin_amdgcn_ds_read_tr16_b64_v4i16((LAS s16x4*)(Vl + (32 * kt + 16 * s) * KP + 32 * dt));
                const s16x4 hi = __builtin_amdgcn_ds_read_tr16_b64_v4i16((LAS s16x4*)(Vl + (32 * kt + 16 * s + 8) * KP + 32 * dt));
                const bf16x8 vf = __builtin_shufflevector(lo, hi, 0, 1, 2, 3, 4, 5, 6, 7); o[dt] = MFMA32(vf, pf, o[dt]); } }
}

struct TileRegs { u32x4 k, v; float c; };
template <bool BIAS>
DI void tile_gload(TileRegs& R, const bf16_t* kbase, const bf16_t* vbase, const float* cbase, int key0, int tid) {
    const size_t off = (size_t)(key0 + (tid >> 3)) * NPROJ + (tid & 7) * 8;
    R.k = *(const u32x4*)(kbase + off); R.v = *(const u32x4*)(vbase + off);
    if (BIAS) { if (tid < 64) R.c = cbase[key0 + tid]; }
}
template <bool BIAS>
DI void tile_lstore(const TileRegs& R, LAS unsigned char* lds, int buf, int tid) {
    const int o = ((tid >> 3) * KP + (tid & 7) * 8) * 2;
    *(LAS u32x4*)(lds + AT_K0 + buf * AT_KBUF + o) = R.k; *(LAS u32x4*)(lds + AT_V0 + buf * AT_KBUF + o) = R.v;
    if (BIAS) { if (tid < 64) *(LAS float*)(lds + AT_C0 + buf * 256 + tid * 4) = R.c; }
}

template <bool BIAS, bool SEL, int NS, int NMAP>
DI void flash_pass(const Ctx& C, const bf16_t* kbase, const bf16_t* vbase, const float* cbase, int j0, int j1, int wave_last, int lowtile,
                   const bf16x8 (&qf)[NMAP][NS], f32x16 (&o)[NMAP][2], float (&m)[NMAP], float (&l)[NMAP], float c1, int trow, unsigned selbits, int hh) {
    const int tid = C.tid, lane = C.lane, r = lane & 31;
    const int i16 = lane & 15, q4 = i16 >> 2, pp = i16 & 3, blk = (lane >> 4) & 1;
    TileRegs R;
    tile_gload<BIAS>(R, kbase, vbase, cbase, 64 * j0, tid);
    tile_lstore<BIAS>(R, C.lds, 0, tid);
    __syncthreads();
    int cur = 0;
    for (int j = j0; j <= j1; ++j) {
        if (j < j1) tile_gload<BIAS>(R, kbase, vbase, cbase, 64 * (j + 1), tid);
        if (j <= wave_last) {
            const LAS bf16_t* Kt = (const LAS bf16_t*)(C.lds + AT_K0 + cur * AT_KBUF);
            const LAS bf16_t* Vl = (const LAS bf16_t*)(C.lds + AT_V0 + cur * AT_KBUF) + (4 * hh + q4) * KP + 16 * blk + 4 * pp;
            const LAS float* Cl = (const LAS float*)(C.lds + AT_C0 + cur * 256) + 4 * hh;
            const int mmode = (j == wave_last) ? 1 : ((j == lowtile) ? 2 : 0);
            const bool kill = SEL ? (((selbits >> j) & 1u) == 0u) : false;
#pragma unroll
            for (int mp = 0; mp < NMAP; ++mp)
                tile_step<BIAS, SEL, NS>(Kt + r * KP + 8 * hh + mp * 32, Vl, Cl, qf[mp], o[mp], m[mp], l[mp], c1, mmode, 64 * j, trow, kill, hh);
        }
        if (j < j1) tile_lstore<BIAS>(R, C.lds, cur ^ 1, tid);
        __syncthreads();
        cur ^= 1;
    }
}

DI void store_row64(bf16_t* dst, const f32x16 (&v)[2], int hh) {
#pragma unroll
    for (int dt = 0; dt < 2; ++dt)
#pragma unroll
        for (int g4 = 0; g4 < 4; ++g4) { u32x2 w; w.x = pk2(v[dt][4 * g4], v[dt][4 * g4 + 1]); w.y = pk2(v[dt][4 * g4 + 2], v[dt][4 * g4 + 3]); *(u32x2*)(dst + 32 * dt + 8 * g4 + 4 * hh) = w; }
}

DI void attn_phase(const Ctx& C, ARGP a, int L) {
    const bf16_t* proj = (const bf16_t*)(C.ws + WS_BIG);
    bf16_t* mix = (bf16_t*)(C.ws + WS_MIX);
    unsigned* qctr = (unsigned*)(C.ws + WS_CTL) + CW_QUEUE + 64 * L;
    volatile LAS int* slot = (volatile LAS int*)(C.lds + AT_MISC);
    const int tid = C.tid, lane = C.lane, w = C.wave, r = lane & 31, hh = lane >> 5;
    for (;;) {
        __syncthreads();
        if (tid == 0) slot[0] = (int)atomicAdd(qctr, 1u);
        __syncthreads();
        const int idx = slot[0];
        if (idx >= 4096) break;
        const int qb8 = 7 - (idx >> 9), rem = idx & 511;
        if (rem >= 256) {
            const int r3 = rem - 256, b = r3 >> 3, h = r3 & 7; const int tok = 256 * qb8 + 32 * w + r; const size_t mrow = (size_t)b * SEQ + tok;
            bf16x8 qf[1][4];
#pragma unroll
            for (int s = 0; s < 4; ++s) qf[0][s] = *(const bf16x8*)(proj + mrow * NPROJ + C_FQ + h * 64 + 16 * s + 8 * hh);
            f32x16 o[1][2]; float m[1] = {-1e30f}, l[1] = {0.f};
#pragma unroll
            for (int dt = 0; dt < 2; ++dt)
#pragma unroll
                for (int i = 0; i < 16; ++i) o[0][dt][i] = 0.f;
            const bf16_t* kb = proj + (size_t)b * SEQ * NPROJ + C_FK + h * 64; const bf16_t* vb = proj + (size_t)b * SEQ * NPROJ + C_FV + h * 64;
            const float* cb = (const float*)(C.ws + WS_CKL) + (size_t)(b * 8 + h) * SEQ;
            flash_pass<true, false, 4, 1>(C, kb, vb, cb, 0, 4 * qb8 + 3, 4 * qb8 + (w >> 1), -1, qf, o, m, l, 0.125f * LOG2E, tok, 0xffffffffu, hh);
            const float lt = l[0] + __shfl_xor(l[0], 32); const float inv = 1.0f / lt;
#pragma unroll
            for (int dt = 0; dt < 2; ++dt)
#pragma unroll
                for (int i = 0; i < 16; ++i) o[0][dt][i] *= inv;
            store_row64(mix + mrow * DM + 512 + h * 64, o[0], hh);
        } else if (rem < 128) {
            const int b = rem >> 2, h = rem & 3; const int tok = 256 * qb8 + 32 * w + r; const size_t mrow = (size_t)b * SEQ + tok;
            bf16x8 qf[2][2];
#pragma unroll
            for (int mp = 0; mp < 2; ++mp)
#pragma unroll
                for (int s = 0; s < 2; ++s) qf[mp][s] = *(const bf16x8*)(proj + mrow * NPROJ + C_DQ + h * 64 + mp * 32 + 16 * s + 8 * hh);
            f32x16 o[2][2]; float m[2] = {-1e30f, -1e30f}, l[2] = {0.f, 0.f};
#pragma unroll
            for (int mp = 0; mp < 2; ++mp)
#pragma unroll
                for (int dt = 0; dt < 2; ++dt)
#pragma unroll
                    for (int i = 0; i < 16; ++i) o[mp][dt][i] = 0.f;
            const bf16_t* kb = proj + (size_t)b * SEQ * NPROJ + C_DK + h * 64; const bf16_t* vb = proj + (size_t)b * SEQ * NPROJ + C_DV + h * 64;
            flash_pass<false, false, 2, 2>(C, kb, vb, nullptr, 0, 4 * qb8 + 3, 4 * qb8 + (w >> 1), -1, qf, o, m, l, 0.17677669529f * LOG2E, tok, 0xffffffffu, hh);
            const float lam = ((const float*)(C.ws + WS_TBL + TB_LAM))[L]; const float li = 0.8f - 0.6f * expf(-0.3f * (float)L);
            const float i0 = 1.0f / (l[0] + __shfl_xor(l[0], 32)), i1 = lam / (l[1] + __shfl_xor(l[1], 32));
            float ss = 0.f;
#pragma unroll
            for (int dt = 0; dt < 2; ++dt)
#pragma unroll
                for (int i = 0; i < 16; ++i) { const float v = o[0][dt][i] * i0 - o[1][dt][i] * i1; o[0][dt][i] = v; ss += v * v; }
            ss += __shfl_xor(ss, 32);
            const float rms = (1.0f / sqrtf(ss * (1.0f / 64.0f) + LN_EPS)) * (1.0f - li);
            const float* sg = a->in[19] + L * 64;
#pragma unroll
            for (int dt = 0; dt < 2; ++dt)
#pragma unroll
                for (int g4 = 0; g4 < 4; ++g4) { const f32x4 gv = *(const f32x4*)(sg + 32 * dt + 8 * g4 + 4 * hh);
#pragma unroll
                    for (int e = 0; e < 4; ++e) o[0][dt][4 * g4 + e] *= rms * gv[e]; }
            store_row64(mix + mrow * DM + 256 + h * 64, o[0], hh);
        } else {
            const int r2 = rem - 128, b = r2 & 31, qb = 4 * qb8 + 3 - (r2 >> 5); const int tok = 64 * qb + 8 * w + (r >> 2), g = r & 3; const size_t mrow = (size_t)b * SEQ + tok;
            bf16x8 qf[1][4];
#pragma unroll
            for (int s = 0; s < 4; ++s) qf[0][s] = *(const bf16x8*)(proj + mrow * NPROJ + C_NQ + g * 64 + 16 * s + 8 * hh);
            const unsigned sel = ((const unsigned*)(C.ws + WS_SEL))[mrow];
            const bf16_t* pb = proj + (size_t)b * SEQ * NPROJ + C_NKV;
            f32x16 o[1][2], keep[2]; float m[1] = {-1e30f}, l[1] = {0.f};
#pragma unroll
            for (int dt = 0; dt < 2; ++dt)
#pragma unroll
                for (int i = 0; i < 16; ++i) o[0][dt][i] = 0.f;
            flash_pass<false, true, 4, 1>(C, pb + 128, pb + 192, nullptr, 0, qb, qb, -1, qf, o, m, l, 0.125f * LOG2E, tok, sel, hh);
            { const float g1 = 1.0f / (1.0f + __expf(-bf2f(proj[mrow * NPROJ + C_NG + g * 3 + 1]))); const float inv = g1 / (l[0] + __shfl_xor(l[0], 32));
              const float* oc = (const float*)(C.ws + WS_OCMP) + mrow * 256 + g * 64;
#pragma unroll
              for (int dt = 0; dt < 2; ++dt)
#pragma unroll
                  for (int g4 = 0; g4 < 4; ++g4) { const f32x4 cv = *(const f32x4*)(oc + 32 * dt + 8 * g4 + 4 * hh);
#pragma unroll
                      for (int e = 0; e < 4; ++e) { keep[dt][4 * g4 + e] = o[0][dt][4 * g4 + e] * inv + cv[e]; o[0][dt][4 * g4 + e] = 0.f; } } }
            m[0] = -1e30f; l[0] = 0.f;
            const int jlo = qb >= 8 ? qb - 8 : 0;
            flash_pass<false, false, 4, 1>(C, pb + 256, pb + 320, nullptr, jlo, qb, qb, qb >= 8 ? qb - 8 : -1, qf, o, m, l, 0.125f * LOG2E, tok, 0xffffffffu, hh);
            { const float g2 = 1.0f / (1.0f + __expf(-bf2f(proj[mrow * NPROJ + C_NG + g * 3 + 2]))); const float inv = g2 / (l[0] + __shfl_xor(l[0], 32));
#pragma unroll
              for (int dt = 0; dt < 2; ++dt)
#pragma unroll
                  for (int i = 0; i < 16; ++i) keep[dt][i] += o[0][dt][i] * inv; }
            store_row64(mix + mrow * DM + g * 64, keep, hh);
        }
    }
}
constexpr int LDS_BYTES = 147456;
constexpr int N_PHASES = 1 + 13 * DEPTH;

template <class Epi>
DI void run_gemm(const Ctx& C, const bf16_t* A, const bf16_t* Bt, int N, int K, const Epi& E, const bool opaque = false) {
    if (opaque) asm volatile("" : "+s"(K), "+s"(N));
    pg8::Gemm g{A, Bt, MTOK, N, K}; pg8::StaticOrder S; S.init(MTOK, N, C.G, C.bid);
    pg8::gemm_phase<Epi, pg8::StaticOrder, true, true>((LAS unsigned char*)C.lds, g, S, E, C.tid);
}

__global__ void __launch_bounds__(512, 2) mega_fwd(Args args_k) {
    const ARGP ap0 = (ARGP)__builtin_amdgcn_kernarg_segment_ptr();
    extern __shared__ __attribute__((aligned(16))) unsigned char lds_raw[];
    Ctx C; const int wave_s = __builtin_amdgcn_readfirstlane((int)threadIdx.x >> 6); C.wave = wave_s; C.lane = 0; C.tid = 0; C.bid = blockIdx.x; C.G = gridDim.x;
    C.ws = args_k.ws; C.lds = (LAS unsigned char*)lds_raw;
    cg::grid_group grid = cg::this_grid();
#define BST ((volatile LAS unsigned*)(C.lds + 131072 + 256))
    if (threadIdx.x < 2) BST[threadIdx.x] = 0u;
    __syncthreads();
    (void)xcd_barrier_post((unsigned*)(C.ws + WS_CTL) + 4096, BST);
    const int lo = args_k.ph_lo, hi = args_k.ph_hi;
    float* X = args_k.out;
    bf16_t* XB = (bf16_t*)(C.ws + WS_XB); bf16_t* BIG = (bf16_t*)(C.ws + WS_BIG); bf16_t* MIX = (bf16_t*)(C.ws + WS_MIX);
#define PH_BEGIN(k) if (lo <= (k) && (k) < hi) { ARGP args = ap0; asm volatile("" : "+s"(args)); { int l_ = (int)__builtin_amdgcn_mbcnt_hi(~0u, __builtin_amdgcn_mbcnt_lo(~0u, 0u)); asm volatile("" : "+v"(l_)); C.lane = l_; C.tid = wave_s * 64 + l_; }
#define PH_END(k) asm volatile("s_waitcnt vmcnt(0)" ::: "memory"); if ((k) + 1 < hi) { if ((k) == 0) grid.sync(); else { XcdBarrier xb_; xb_.bar = (unsigned*)(C.ws + WS_CTL) + 4096; xb_.x = xb_xcc_id(); xb_.st = BST; xcd_barrier(xb_); } } }
    PH_BEGIN(0) prep_phase(C, args); PH_END(0)
    for (int L = 0; L < DEPTH; ++L) {
        const int pb = 1 + 13 * L;
        unsigned char* wb = C.ws + WS_W + (size_t)L * W_LAYER;
        PH_BEGIN(pb + 0) { pg8::EpiSwiGLU E{BIG, DFFP}; run_gemm(C, L == 0 ? XB : MIX, (const bf16_t*)(wb + W_UP1), NUP, DM, E); } PH_END(pb + 0)
        PH_BEGIN(pb + 1) { pg8::EpiResid E{L == 0 ? args->in[0] : X, X, DN_ALPHA, 0.5f, nullptr, nullptr, nullptr}; run_gemm(C, BIG, (const bf16_t*)(wb + W_DN1), DM, DFFP, E); } PH_END(pb + 1)
        PH_BEGIN(pb + 2) ln_phase(C, X, XB, args->in[2] + (size_t)(L * 3 + 0) * DM, args->in[3] + (size_t)(L * 3 + 0) * DM); PH_END(pb + 2)
        PH_BEGIN(pb + 3) { pg8::EpiProjRope E{C.ws, NPROJ}; run_gemm(C, XB, (const bf16_t*)(wb + W_IN), NPROJ, DM, E); } PH_END(pb + 3)
        PH_BEGIN(pb + 4) attn_prep_phase(C, args, L); PH_END(pb + 4)
        PH_BEGIN(pb + 5) cmp_attn_phase(C, L); PH_END(pb + 5)
        PH_BEGIN(pb + 6) attn_phase(C, args, L); PH_END(pb + 6)
        PH_BEGIN(pb + 7) { pg8::EpiResid E{X, X, DN_ALPHA, 1.0f, XB, nullptr, nullptr}; run_gemm(C, MIX, (const bf16_t*)(wb + W_OUT), DM, DM, E); } PH_END(pb + 7)
        PH_BEGIN(pb + 8) ln_phase(C, X, XB, args->in[2] + (size_t)(L * 3 + 1) * DM, args->in[3] + (size_t)(L * 3 + 1) * DM); PH_END(pb + 8)
        PH_BEGIN(pb + 9) { pg8::EpiSwiGLU E{BIG, DFFP}; run_gemm(C, XB, (const bf16_t*)(wb + W_UP2), NUP, DM, E); } PH_END(pb + 9)
        PH_BEGIN(pb + 10) { pg8::EpiResid E{X, X, DN_ALPHA, 0.5f, XB, nullptr, nullptr}; run_gemm(C, BIG, (const bf16_t*)(wb + W_DN2), DM, DFFP, E); } PH_END(pb + 10)
        PH_BEGIN(pb + 11) { ln_phase(C, X, XB, args->in[2] + (size_t)(L * 3 + 2) * DM, args->in[3] + (size_t)(L * 3 + 2) * DM); __syncthreads();
            pg8::EpiBf16 E{BIG, DM}; run_gemm(C, (const bf16_t*)(C.ws + WS_PB) + (size_t)L * MTOK * PLED, (const bf16_t*)(wb + W_PLEP), DM, PLED, E, true); } PH_END(pb + 11)
        PH_BEGIN(pb + 12) { pg8::EpiPle E{XB, X, L == DEPTH - 1 ? (bf16_t*)nullptr : MIX, args->in[22] + (size_t)L * DM, BIG}; run_gemm(C, XB, (const bf16_t*)(wb + W_PLEG), DM, DM, E); } PH_END(pb + 12)
    }
}

#ifndef MK_SPLIT
#define MK_SPLIT 0
#endif
extern "C" void kernel_launch(void* const* d_in, const int* in_sizes, int n_in, void* d_out, int out_size, void* d_ws, size_t ws_size, hipStream_t stream) {
    static int grid = 0;
    if (grid == 0) {
        if (n_in != 24 || out_size != MTOK * DM || ws_size < WS_END) { fprintf(stderr, "kernel_launch: unexpected shapes (n_in %d out %d ws %zu)\n", n_in, out_size, ws_size); grid = -1; return; }
        if (hipFuncSetAttribute((const void*)mega_fwd, hipFuncAttributeMaxDynamicSharedMemorySize, LDS_BYTES) != hipSuccess) { fprintf(stderr, "kernel_launch: hipFuncSetAttribute failed\n"); grid = -1; return; }
        int dev = 0, cus = 0, per_cu = 0; hipGetDevice(&dev); hipDeviceGetAttribute(&cus, hipDeviceAttributeMultiprocessorCount, dev);
        hipOccupancyMaxActiveBlocksPerMultiprocessor(&per_cu, (const void*)mega_fwd, 512, LDS_BYTES);
        if (per_cu < 1) { fprintf(stderr, "kernel_launch: occupancy query says %d blocks/CU\n", per_cu); per_cu = 1; }
        (void)hipGetLastError();
        grid = cus;
    }
    if (grid < 0) return;
    hipMemsetAsync((char*)d_ws + WS_CTL, 0, 1 * MiB, stream);
    Args a{};
    for (int i = 0; i < 24; ++i) a.in[i] = (const float*)d_in[i];
    a.out = (float*)d_out; a.ws = (unsigned char*)d_ws;
#if MK_SPLIT
    for (int p = 0; p < N_PHASES; ++p) { a.ph_lo = p; a.ph_hi = p + 1; hipLaunchKernelGGL(mega_fwd, dim3(grid), dim3(512), LDS_BYTES, stream, a); }
#else
    a.ph_lo = 0; a.ph_hi = N_PHASES;
    void* kargs[] = {&a};
    hipError_t e = hipLaunchCooperativeKernel((const void*)mega_fwd, dim3(grid), dim3(512), kargs, LDS_BYTES, stream);
    if (e != hipSuccess) fprintf(stderr, "cooperative launch failed: %s (grid %d)\n", hipGetErrorString(e), grid);
#endif
}
```

```cpp
#include <hip/hip_runtime.h>
#include <hip/hip_cooperative_groups.h>
#include <cstdio>
#include <cstdint>
#include <cmath>
namespace cg = cooperative_groups;

__device__ __forceinline__ int lane_here() { int l; asm volatile("v_mbcnt_lo_u32_b32 %0, -1, 0\n\tv_mbcnt_hi_u32_b32 %0, -1, %0" : "=&v"(l)); return l; }
template <int O> __device__ __forceinline__ int shxi(int v) {
    if constexpr (O < 32) return __builtin_amdgcn_ds_swizzle(v, (O << 10) | 0x1f);
    else return __builtin_amdgcn_ds_bpermute((lane_here() ^ O) << 2, v);
}
template <int O> __device__ __forceinline__ float shx(float v) { return __builtin_bit_cast(float, shxi<O>(__builtin_bit_cast(int, v))); }

constexpr size_t K_WS_BIG = (size_t)484 << 20, K_WS_TBL = (size_t)1 << 20, K_TB_COS64 = 0, K_TB_SIN64 = 256 * 1024, K_TB_COS32 = 512 * 1024, K_TB_SIN32 = 640 * 1024;

namespace pg8 {
#define PG8_LAS __attribute__((address_space(3)))
typedef unsigned short bf16_t;
typedef short bf16x8 __attribute__((ext_vector_type(8)));
typedef float f32x4 __attribute__((ext_vector_type(4)));
typedef unsigned u32x4 __attribute__((ext_vector_type(4)));
constexpr int BM = 256, BK = 64, HALF = 128, HTB = HALF * BK * 2  , STAGE_BYTES = 8 * HTB, NXCD = 8, WGM = 8;

__host__ __device__ __forceinline__ int lds_byte(int r, int c) { const int st = (r >> 4) * 2 + (c >> 5), rr = r & 15, cc = c & 31, ob = rr * 64 + cc * 2; return st * 1024 + (ob ^ (((ob >> 9) & 1) << 5)); }
__host__ __device__ __forceinline__ void stage_rc(int b, int& R, int& C) { const int st = b / 1024, sb = b % 1024, swz = sb ^ (((sb >> 9) & 1) << 5); R = (st >> 1) * 16 + swz / 64; C = (st & 1) * 32 + (swz % 64) / 2; }
__host__ __device__ __forceinline__ int perm32(int rho) { const int n = rho >> 4, i = rho & 15; return 8 * (i >> 2) + 4 * n + (i & 3); }

struct Unit { int pm, pn; };
struct Gemm { const bf16_t* A; const bf16_t* Bt; int M, N, K; };

struct StaticOrder {
    int nM, nN, nwg, G, c;
    __host__ __device__ void init(int M, int N, int G_, int c_) { nM = M / BM; nN = N / BM; nwg = nM * nN; G = G_; c = c_; }
    __host__ __device__ bool next(int i, Unit& u) const {
        const long L = (long)i * G + c; if (L >= nwg) return false;
        int wgid = (int)L; { const int q = nwg / NXCD, r = nwg % NXCD, xcd = wgid % NXCD, off = wgid / NXCD; wgid = (xcd < r ? xcd * (q + 1) : r * (q + 1) + (xcd - r) * q) + off; }
        const int nig = WGM * nN, gid = wgid / nig, fm = gid * WGM, gsz = (nM - fm) < WGM ? (nM - fm) : WGM;
        u.pm = fm + ((wgid % nig) % gsz); u.pn = (wgid % nig) / gsz; return true;
    }
    __device__ __forceinline__ void a_ready(const Unit&) const {}
    __device__ __forceinline__ void done(const Unit&) const {}
};

__device__ __forceinline__ unsigned cvt_pk_bf16(float lo, float hi) { unsigned r; asm volatile("v_cvt_pk_bf16_f32 %0, %1, %2" : "=v"(r) : "v"(lo), "v"(hi)); return r; }
typedef unsigned u32x2 __attribute__((ext_vector_type(2)));
typedef float f32x2 __attribute__((ext_vector_type(2)));
struct EpiBf16 {
    static constexpr bool PERM = true, AFTER_DRAIN = false;
    bf16_t* O; int ldc;
    __device__ __forceinline__ void operator()(const f32x4 (&acc)[2][2][4][2], const Unit& u, int wr, int wc, int fr, int fq) const {
        const int row0 = u.pm * BM + wr * 64 + fr; const int col0 = u.pn * BM + wc * 32 + 8 * fq;
#pragma unroll
        for (int ai = 0; ai < 2; ++ai)
#pragma unroll
            for (int m = 0; m < 4; ++m) { bf16_t* rowp = O + (size_t)(row0 + ai * HALF + m * 16) * ldc + col0;
#pragma unroll
                for (int bj = 0; bj < 2; ++bj) { const f32x4 v0 = acc[ai][bj][m][0], v1 = acc[ai][bj][m][1];
                    u32x4 w; w.x = cvt_pk_bf16(v0[0], v0[1]); w.y = cvt_pk_bf16(v0[2], v0[3]); w.z = cvt_pk_bf16(v1[0], v1[1]); w.w = cvt_pk_bf16(v1[2], v1[3]);
                    *(u32x4*)(rowp + bj * HALF) = w; } __builtin_amdgcn_sched_barrier(0); }
    }
};
__device__ __forceinline__ int proj_seg_type(int s) { return (s < 4 || s == 6 || s == 8) ? 1 : ((s >= 10 && s < 18) ? 2 : 0); }
struct EpiProjRope {
    static constexpr bool PERM = true, AFTER_DRAIN = false;
    unsigned char* ws; int ldc;
    __device__ __forceinline__ void operator()(const f32x4 (&acc)[2][2][4][2], const Unit& u, int wr, int wc, int fr, int fq) const {
        asm volatile("" : "+v"(fr), "+v"(fq));
        unsigned char* w_ = ws; asm volatile("" : "+s"(w_));
        bf16_t* O = (bf16_t*)(w_ + ::K_WS_BIG); const float* cos64 = (const float*)(w_ + ::K_WS_TBL + ::K_TB_COS64); const float* sin64 = (const float*)(w_ + ::K_WS_TBL + ::K_TB_SIN64);
        const float* cos32 = (const float*)(w_ + ::K_WS_TBL + ::K_TB_COS32); const float* sin32 = (const float*)(w_ + ::K_WS_TBL + ::K_TB_SIN32);
        const int s = u.pn * 4 + wc, ty = proj_seg_type(s);
        const int row0 = u.pm * BM + wr * 64 + fr;
        const int d0 = (ty == 2) ? 64 * s + 32 * (fq >> 1) + 8 * (fq & 1) : 64 * s + 8 * fq;
        const int dstep = (ty == 2) ? 16 : 32;
        const float* ct = (ty == 2) ? cos32 : cos64; const float* st = (ty == 2) ? sin32 : sin64;
        const int tw = (ty == 2) ? 16 : 32, i0 = (ty == 2) ? 8 * (fq & 1) : 8 * fq;
#pragma unroll
        for (int ai = 0; ai < 2; ++ai)
#pragma unroll
            for (int m = 0; m < 4; ++m) { const int row = row0 + ai * HALF + m * 16; bf16_t* rowp = O + (size_t)row * ldc + d0; const int pos = row & 2047;
#pragma unroll
                for (int n = 0; n < 2; ++n) { f32x4 x1 = acc[ai][0][m][n], x2 = acc[ai][1][m][n];
                    if (ty != 0) { const f32x4 cv = *(const f32x4*)(ct + pos * tw + i0 + 4 * n), sv = *(const f32x4*)(st + pos * tw + i0 + 4 * n);
                        const f32x4 y1 = x1 * cv - x2 * sv, y2 = x2 * cv + x1 * sv; x1 = y1; x2 = y2; }
                    u32x2 w; w.x = cvt_pk_bf16(x1[0], x1[1]); w.y = cvt_pk_bf16(x1[2], x1[3]); *(u32x2*)(rowp + 4 * n) = w;
                    w.x = cvt_pk_bf16(x2[0], x2[1]); w.y = cvt_pk_bf16(x2[2], x2[3]); *(u32x2*)(rowp + dstep + 4 * n) = w;
                    __builtin_amdgcn_sched_barrier(0); } }
    }
};
__device__ __forceinline__ float silu_mul(float g, float uu) { return g * uu * __builtin_amdgcn_rcpf(1.0f + __builtin_amdgcn_exp2f(-1.44269504f * g)); }
struct EpiSwiGLU {
    static constexpr bool PERM = true, AFTER_DRAIN = false;
    bf16_t* H; int ldh;
    __device__ __forceinline__ void operator()(const f32x4 (&acc)[2][2][4][2], const Unit& u, int wr, int wc, int fr, int fq) const {
        const int row0 = u.pm * BM + wr * 64 + fr; const int col0 = u.pn * HALF + wc * 32 + 8 * fq;
#pragma unroll
        for (int ai = 0; ai < 2; ++ai)
#pragma unroll
            for (int m = 0; m < 4; ++m) { bf16_t* rowp = H + (size_t)(row0 + ai * HALF + m * 16) * ldh + col0;
                const f32x4 g0 = acc[ai][0][m][0], g1 = acc[ai][0][m][1], u0 = acc[ai][1][m][0], u1 = acc[ai][1][m][1];
                u32x4 w; w.x = cvt_pk_bf16(silu_mul(g0[0], u0[0]), silu_mul(g0[1], u0[1])); w.y = cvt_pk_bf16(silu_mul(g0[2], u0[2]), silu_mul(g0[3], u0[3]));
                w.z = cvt_pk_bf16(silu_mul(g1[0], u1[0]), silu_mul(g1[1], u1[1])); w.w = cvt_pk_bf16(silu_mul(g1[2], u1[2]), silu_mul(g1[3], u1[3]));
                *(u32x4*)rowp = w; __builtin_amdgcn_sched_barrier(0); }
    }
};
template <bool FROMBF16> struct EpiResid {
    static constexpr bool PERM = false, AFTER_DRAIN = false;
    const float* X; bf16_t* YB; float alpha, s; const bf16_t* XBs;
    __device__ __forceinline__ void operator()(const f32x4 (&acc)[2][2][4][2], const Unit& u, int wr, int wc, int fr, int fq) const {
        asm volatile("" : "+v"(fr), "+v"(fq));
        float a_ = alpha, s_ = s; asm volatile("" : "+v"(a_), "+v"(s_));
        const int col0 = u.pn * BM + wc * 32 + 4 * fq;
#pragma unroll
        for (int ai = 0; ai < 2; ++ai)
#pragma unroll
            for (int m = 0; m < 4; ++m) { const int row = u.pm * BM + ai * HALF + wr * 64 + m * 16 + fr; const size_t off = (size_t)row * 1024 + col0;
#pragma unroll
                for (int bj = 0; bj < 2; ++bj)
#pragma unroll
                    for (int n = 0; n < 2; ++n) { f32x4 xv;
                        if (FROMBF16) { const u32x2 pw = *(const u32x2*)(XBs + off + bj * HALF + n * 16); xv[0] = __uint_as_float(pw.x << 16); xv[1] = __uint_as_float(pw.x & 0xffff0000u); xv[2] = __uint_as_float(pw.y << 16); xv[3] = __uint_as_float(pw.y & 0xffff0000u); }
                        else xv = *(const f32x4*)(X + off + bj * HALF + n * 16);
                        const f32x4 yv = xv * a_ + acc[ai][bj][m][n] * s_;
                        u32x2 w; w.x = cvt_pk_bf16(yv[0], yv[1]); w.y = cvt_pk_bf16(yv[2], yv[3]); *(u32x2*)(YB + off + bj * HALF + n * 16) = w; } }
    }
};
struct EpiPle {
    static constexpr bool PERM = false, AFTER_DRAIN = false;
    const bf16_t* XBs; float* OUT; bf16_t* XB; const float* bias; const bf16_t* PP;
    __device__ __forceinline__ void operator()(const f32x4 (&acc)[2][2][4][2], const Unit& u, int wr, int wc, int fr, int fq) const {
        const int col0 = u.pn * BM + wc * 32 + 4 * fq;
#pragma unroll
        for (int ai = 0; ai < 2; ++ai)
#pragma unroll
            for (int m = 0; m < 4; ++m) { const int row = u.pm * BM + ai * HALF + wr * 64 + m * 16 + fr; const size_t off = (size_t)row * 1024 + col0;
#pragma unroll
                for (int bj = 0; bj < 2; ++bj)
#pragma unroll
                    for (int n = 0; n < 2; ++n) { const int co = bj * HALF + n * 16;
                        f32x4 xv; { const u32x2 xw = *(const u32x2*)(XBs + off + co); xv[0] = __uint_as_float(xw.x << 16); xv[1] = __uint_as_float(xw.x & 0xffff0000u); xv[2] = __uint_as_float(xw.y << 16); xv[3] = __uint_as_float(xw.y & 0xffff0000u); }
                        const f32x4 bv = *(const f32x4*)(bias + col0 + co);
                        const u32x2 pw = *(const u32x2*)(PP + off + co);
                        f32x4 pv; pv[0] = __uint_as_float(pw.x << 16); pv[1] = __uint_as_float(pw.x & 0xffff0000u); pv[2] = __uint_as_float(pw.y << 16); pv[3] = __uint_as_float(pw.y & 0xffff0000u);
                        f32x4 o;
#pragma unroll
                        for (int e = 0; e < 4; ++e) { const float z = acc[ai][bj][m][n][e] + bv[e]; const float sg = __builtin_amdgcn_rcpf(1.0f + __builtin_amdgcn_exp2f(-1.44269504f * z)); o[e] = xv[e] + sg * pv[e]; }
                        *(f32x4*)(OUT + off + co) = o;
                        if (XB) { u32x2 w; w.x = cvt_pk_bf16(o[0], o[1]); w.y = cvt_pk_bf16(o[2], o[3]); *(u32x2*)(XB + off + co) = w; } } }
    }
};
template <class Epi, class Sched, bool ALIGN_EPI = false, bool SP2 = false>
__device__ __forceinline__ void gemm_phase(PG8_LAS unsigned char* lds, const Gemm g, const Sched& S, const Epi& E, const int tid_in) {
    int tid_ = tid_in; asm volatile("" : "+v"(tid_));
    const int tid = tid_, wid = __builtin_amdgcn_readfirstlane(tid >> 6), lane = tid & 63, wr = wid >> 2, wc = wid & 3, fr = lane & 15, fq = lane >> 4;
    const int K = g.K, nt = K / BK;
    unsigned voffA[2], voffB[2];
#pragma unroll
    for (int i = 0; i < 2; ++i) { int R, C; stage_rc(tid * 16 + i * 8192, R, C); const int Rb = Epi::PERM ? ((R & ~31) + perm32(R & 31)) : R;
        voffA[i] = (unsigned)(R * K + C) * 2u; voffB[i] = (unsigned)(Rb * K + C) * 2u; }
    const size_t kstep = (size_t)(BK * 2);
    const size_t hstep = (size_t)HALF * K * 2;
    const size_t tstep = 2 * hstep;
    const unsigned ldsw = (unsigned)wid * 1024u;
    const int aoff = lds_byte(wr * 64 + fr, fq * 8), boff = lds_byte(wc * 32 + fr, fq * 8);
#define PG8_SA(b, h) (((b) * 2 + (h)) * HTB)
#define PG8_SB(b, h) ((4 + (b) * 2 + (h)) * HTB)
#define PG8_STAGE(bufoff, gbase, voff) do { _Pragma("unroll") for (int _i = 0; _i < 2; ++_i) \
        __builtin_amdgcn_global_load_lds((const unsigned*)((const char*)(gbase) + (voff)[_i]), (PG8_LAS unsigned*)(lds + (bufoff) + ldsw + _i * 8192), 16, 0, 0); } while (0)
#define PG8_LDA(dst, b, h) do { _Pragma("unroll") for (int m = 0; m < 4; ++m) _Pragma("unroll") for (int k = 0; k < 2; ++k) dst[m][k] = *(const PG8_LAS bf16x8*)(lds + PG8_SA(b, h) + aoff + m * 2048 + k * 1024); } while (0)
#define PG8_LDB(dst, b, h) do { _Pragma("unroll") for (int n = 0; n < 2; ++n) _Pragma("unroll") for (int k = 0; k < 2; ++k) dst[n][k] = *(const PG8_LAS bf16x8*)(lds + PG8_SB(b, h) + boff + n * 2048 + k * 1024); } while (0)
#define PG8_MMA(ai, bj, At, Bt) do { __builtin_amdgcn_s_setprio(1); _Pragma("unroll") for (int m = 0; m < 4; ++m) _Pragma("unroll") for (int n = 0; n < 2; ++n) _Pragma("unroll") for (int k = 0; k < 2; ++k) \
        acc[ai][bj][m][n] = __builtin_amdgcn_mfma_f32_16x16x32_bf16(Bt[n][k], At[m][k], acc[ai][bj][m][n], 0, 0, 0); __builtin_amdgcn_s_setprio(0); } while (0)
#define PG8_WAIT_V(n) asm volatile("s_waitcnt vmcnt(" #n ")" ::: "memory")
#define PG8_WAIT_L(n) asm volatile("s_waitcnt lgkmcnt(" #n ")" ::: "memory")
#define PG8_BAR __builtin_amdgcn_s_barrier()
#define PG8_SCHED __builtin_amdgcn_sched_barrier(0)
    Unit cur, nxt; int ui = 0;
    if (!S.next(0, cur)) return;
    f32x4 acc[2][2][4][2];
#pragma unroll
    for (int a = 0; a < 2; ++a)
#pragma unroll
        for (int b = 0; b < 2; ++b)
#pragma unroll
            for (int m = 0; m < 4; ++m)
#pragma unroll
                for (int n = 0; n < 2; ++n) acc[a][b][m][n] = (f32x4){0.f, 0.f, 0.f, 0.f};
    bf16x8 At[4][2], B0[2][2], B1[2][2];
    const char* cA = (const char*)g.A + (size_t)cur.pm * tstep; const char* cB = (const char*)g.Bt + (size_t)cur.pn * tstep;
    S.a_ready(cur);
    if constexpr (SP2) {
        PG8_STAGE(PG8_SB(0, 0), cB, voffB); PG8_STAGE(PG8_SB(0, 1), cB + hstep, voffB); PG8_STAGE(PG8_SA(0, 0), cA, voffA); PG8_STAGE(PG8_SA(0, 1), cA + hstep, voffA);
        if (wr == 1) PG8_BAR;
        PG8_WAIT_V(2); PG8_BAR;
        PG8_STAGE(PG8_SB(1, 0), cB + kstep, voffB); PG8_STAGE(PG8_SA(1, 0), cA + kstep, voffA); PG8_STAGE(PG8_SB(1, 1), cB + hstep + kstep, voffB);
        PG8_WAIT_V(6); PG8_BAR;
    } else {
        PG8_STAGE(PG8_SB(0, 0), cB, voffB); PG8_STAGE(PG8_SA(0, 0), cA, voffA); PG8_STAGE(PG8_SB(0, 1), cB + hstep, voffB); PG8_STAGE(PG8_SA(0, 1), cA + hstep, voffA);
        if (wr == 1) PG8_BAR;
        PG8_WAIT_V(4); PG8_BAR;
        PG8_STAGE(PG8_SB(1, 0), cB + kstep, voffB); PG8_STAGE(PG8_SA(1, 0), cA + kstep, voffA); PG8_STAGE(PG8_SB(1, 1), cB + hstep + kstep, voffB);
        PG8_WAIT_V(6); PG8_BAR;
    }
    for (;;) {
        const bool has_next = S.next(ui + 1, nxt);
        const char* nA = has_next ? (const char*)g.A + (size_t)nxt.pm * tstep : cA; const char* nB = has_next ? (const char*)g.Bt + (size_t)nxt.pn * tstep : cB;
        for (int t = 0; t < nt; t += 2) {
            const bool last = (t == nt - 2);
            const char* a1 = cA + (size_t)(t + 1) * kstep;
            const char* a2 = last ? nA : cA + (size_t)(t + 2) * kstep; const char* b2 = last ? nB : cB + (size_t)(t + 2) * kstep;
            const char* a3 = a2 + kstep; const char* b3 = b2 + kstep;
            if (last && has_next) S.a_ready(nxt);
            if constexpr (SP2) {
            PG8_LDB(B0, 0, 0); PG8_LDB(B1, 0, 1); PG8_SCHED; PG8_LDA(At, 0, 0); PG8_STAGE(PG8_SA(1, 1), a1 + hstep, voffA);
            PG8_WAIT_V(8); PG8_WAIT_L(0); PG8_BAR; PG8_MMA(0, 0, At, B0); PG8_MMA(0, 1, At, B1); PG8_BAR; PG8_SCHED;
            PG8_LDA(At, 0, 1); PG8_STAGE(PG8_SB(0, 0), b2, voffB); PG8_STAGE(PG8_SB(0, 1), b2 + hstep, voffB); PG8_STAGE(PG8_SA(0, 0), a2, voffA);
            PG8_WAIT_V(8); PG8_WAIT_L(0); PG8_BAR; PG8_MMA(1, 0, At, B0); PG8_MMA(1, 1, At, B1); PG8_BAR; PG8_SCHED;
            PG8_LDB(B0, 1, 0); PG8_LDB(B1, 1, 1); PG8_SCHED; PG8_LDA(At, 1, 0); PG8_STAGE(PG8_SA(0, 1), a2 + hstep, voffA);
            PG8_WAIT_V(8); PG8_WAIT_L(0); PG8_BAR; PG8_MMA(0, 0, At, B0); PG8_MMA(0, 1, At, B1); PG8_BAR; PG8_SCHED;
            PG8_LDA(At, 1, 1); PG8_STAGE(PG8_SB(1, 0), b3, voffB); PG8_STAGE(PG8_SB(1, 1), b3 + hstep, voffB); PG8_STAGE(PG8_SA(1, 0), a3, voffA);
            PG8_WAIT_V(8); PG8_WAIT_L(0); PG8_BAR; PG8_MMA(1, 0, At, B0); PG8_MMA(1, 1, At, B1); PG8_BAR; PG8_SCHED;
            } else {
            PG8_LDB(B0, 0, 0); PG8_SCHED; PG8_LDA(At, 0, 0); PG8_STAGE(PG8_SA(1, 1), a1 + hstep, voffA);
            PG8_WAIT_L(8); PG8_BAR; PG8_WAIT_L(0); PG8_MMA(0, 0, At, B0); PG8_BAR; PG8_SCHED;
            PG8_LDB(B1, 0, 1); PG8_STAGE(PG8_SB(0, 0), b2, voffB);
            PG8_BAR; PG8_WAIT_L(0); PG8_MMA(0, 1, At, B1); PG8_BAR;
            PG8_LDA(At, 0, 1); PG8_STAGE(PG8_SA(0, 0), a2, voffA);
            PG8_BAR; PG8_WAIT_L(0); PG8_MMA(1, 0, At, B0); PG8_BAR; PG8_SCHED;
            PG8_STAGE(PG8_SB(0, 1), b2 + hstep, voffB);
            PG8_WAIT_V(6); PG8_BAR; PG8_MMA(1, 1, At, B1); PG8_BAR;
            PG8_LDB(B0, 1, 0); PG8_SCHED; PG8_LDA(At, 1, 0); PG8_STAGE(PG8_SA(0, 1), a2 + hstep, voffA);
            PG8_WAIT_L(8); PG8_BAR; PG8_WAIT_L(0); PG8_MMA(0, 0, At, B0); PG8_BAR; PG8_SCHED;
            PG8_LDB(B1, 1, 1); PG8_STAGE(PG8_SB(1, 0), b3, voffB);
            PG8_BAR; PG8_WAIT_L(0); PG8_MMA(0, 1, At, B1); PG8_BAR;
            PG8_LDA(At, 1, 1); PG8_STAGE(PG8_SA(1, 0), a3, voffA);
            PG8_BAR; PG8_WAIT_L(0); PG8_MMA(1, 0, At, B0); PG8_BAR; PG8_SCHED;
            PG8_STAGE(PG8_SB(1, 1), b3 + hstep, voffB);
            PG8_WAIT_V(6); PG8_BAR; PG8_MMA(1, 1, At, B1); PG8_BAR;
            }
        }
        if constexpr (ALIGN_EPI) { if (wr == 0) PG8_BAR; }
        if constexpr (!Epi::AFTER_DRAIN) { E(acc, cur, wr, wc, fr, fq); S.done(cur); }
        if (!has_next) break;
#pragma unroll
        for (int a = 0; a < 2; ++a)
#pragma unroll
            for (int b = 0; b < 2; ++b)
#pragma unroll
                for (int m = 0; m < 4; ++m)
#pragma unroll
                    for (int n = 0; n < 2; ++n) acc[a][b][m][n] = (f32x4){0.f, 0.f, 0.f, 0.f};
        cur = nxt; cA = nA; cB = nB; ++ui;
        if constexpr (ALIGN_EPI) { if (wr == 1) PG8_BAR; }
    }
    PG8_WAIT_V(0);
    if constexpr (!ALIGN_EPI) { if (wr == 0) PG8_BAR; }
    PG8_BAR;
    if constexpr (Epi::AFTER_DRAIN) { E.fused(acc, cur, wr, wc, fr, fq, lds, wid, lane); S.done(cur); }
#undef PG8_SA
#undef PG8_SB
#undef PG8_STAGE
#undef PG8_LDA
#undef PG8_LDB
#undef PG8_MMA
#undef PG8_WAIT_V
#undef PG8_WAIT_L
#undef PG8_BAR
#undef PG8_SCHED
}
}
#define DI __device__ __forceinline__
#define LAS __attribute__((address_space(3)))
typedef unsigned short bf16_t;
typedef short bf16x8 __attribute__((ext_vector_type(8)));
typedef short s16x4 __attribute__((ext_vector_type(4)));
typedef float f32x2 __attribute__((ext_vector_type(2)));
typedef float f32x4 __attribute__((ext_vector_type(4)));
typedef float f32x16 __attribute__((ext_vector_type(16)));
typedef unsigned u32x2 __attribute__((ext_vector_type(2)));
typedef unsigned u32x4 __attribute__((ext_vector_type(4)));
typedef __bf16 bf16x2_t __attribute__((ext_vector_type(2)));

constexpr int DM = 1024, BATCH = 32, SEQ = 2048, DEPTH = 2, MTOK = BATCH * SEQ, DFF = 2752, DFFP = 2816, NUP = 2 * DFFP, NPROJ = 3072, PLED = 256;
constexpr int IN_COLS = 2964;
constexpr int C_NQ = 0, C_NKV = 256, C_DQ = 640, C_DK = 896, C_DV = 1152, C_FQ = 1408, C_FK = 1920, C_FV = 2432, C_NG = 2944, C_FF = 2956;
constexpr float LN_EPS = 1e-5f;
constexpr float DN_ALPHA = 1.41421356237f;
constexpr float LOG2E = 1.44269504089f;

constexpr size_t MiB = 1u << 20;
constexpr size_t WS_CTL = 0;
constexpr size_t WS_TBL = 1 * MiB;
constexpr size_t TB_COS64 = 0, TB_SIN64 = 256 * 1024, TB_COS32 = 512 * 1024, TB_SIN32 = 640 * 1024, TB_CBIAS = 768 * 1024, TB_LAM = 772 * 1024;
constexpr size_t WS_KC = 2 * MiB, WS_VC = 2 * MiB + 512 * 1024;
constexpr size_t WS_SEL = 3 * MiB;
constexpr size_t WS_CKL = 4 * MiB;
constexpr size_t WS_W = 8 * MiB, W_LAYER = 46 * MiB;
constexpr size_t W_UP1 = 0, W_DN1 = 11 * MiB, W_UP2 = W_DN1 + 5632 * 1024, W_DN2 = W_UP2 + 11 * MiB, W_IN = W_DN2 + 5632 * 1024, W_OUT = W_IN + 6 * MiB,
                 W_PLEG = W_OUT + 2 * MiB, W_PLEP = W_PLEG + 2 * MiB, W_K1 = W_PLEP + 512 * 1024, W_V1 = W_K1 + 1 * MiB, W_K2 = W_V1 + 1 * MiB, W_V2 = W_K2 + 32 * 1024;
static_assert(W_V2 + 32 * 1024 <= W_LAYER, "weights fit");
constexpr size_t WS_XB = 100 * MiB;
constexpr size_t WS_PB = 228 * MiB;
constexpr size_t WS_OCMP = 292 * MiB;
constexpr size_t WS_MIX = 356 * MiB;
constexpr size_t WS_BIG = 484 * MiB;
constexpr size_t WS_END = 868 * MiB;
constexpr size_t WS_LNST = 6 * MiB;
static_assert(K_WS_BIG == WS_BIG && K_WS_TBL == WS_TBL && K_TB_COS64 == TB_COS64 && K_TB_SIN64 == TB_SIN64 && K_TB_COS32 == TB_COS32 && K_TB_SIN32 == TB_SIN32, "epilogue offsets");
constexpr int CW_QUEUE = 64;

DI unsigned pk2(float lo, float hi) { f32x2 v = {lo, hi}; return __builtin_bit_cast(unsigned, __builtin_convertvector(v, bf16x2_t)); }
DI float bf2f(bf16_t h) { return __uint_as_float((unsigned)h << 16); }
DI bf16_t f2bf(float f) { return (bf16_t)(pk2(f, 0.f) & 0xffffu); }
DI float wave_sum(float v) {
    v += shx<1>(v); v += shx<2>(v); v += shx<4>(v); v += shx<8>(v); v += shx<16>(v); v += shx<32>(v);
    return v;
}
DI int crow(int i, int hh) { return (i & 3) + 8 * (i >> 2) + 4 * hh; }
#define MFMA32(a, b, c) __builtin_amdgcn_mfma_f32_32x32x16_bf16((a), (b), (c), 0, 0, 0)
#define MFMA16(a, b, c) __builtin_amdgcn_mfma_f32_16x16x32_bf16((a), (b), (c), 0, 0, 0)
#define LDS_WAIT() asm volatile("s_waitcnt lgkmcnt(0)" ::: "memory")

struct Args {
    const float* in[24]; float* out; unsigned char* ws; int ph_lo, ph_hi;
};
typedef const __attribute__((address_space(4))) Args* ARGP;
struct Ctx {
    int tid, lane, wave, bid, G;
    unsigned char* ws; LAS unsigned char* lds;
};

DI void tr_item(const float* W, int ldn, int Ksrc, int srccol, bf16_t* WT, int ldk, int k0, int nrow0, LAS float* scr, int lane) {
#pragma unroll
    for (int i = 0; i < 32; ++i) { const int kk = 2 * i + (lane >> 5), k = k0 + kk; float v = 0.f; if (srccol >= 0 && k < Ksrc) v = W[(size_t)k * ldn + srccol]; scr[kk * 33 + (lane & 31)] = v; }
    LDS_WAIT();
    const int c = lane & 7;
#pragma unroll
    for (int j = 0; j < 4; ++j) { const int n = (lane >> 3) + 8 * j; const LAS float* s = scr + (8 * c) * 33 + n;
        u32x4 o; o.x = pk2(s[0 * 33], s[1 * 33]); o.y = pk2(s[2 * 33], s[3 * 33]); o.z = pk2(s[4 * 33], s[5 * 33]); o.w = pk2(s[6 * 33], s[7 * 33]);
        *(u32x4*)(WT + (size_t)(nrow0 + n) * ldk + k0 + 8 * c) = o; }
    LDS_WAIT();
}
DI int proj_col_of_row(int n) { const int tile = n >> 8, bj = (n >> 7) & 1, wc = (n >> 5) & 3, j = n & 31, sg = tile * 4 + wc;
    return (sg >= 10 && sg < 18) ? 64 * sg + 32 * (j >> 4) + 16 * bj + (j & 15) : 64 * sg + 32 * bj + j; }
DI int win_map(int n) { return n < 640 ? n : (n < 2944 ? n + 12 : (n < 2956 ? n - 2944 + 640 : (n < 2964 ? n : -1))); }

DI void prep_phase(const Ctx& C, ARGP a) {
    LAS float* scr = (LAS float*)(C.lds + C.wave * 16384);
    const int gw = C.bid * 8 + C.wave, NGW = C.G * 8, lane = C.lane;
    constexpr int I_UP = 16 * 176, I_DN = 44 * 32, I_IN = 16 * 96, I_SQ = 16 * 32, I_PP = 4 * 32, I_P1 = 32 * 8, I_P2 = 4 * 2;
    constexpr int PER_LAYER = 2 * I_UP + 2 * I_DN + I_IN + 2 * I_SQ + I_PP + 2 * I_P1 + 2 * I_P2;
    for (int it = gw; it < DEPTH * PER_LAYER; it += NGW) {
        const int L = it / PER_LAYER; int r = it % PER_LAYER;
        unsigned char* wb = C.ws + WS_W + (size_t)L * W_LAYER;
        if (r < 2 * I_UP) { const int f = r / I_UP; r %= I_UP; const int kb = r / 176, nb = r % 176; const int n = 32 * nb + (lane & 31);
            const int pn = n >> 8, bj = (n >> 7) & 1, hid = 128 * pn + (n & 127);
            const float* src = a->in[(f ? 7 : 4) + bj] + (size_t)L * DM * DFF;
            tr_item(src, DFF, DM, hid < DFF ? hid : -1, (bf16_t*)(wb + (f ? W_UP2 : W_UP1)), DM, 64 * kb, 32 * nb, scr, lane); continue; }
        r -= 2 * I_UP;
        if (r < 2 * I_DN) { const int f = r / I_DN; r %= I_DN; const int kb = r / 32, nb = r % 32;
            const float* src = a->in[f ? 9 : 6] + (size_t)L * DFF * DM;
            tr_item(src, DM, DFF, 32 * nb + (lane & 31), (bf16_t*)(wb + (f ? W_DN2 : W_DN1)), DFFP, 64 * kb, 32 * nb, scr, lane); continue; }
        r -= 2 * I_DN;
        if (r < I_IN) { const int kb = r / 96, nb = r % 96;
            tr_item(a->in[10] + (size_t)L * DM * IN_COLS, IN_COLS, DM, win_map(proj_col_of_row(32 * nb + (lane & 31))), (bf16_t*)(wb + W_IN), DM, 64 * kb, 32 * nb, scr, lane); continue; }
        r -= I_IN;
        if (r < 2 * I_SQ) { const int f = r / I_SQ; r %= I_SQ; const int kb = r / 32, nb = r % 32;
            tr_item(a->in[f ? 21 : 20] + (size_t)L * DM * DM, DM, DM, 32 * nb + (lane & 31), (bf16_t*)(wb + (f ? W_PLEG : W_OUT)), DM, 64 * kb, 32 * nb, scr, lane); continue; }
        r -= 2 * I_SQ;
        if (r < I_PP) { const int kb = r / 32, nb = r % 32;
            tr_item(a->in[23] + (size_t)L * PLED * DM, DM, PLED, 32 * nb + (lane & 31), (bf16_t*)(wb + W_PLEP), PLED, 64 * kb, 32 * nb, scr, lane); continue; }
        r -= I_PP;
        if (r < 2 * I_P1) { const int f = r / I_P1; r %= I_P1; const int kb = r / 8, nb = r % 8;
            tr_item(a->in[f ? 16 : 14] + (size_t)L * 2048 * 256, 256, 2048, 32 * nb + (lane & 31), (bf16_t*)(wb + (f ? W_V1 : W_K1)), 2048, 64 * kb, 32 * nb, scr, lane); continue; }
        r -= 2 * I_P1;
        { const int f = r / I_P2; r %= I_P2; const int kb = r / 2, nb = r % 2;
            tr_item(a->in[f ? 17 : 15] + (size_t)L * 256 * 64, 64, 256, 32 * nb + (lane & 31), (bf16_t*)(wb + (f ? W_V2 : W_K2)), 256, 64 * kb, 32 * nb, scr, lane); }
    }
    const size_t gt = (size_t)C.bid * 512 + C.tid, NT = (size_t)C.G * 512;
    { const float* x = a->in[0]; bf16_t* xb = (bf16_t*)(C.ws + WS_XB); const float* p = a->in[1]; bf16_t* pb = (bf16_t*)(C.ws + WS_PB);
      constexpr size_t NX = (size_t)MTOK * DM / 8, NP = (size_t)DEPTH * MTOK * PLED / 8;
      for (size_t i0 = gt; i0 < NX + NP; i0 += 4 * NT) { f32x4 v[4][2];
#pragma unroll
          for (int q = 0; q < 4; ++q) { size_t i = i0 + q * NT; if (i >= NX + NP) i = gt; const float* src = i < NX ? x + i * 8 : p + (i - NX) * 8; v[q][0] = *(const f32x4*)src; v[q][1] = *(const f32x4*)(src + 4); }
#pragma unroll
          for (int q = 0; q < 4; ++q) { size_t i = i0 + q * NT; if (i >= NX + NP) i = gt; bf16_t* dst = i < NX ? xb + i * 8 : pb + (i - NX) * 8;
              u32x4 o; o.x = pk2(v[q][0][0], v[q][0][1]); o.y = pk2(v[q][0][2], v[q][0][3]); o.z = pk2(v[q][1][0], v[q][1][1]); o.w = pk2(v[q][1][2], v[q][1][3]); *(u32x4*)dst = o; } } }
    { float* tb = (float*)(C.ws + WS_TBL);
      for (size_t i = gt; i < (size_t)SEQ * 48; i += NT) {
          int pos, k; float inv; const bool big = i < (size_t)SEQ * 32; size_t j;
          if (big) { j = i; pos = (int)(i >> 5); k = (int)(i & 31); inv = exp2f(-(float)k * (13.2877123795f / 32.0f)); }
          else { j = i - (size_t)SEQ * 32; pos = (int)(j >> 4); k = (int)(j & 15); inv = exp2f(-(float)k * (13.2877123795f / 16.0f)); }
          const float ang = (float)pos * inv; double rv = (double)ang * 0.15915494309189535; rv -= floor(rv); const float fr = (float)rv;
          const float cs = __builtin_amdgcn_cosf(fr), sn = __builtin_amdgcn_sinf(fr);
          if (big) { tb[TB_COS64 / 4 + j] = cs; tb[TB_SIN64 / 4 + j] = sn; } else { tb[TB_COS32 / 4 + j] = cs; tb[TB_SIN32 / 4 + j] = sn; } } }
    { float* cb = (float*)(C.ws + WS_TBL + TB_CBIAS);
      for (int o = gw; o < DEPTH * 2 * 256; o += NGW) { const int L = o >> 9, kv = (o >> 8) & 1, n = o & 255;
          const float* pe = a->in[kv ? 13 : 12] + (size_t)L * 2048; const float* w1 = a->in[kv ? 16 : 14] + (size_t)L * 2048 * 256;
          float s = 0.f; for (int k = lane; k < 2048; k += 64) s += pe[k] * w1[(size_t)k * 256 + n];
          s = wave_sum(s); if (lane == 0) cb[o] = s; } }
    if (C.bid == 0 && C.tid < DEPTH) { const int L = C.tid; const float* lp = a->in[18] + L * 128; float s1 = 0.f, s2 = 0.f;
        for (int k = 0; k < 32; ++k) { s1 += lp[k] * lp[32 + k]; s2 += lp[64 + k] * lp[96 + k]; }
        const float li = 0.8f - 0.6f * expf(-0.3f * (float)L);
        ((float*)(C.ws + WS_TBL + TB_LAM))[L] = expf(s1) - expf(s2) + li; }
}

DI void ln_phase(const Ctx& C, bf16_t* XB, const float* g, const float* b) {
    const int gw = C.bid * 8 + C.wave, NGW = C.G * 8, lane = C.lane;
    f32x4 gv[4], bv[4];
#pragma unroll
    for (int j = 0; j < 4; ++j) { gv[j] = *(const f32x4*)(g + 16 * lane + 4 * j); bv[j] = *(const f32x4*)(b + 16 * lane + 4 * j); }
    for (int m = gw; m < MTOK; m += NGW) {
        u32x4* xr = (u32x4*)(XB + (size_t)m * DM + 16 * lane); const u32x4 r0 = xr[0], r1 = xr[1];
        f32x4 v[4];
        v[0][0] = __uint_as_float(r0.x << 16); v[0][1] = __uint_as_float(r0.x & 0xffff0000u); v[0][2] = __uint_as_float(r0.y << 16); v[0][3] = __uint_as_float(r0.y & 0xffff0000u);
        v[1][0] = __uint_as_float(r0.z << 16); v[1][1] = __uint_as_float(r0.z & 0xffff0000u); v[1][2] = __uint_as_float(r0.w << 16); v[1][3] = __uint_as_float(r0.w & 0xffff0000u);
        v[2][0] = __uint_as_float(r1.x << 16); v[2][1] = __uint_as_float(r1.x & 0xffff0000u); v[2][2] = __uint_as_float(r1.y << 16); v[2][3] = __uint_as_float(r1.y & 0xffff0000u);
        v[3][0] = __uint_as_float(r1.z << 16); v[3][1] = __uint_as_float(r1.z & 0xffff0000u); v[3][2] = __uint_as_float(r1.w << 16); v[3][3] = __uint_as_float(r1.w & 0xffff0000u);
        float s = 0.f;
#pragma unroll
        for (int j = 0; j < 4; ++j) s += (v[j][0] + v[j][1]) + (v[j][2] + v[j][3]);
        const float mean = wave_sum(s) * (1.f / DM); float s2 = 0.f;
#pragma unroll
        for (int j = 0; j < 4; ++j) { v[j] = v[j] - mean; s2 += (v[j][0] * v[j][0] + v[j][1] * v[j][1]) + (v[j][2] * v[j][2] + v[j][3] * v[j][3]); }
        const float rstd = 1.0f / sqrtf(wave_sum(s2) * (1.f / DM) + LN_EPS);
        f32x4 o[4];
#pragma unroll
        for (int j = 0; j < 4; ++j) o[j] = v[j] * rstd * gv[j] + bv[j];
        u32x4 w0, w1; w0.x = pk2(o[0][0], o[0][1]); w0.y = pk2(o[0][2], o[0][3]); w0.z = pk2(o[1][0], o[1][1]); w0.w = pk2(o[1][2], o[1][3]);
        w1.x = pk2(o[2][0], o[2][1]); w1.y = pk2(o[2][2], o[2][3]); w1.z = pk2(o[3][0], o[3][1]); w1.w = pk2(o[3][2], o[3][3]);
        xr[0] = w0; xr[1] = w1;
    }
}
#define XLAS __attribute__((address_space(3)))
#define XB_TMO      128
#define XB_XCNT(j)  (256  + 64 * (j))
#define XB_XSUB(j)  (1280 + 64 * (j))
#define XB_XGEN(j)  (2304 + 64 * (j))
#define XB_TOP      3328
#define XB_TOPGEN   3392
#define XCD_BAR_WORDS 3456
#define XB_SPIN_CAP (1u << 18)

__device__ __forceinline__ unsigned xb_ld(unsigned* p)              { return __hip_atomic_load(p, __ATOMIC_RELAXED, __HIP_MEMORY_SCOPE_AGENT); }
__device__ __forceinline__ unsigned xb_add(unsigned* p, unsigned v) { return __hip_atomic_fetch_add(p, v, __ATOMIC_RELAXED, __HIP_MEMORY_SCOPE_AGENT); }
__device__ __forceinline__ unsigned xb_xcc_id() { return (unsigned)__builtin_amdgcn_s_getreg((3 << 11) | 20) & 0xFu; }
#define XB_SPIN(cond, bar) do { unsigned _sp = 0; while (cond) { __builtin_amdgcn_s_sleep(1); \
    if ((++_sp & 255u) == 0u) { if (xb_ld(&(bar)[XB_TMO])) break; if (_sp > XB_SPIN_CAP) { atomicAdd(&(bar)[XB_TMO], 1u); break; } } } } while (0)

struct XcdBarrier {
    unsigned* bar; unsigned x;
    volatile XLAS unsigned* st;
};

__device__ __forceinline__ XcdBarrier xcd_barrier_post(unsigned* bar, volatile XLAS unsigned* st) {
    XcdBarrier b; b.bar = bar; b.x = xb_xcc_id(); b.st = st;
    if (threadIdx.x == 0) (void)xb_add(&bar[XB_XCNT(b.x)], 1u);
    return b;
}
__device__ __forceinline__ void xcd_barrier_complete(unsigned* bar, unsigned x, unsigned& nloc, unsigned& nx) {
    const unsigned G = gridDim.x * gridDim.y * gridDim.z;
    unsigned sum, cnt, mine, sp = 0u;
    for (;;) {
        sum = 0u; cnt = 0u; mine = 0u;
#pragma unroll
        for (unsigned j = 0; j < 16; ++j) { const unsigned c = xb_ld(&bar[XB_XCNT(j)]); sum += c; cnt += (c > 0u) ? 1u : 0u; mine = (j == x) ? c : mine; }
        if (sum == G) break;
        __builtin_amdgcn_s_sleep(1);
        if ((++sp & 255u) == 0u) { if (xb_ld(&bar[XB_TMO])) break; if (sp > XB_SPIN_CAP) { atomicAdd(&bar[XB_TMO], 1u); break; } }
    }
    nloc = mine > 0u ? mine : 1u; nx = cnt > 0u ? cnt : 1u;
}

__device__ __forceinline__ void xcd_barrier(const XcdBarrier& b) {
    asm volatile("s_waitcnt vmcnt(0)" ::: "memory");
    __syncthreads();
    if (threadIdx.x == 0) {
        unsigned* bar = b.bar;
        __builtin_amdgcn_s_waitcnt(0);
        unsigned nloc = b.st[0], nx = b.st[1];
        if (nloc == 0u) { xcd_barrier_complete(bar, b.x, nloc, nx); b.st[0] = nloc; b.st[1] = nx; }
        const unsigned old = xb_add(&bar[XB_XSUB(b.x)], 1u);
        const unsigned gen = old / nloc;
        if (old + 1u == (gen + 1u) * nloc) {
            __builtin_amdgcn_fence(__ATOMIC_RELEASE, "agent");
            asm volatile("s_waitcnt vmcnt(0)" ::: "memory");
            const unsigned og = xb_add(&bar[XB_TOP], 1u);
            const unsigned tg = og / nx;
            if (og + 1u == (tg + 1u) * nx) xb_add(&bar[XB_TOPGEN], 1u);
            else XB_SPIN(xb_ld(&bar[XB_TOPGEN]) == tg, bar);
            __builtin_amdgcn_fence(__ATOMIC_ACQUIRE, "agent");
            xb_add(&bar[XB_XGEN(b.x)], 1u);
            asm volatile("s_waitcnt vmcnt(0)" ::: "memory");
        } else {
            XB_SPIN(xb_ld(&bar[XB_XGEN(b.x)]) == gen, bar);
            __builtin_amdgcn_fence(__ATOMIC_ACQUIRE, "agent");
            asm volatile("s_waitcnt vmcnt(0)" ::: "memory");
        }
    }
    __syncthreads();
}
DI float gelu_tanh(float x) { const float z = 0.7978845608f * (x + 0.044715f * x * x * x); const float e = __builtin_amdgcn_exp2f(2.0f * LOG2E * z); return 0.5f * x * (2.0f - 2.0f * __builtin_amdgcn_rcpf(e + 1.0f)); }

DI void cmp_mlp_unit(const Ctx& C, const bf16_t* proj, int b, int cgp, int kv, const bf16_t* W1t, const bf16_t* W2t, const float* bias, bf16_t* outp, const float* cos64, const float* sin64) {
    constexpr int SP = 72, HP = 264;
    LAS bf16_t* span = (LAS bf16_t*)C.lds;
    LAS bf16_t* Hs = (LAS bf16_t*)(C.lds + 528 * SP * 2);
    LAS float* Os = (LAS float*)(C.lds + 528 * SP * 2 + 32 * HP * 2);
    const int tid = C.tid, lane = C.lane, w = C.wave, row16 = lane & 15, quad = lane >> 4;
    const int t0 = 512 * cgp;
    for (int idx = tid; idx < 528 * 8; idx += 512) { const int tr = idx >> 3, ch = idx & 7, t = t0 + tr; u32x4 v = {0u, 0u, 0u, 0u};
        if (t < SEQ) v = *(const u32x4*)(proj + (size_t)(b * SEQ + t) * NPROJ + C_NKV + kv * 64 + ch * 8);
        *(LAS u32x4*)(span + tr * SP + ch * 8) = v; }
    __syncthreads();
    f32x4 acc[2][2];
#pragma unroll
    for (int i = 0; i < 2; ++i)
#pragma unroll
        for (int j = 0; j < 2; ++j) acc[i][j] = (f32x4){0.f, 0.f, 0.f, 0.f};
    const bf16_t* wb0 = W1t + (size_t)(32 * w + row16) * 2048 + quad * 8;
#pragma unroll 4
    for (int ks = 0; ks < 64; ++ks) { const int l = ks >> 1, dq = ks & 1, k0 = l * 64 + 32 * dq;
        const bf16x8 b0 = *(const bf16x8*)(wb0 + k0), b1 = *(const bf16x8*)(wb0 + 16 * 2048 + k0);
        const bf16x8 a0 = *(const LAS bf16x8*)(span + (16 * row16 + l) * SP + 32 * dq + quad * 8);
        const bf16x8 a1 = *(const LAS bf16x8*)(span + (16 * (16 + row16) + l) * SP + 32 * dq + quad * 8);
        acc[0][0] = MFMA16(a0, b0, acc[0][0]); acc[0][1] = MFMA16(a0, b1, acc[0][1]); acc[1][0] = MFMA16(a1, b0, acc[1][0]); acc[1][1] = MFMA16(a1, b1, acc[1][1]); }
#pragma unroll
    for (int mi = 0; mi < 2; ++mi)
#pragma unroll
        for (int ni = 0; ni < 2; ++ni) { const int n = 32 * w + 16 * ni + row16; const float bs = bias[n];
#pragma unroll
            for (int j = 0; j < 4; ++j) Hs[(16 * mi + quad * 4 + j) * HP + n] = f2bf(gelu_tanh(acc[mi][ni][j] + bs)); }
    __syncthreads();
    { const int mt = w >> 2, nt = w & 3; f32x4 a2 = {0.f, 0.f, 0.f, 0.f};
#pragma unroll
      for (int ks = 0; ks < 8; ++ks) { const bf16x8 av = *(const LAS bf16x8*)(Hs + (16 * mt + row16) * HP + 32 * ks + quad * 8);
          const bf16x8 bv = *(const bf16x8*)(W2t + (size_t)(16 * nt + row16) * 256 + 32 * ks + quad * 8); a2 = MFMA16(av, bv, a2); }
#pragma unroll
      for (int j = 0; j < 4; ++j) Os[(16 * mt + quad * 4 + j) * 64 + 16 * nt + row16] = a2[j]; }
    __syncthreads();
    { const int c = tid >> 4, cglob = 32 * cgp + c; bf16_t* op = outp + (size_t)(b * 128 + cglob) * 64;
#pragma unroll
      for (int e = 0; e < 2; ++e) { const int i = (tid & 15) * 2 + e; float x1 = Os[c * 64 + i], x2 = Os[c * 64 + i + 32];
          if (cglob >= 127) { x1 = 0.f; x2 = 0.f; }
          else if (kv == 0) { const int pos = 16 * cglob + 31; const float cs = cos64[pos * 32 + i], sn = sin64[pos * 32 + i]; const float y1 = x1 * cs - x2 * sn, y2 = x2 * cs + x1 * sn; x1 = y1; x2 = y2; }
          op[i] = f2bf(x1); op[i + 32] = f2bf(x2); } }
    __syncthreads();
}

DI void attn_prep_phase(const Ctx& C, ARGP a, int L) {
    bf16_t* proj = (bf16_t*)(C.ws + WS_BIG);
    const float* tb = (const float*)(C.ws + WS_TBL);
    const float* cos64 = tb + TB_COS64 / 4; const float* sin64 = tb + TB_SIN64 / 4; const float* cos32 = tb + TB_COS32 / 4; const float* sin32 = tb + TB_SIN32 / 4;
    unsigned char* wb = C.ws + WS_W + (size_t)L * W_LAYER;
    for (int u = C.bid; u < BATCH * 4 * 2; u += C.G) { const int kv = u & 1, cgp = (u >> 1) & 3, b = u >> 3;
        cmp_mlp_unit(C, proj, b, cgp, kv, (const bf16_t*)(wb + (kv ? W_V1 : W_K1)), (const bf16_t*)(wb + (kv ? W_V2 : W_K2)),
                     (const float*)(C.ws + WS_TBL + TB_CBIAS) + (L * 2 + kv) * 256, (bf16_t*)(C.ws + (kv ? WS_VC : WS_KC)), cos64, sin64); }
    const int gw = C.bid * 8 + C.wave, NGW = C.G * 8, lane = C.lane;
    for (int u = gw; u < BATCH * 8; u += NGW) { const int b = u >> 3, h = u & 7; const float bf = a->in[11][L * 8 + h];
        float* ck = (float*)(C.ws + WS_CKL) + (size_t)u * SEQ + lane * 32; const bf16_t* fp = proj + (size_t)(b * SEQ + lane * 32) * NPROJ + C_FF + h;
        float run = 0.f; float loc[32];
#pragma unroll
        for (int i = 0; i < 32; ++i) { const float x = bf2f(fp[(size_t)i * NPROJ]) + bf; const float ls = fminf(x, 0.f) - log1pf(expf(-fabsf(x))); run += ls; loc[i] = run; }
        float incl = run;
#pragma unroll
        for (int o = 1; o < 64; o <<= 1) { const float t = __builtin_bit_cast(float, __builtin_amdgcn_ds_bpermute((lane - o) << 2, __builtin_bit_cast(int, incl))); if (lane >= o) incl += t; }
        const float base = incl - run;
#pragma unroll
        for (int i = 0; i < 32; ++i) ck[i] = (base + loc[i]) * LOG2E; }
}

constexpr int KP = 72;
DI void cmp_attn_phase(const Ctx& C, int L) {
    const bf16_t* proj = (const bf16_t*)(C.ws + WS_BIG);
    LAS bf16_t* Ks = (LAS bf16_t*)C.lds;
    LAS bf16_t* Vs = (LAS bf16_t*)(C.lds + 128 * KP * 2);
    LAS float* Ps = (LAS float*)(C.lds + 2 * 128 * KP * 2 + C.wave * 5120);
    LAS float* Sc = Ps + 8 * 128;
    const int tid = C.tid, lane = C.lane, w = C.wave, r = lane & 31, hh = lane >> 5;
    const float c1 = 0.125f * LOG2E;
    for (int ug = C.bid; ug < BATCH * 8; ug += C.G) {
        const int b = ug >> 3;
        __syncthreads();
        for (int idx = tid; idx < 128 * 8 * 2; idx += 512) { const int kvs = idx >> 10, rem = idx & 1023, c = rem >> 3, ch = rem & 7;
            const u32x4 v = *(const u32x4*)((const bf16_t*)(C.ws + (kvs ? WS_VC : WS_KC)) + (size_t)(b * 128 + c) * 64 + ch * 8);
            *(LAS u32x4*)((kvs ? Vs : Ks) + c * KP + ch * 8) = v; }
        __syncthreads();
        for (int uu = 0; uu < 4; ++uu) {
            const int t0 = ((ug & 7) * 4 + uu) * 64; const int tok = t0 + 8 * w + (r >> 2), g = r & 3; const size_t m = (size_t)b * SEQ + tok;
            bf16x8 qf[4];
#pragma unroll
            for (int s = 0; s < 4; ++s) qf[s] = *(const bf16x8*)(proj + m * NPROJ + C_NQ + g * 64 + 16 * s + 8 * hh);
            f32x16 p[4];
#pragma unroll
            for (int kt = 0; kt < 4; ++kt) { f32x16 acc;
#pragma unroll
                for (int i = 0; i < 16; ++i) acc[i] = 0.f;
#pragma unroll
                for (int s = 0; s < 4; ++s) { const bf16x8 kf = *(const LAS bf16x8*)(Ks + (32 * kt + r) * KP + 16 * s + 8 * hh); acc = MFMA32(kf, qf[s], acc); }
                p[kt] = acc; }
            float mx = -1e30f; const int climh = ((tok - 31) >> 4) - 4 * hh;
#pragma unroll
            for (int kt = 0; kt < 4; ++kt)
#pragma unroll
                for (int i = 0; i < 16; ++i) { const bool ok = (32 * kt + (i & 3) + 8 * (i >> 2)) <= climh; p[kt][i] = ok ? p[kt][i] : -INFINITY; mx = fmaxf(mx, p[kt][i]); }
            mx = fmaxf(mx, shx<32>(mx));
            float sum = 0.f; const float off = mx * c1;
#pragma unroll
            for (int kt = 0; kt < 4; ++kt)
#pragma unroll
                for (int i = 0; i < 16; ++i) { const float e = __builtin_amdgcn_exp2f(p[kt][i] * c1 - off); p[kt][i] = e; sum += e; }
            sum += shx<32>(sum);
            const float inv = (tok >= 31) ? 1.0f / sum : 0.f;
#pragma unroll
            for (int kt = 0; kt < 4; ++kt)
#pragma unroll
                for (int i = 0; i < 16; ++i) p[kt][i] *= inv;
            __builtin_amdgcn_sched_barrier(0);
            f32x16 o[2];
#pragma unroll
            for (int dt = 0; dt < 2; ++dt)
#pragma unroll
                for (int i = 0; i < 16; ++i) o[dt][i] = 0.f;
            const int i16 = lane & 15, q4 = i16 >> 2, pp = i16 & 3, blk = (lane >> 4) & 1;
            const LAS bf16_t* vb = Vs + (4 * hh + q4) * KP + 16 * blk + 4 * pp;
#pragma unroll
            for (int kt = 0; kt < 4; ++kt)
#pragma unroll
                for (int s = 0; s < 2; ++s) { u32x4 pw; pw.x = pk2(p[kt][8 * s], p[kt][8 * s + 1]); pw.y = pk2(p[kt][8 * s + 2], p[kt][8 * s + 3]); pw.z = pk2(p[kt][8 * s + 4], p[kt][8 * s + 5]); pw.w = pk2(p[kt][8 * s + 6], p[kt][8 * s + 7]);
                    const bf16x8 pf = __builtin_bit_cast(bf16x8, pw);
#pragma unroll
                    for (int dt = 0; dt < 2; ++dt) { const s16x4 lo = __builtin_amdgcn_ds_read_tr16_b64_v4i16((LAS s16x4*)(vb + (32 * kt + 16 * s) * KP + 32 * dt));
                        const s16x4 hi = __builtin_amdgcn_ds_read_tr16_b64_v4i16((LAS s16x4*)(vb + (32 * kt + 16 * s + 8) * KP + 32 * dt));
                        const bf16x8 vf = __builtin_shufflevector(lo, hi, 0, 1, 2, 3, 4, 5, 6, 7); o[dt] = MFMA32(vf, pf, o[dt]); } __builtin_amdgcn_sched_barrier(0); }
            __builtin_amdgcn_sched_barrier(0);
            { const float gl = bf2f(proj[m * NPROJ + C_NG + g * 3 + 0]); const float gate = 1.0f / (1.0f + __expf(-gl));
              float* op = (float*)(C.ws + WS_OCMP) + m * 256 + g * 64;
#pragma unroll
              for (int dt = 0; dt < 2; ++dt)
#pragma unroll
                  for (int g4 = 0; g4 < 4; ++g4) { f32x4 v; v[0] = o[dt][4 * g4] * gate; v[1] = o[dt][4 * g4 + 1] * gate; v[2] = o[dt][4 * g4 + 2] * gate; v[3] = o[dt][4 * g4 + 3] * gate;
                      *(f32x4*)(op + 32 * dt + 8 * g4 + 4 * hh) = v; } }
            __builtin_amdgcn_sched_barrier(0);
#pragma unroll
            for (int kt = 0; kt < 4; ++kt)
#pragma unroll
                for (int i = 0; i < 16; ++i) { float v = p[kt][i]; v += shx<1>(v); v += shx<2>(v); p[kt][i] = v; }
            __builtin_amdgcn_sched_barrier(0);
            if (g == 0) {
#pragma unroll
                for (int kt = 0; kt < 4; ++kt)
#pragma unroll
                    for (int g4 = 0; g4 < 4; ++g4) { f32x4 v; v[0] = p[kt][4 * g4]; v[1] = p[kt][4 * g4 + 1]; v[2] = p[kt][4 * g4 + 2]; v[3] = p[kt][4 * g4 + 3];
                        *(LAS f32x4*)(Ps + (r >> 2) * 128 + 32 * kt + 8 * g4 + 4 * hh) = v; } }
            LDS_WAIT();
            { const int tk = lane >> 3, jg = lane & 7; const int t = t0 + 8 * w + tk; const int blk_t = t >> 6;
              float sc[4];
#pragma unroll
              for (int jj = 0; jj < 4; ++jj) { const int j = 4 * jg + jj; float imp = 0.f;
#pragma unroll
                  for (int cc = -1; cc < 4; ++cc) { const int c = 4 * j + cc; if (c >= 0) imp += Ps[tk * 128 + c]; }
                  const bool forced = (j == 0) || (j == blk_t) || (j == blk_t - 1); const bool valid = (j * 64) <= t;
                  sc[jj] = forced ? 1e9f : (valid ? imp : -1.0f); Sc[tk * 32 + j] = sc[jj]; }
              LDS_WAIT();
              unsigned bits = 0u;
#pragma unroll
              for (int jj = 0; jj < 4; ++jj) { const int j = 4 * jg + jj; int cnt = 0;
                  for (int j2 = 0; j2 < 32; ++j2) { const float o2 = Sc[tk * 32 + j2]; cnt += (o2 > sc[jj] || (o2 == sc[jj] && j2 < j)) ? 1 : 0; }
                  if (cnt < 16) bits |= 1u << j; }
              bits |= (unsigned)shxi<1>((int)bits); bits |= (unsigned)shxi<2>((int)bits); bits |= (unsigned)shxi<4>((int)bits);
              if (jg == 0) ((unsigned*)(C.ws + WS_SEL))[(size_t)b * SEQ + t] = bits; }
            LDS_WAIT();
        }
    }
}
constexpr int AT_KBUF = 64 * KP * 2;
constexpr int AT_K0 = 0, AT_V0 = 2 * AT_KBUF, AT_C0 = 4 * AT_KBUF, AT_MISC = AT_C0 + 2 * 256;

template <bool BIAS, bool SEL, int NS>
DI void tile_step(const LAS bf16_t* Kl, const LAS bf16_t* Vl, const LAS float* Cl, const bf16x8 (&qf)[NS], f32x16 (&o)[2], float& m, float& l,
                  const float c1, const int mmode, const int key0, const int trow, const bool kill, const int hh) {
    f32x16 p[2];
#pragma unroll
    for (int kt = 0; kt < 2; ++kt) { f32x16 acc;
#pragma unroll
        for (int i = 0; i < 16; ++i) acc[i] = 0.f;
#pragma unroll
        for (int s = 0; s < NS; ++s) { const bf16x8 kf = *(const LAS bf16x8*)(Kl + 32 * kt * KP + 16 * s); acc = MFMA32(kf, qf[s], acc); }
        p[kt] = acc; }
    if (BIAS) {
        const f32x2 c1v = {c1, c1};
#pragma unroll
        for (int kt = 0; kt < 2; ++kt)
#pragma unroll
            for (int g4 = 0; g4 < 4; ++g4) { const f32x4 cv = *(const LAS f32x4*)(Cl + 32 * kt + 8 * g4);
                f32x2 a0 = {p[kt][4 * g4], p[kt][4 * g4 + 1]}, a1 = {p[kt][4 * g4 + 2], p[kt][4 * g4 + 3]};
                a0 = a0 * c1v - (f32x2){cv[0], cv[1]}; a1 = a1 * c1v - (f32x2){cv[2], cv[3]};
                p[kt][4 * g4] = a0[0]; p[kt][4 * g4 + 1] = a0[1]; p[kt][4 * g4 + 2] = a1[0]; p[kt][4 * g4 + 3] = a1[1]; }
    }
    const int lim = trow - key0 - 4 * hh;
    if (mmode == 1) {
#pragma unroll
        for (int kt = 0; kt < 2; ++kt)
#pragma unroll
            for (int i = 0; i < 16; ++i) p[kt][i] = ((32 * kt + (i & 3) + 8 * (i >> 2)) > lim) ? -INFINITY : p[kt][i];
    } else if (mmode == 2) {
#pragma unroll
        for (int kt = 0; kt < 2; ++kt)
#pragma unroll
            for (int i = 0; i < 16; ++i) p[kt][i] = ((32 * kt + (i & 3) + 8 * (i >> 2)) <= lim - 512) ? -INFINITY : p[kt][i];
    }
    if (SEL) { if (kill) {
#pragma unroll
        for (int kt = 0; kt < 2; ++kt)
#pragma unroll
            for (int i = 0; i < 16; ++i) p[kt][i] = -INFINITY; } }
    float mx = p[0][0];
#pragma unroll
    for (int kt = 0; kt < 2; ++kt)
#pragma unroll
        for (int i = 0; i < 16; ++i) mx = fmaxf(mx, p[kt][i]);
    mx = fmaxf(mx, shx<32>(mx));
    const float mn = fmaxf(m, mx);
    float alpha, off, sc;
    if (BIAS) { alpha = __builtin_amdgcn_exp2f(m - mn); off = mn; sc = 1.0f; } else { alpha = __builtin_amdgcn_exp2f((m - mn) * c1); off = mn * c1; sc = c1; }
    m = mn;
    f32x2 rs2 = {0.f, 0.f}; const f32x2 scv = {sc, sc}, offv = {off, off};
#pragma unroll
    for (int kt = 0; kt < 2; ++kt)
#pragma unroll
        for (int i = 0; i < 16; i += 2) { f32x2 a = {p[kt][i], p[kt][i + 1]}; a = a * scv - offv; f32x2 e; e[0] = __builtin_amdgcn_exp2f(a[0]); e[1] = __builtin_amdgcn_exp2f(a[1]);
            p[kt][i] = e[0]; p[kt][i + 1] = e[1]; rs2 += e; }
    l = l * alpha + (rs2[0] + rs2[1]);
    const f32x2 av = {alpha, alpha};
#pragma unroll
    for (int dt = 0; dt < 2; ++dt)
#pragma unroll
        for (int i = 0; i < 16; i += 2) { f32x2 a = {o[dt][i], o[dt][i + 1]}; a = a * av; o[dt][i] = a[0]; o[dt][i + 1] = a[1]; }
#pragma unroll
    for (int kt = 0; kt < 2; ++kt)
#pragma unroll
        for (int s = 0; s < 2; ++s) { u32x4 pw; pw.x = pk2(p[kt][8 * s], p[kt][8 * s + 1]); pw.y = pk2(p[kt][8 * s + 2], p[kt][8 * s + 3]); pw.z = pk2(p[kt][8 * s + 4], p[kt][8 * s + 5]); pw.w = pk2(p[kt][8 * s + 6], p[kt][8 * s + 7]);
            const bf16x8 pf = __builtin_bit_cast(bf16x8, pw);
#pragma unroll
            for (int dt = 0; dt < 2; ++dt) { const s16x4 lo = __builtin_amdgcn_ds_read_tr16_b64_v4i16((LAS s16x4*)(Vl + (32 * kt + 16 * s) * KP + 32 * dt));
                const s16x4 hi = __builtin_amdgcn_ds_read_tr16_b64_v4i16((LAS s16x4*)(Vl + (32 * kt + 16 * s + 8) * KP + 32 * dt));
                const bf16x8 vf = __builtin_shufflevector(lo, hi, 0, 1, 2, 3, 4, 5, 6, 7); o[dt] = MFMA32(vf, pf, o[dt]); } }
}

struct TileRegs { u32x4 k, v; float c; };
template <bool BIAS>
DI void tile_gload(TileRegs& R, const bf16_t* kbase, const bf16_t* vbase, const float* cbase, int key0, int tid) {
    const size_t off = (size_t)(key0 + (tid >> 3)) * NPROJ + (tid & 7) * 8;
    R.k = *(const u32x4*)(kbase + off); R.v = *(const u32x4*)(vbase + off);
    if (BIAS) { if (tid < 64) R.c = cbase[key0 + tid]; }
}
template <bool BIAS>
DI void tile_lstore(const TileRegs& R, LAS unsigned char* lds, int buf, int tid) {
    const int o = ((tid >> 3) * KP + (tid & 7) * 8) * 2;
    *(LAS u32x4*)(lds + AT_K0 + buf * AT_KBUF + o) = R.k; *(LAS u32x4*)(lds + AT_V0 + buf * AT_KBUF + o) = R.v;
    if (BIAS) { if (tid < 64) *(LAS float*)(lds + AT_C0 + buf * 256 + tid * 4) = R.c; }
}

template <bool BIAS, bool SEL, int NS, int NMAP>
DI void flash_pass(const Ctx& C, const bf16_t* kbase, const bf16_t* vbase, const float* cbase, int j0, int j1, int wave_last, int lowtile,
                   const bf16x8 (&qf)[NMAP][NS], f32x16 (&o)[NMAP][2], float (&m)[NMAP], float (&l)[NMAP], float c1, int trow, unsigned selbits, int hh) {
    const int tid = C.tid, lane = C.lane, r = lane & 31;
    const int i16 = lane & 15, q4 = i16 >> 2, pp = i16 & 3, blk = (lane >> 4) & 1;
    TileRegs R;
    tile_gload<BIAS>(R, kbase, vbase, cbase, 64 * j0, tid);
    tile_lstore<BIAS>(R, C.lds, 0, tid);
    __syncthreads();
    int cur = 0;
    for (int j = j0; j <= j1; ++j) {
        if (j < j1) tile_gload<BIAS>(R, kbase, vbase, cbase, 64 * (j + 1), tid);
        if (j <= wave_last) {
            const LAS bf16_t* Kt = (const LAS bf16_t*)(C.lds + AT_K0 + cur * AT_KBUF);
            const LAS bf16_t* Vl = (const LAS bf16_t*)(C.lds + AT_V0 + cur * AT_KBUF) + (4 * hh + q4) * KP + 16 * blk + 4 * pp;
            const LAS float* Cl = (const LAS float*)(C.lds + AT_C0 + cur * 256) + 4 * hh;
            const int mmode = (j == wave_last) ? 1 : ((j == lowtile) ? 2 : 0);
            const bool kill = SEL ? (((selbits >> j) & 1u) == 0u) : false;
#pragma unroll
            for (int mp = 0; mp < NMAP; ++mp)
                tile_step<BIAS, SEL, NS>(Kt + r * KP + 8 * hh + mp * 32, Vl, Cl, qf[mp], o[mp], m[mp], l[mp], c1, mmode, 64 * j, trow, kill, hh);
        }
        if (j < j1) tile_lstore<BIAS>(R, C.lds, cur ^ 1, tid);
        __syncthreads();
        cur ^= 1;
    }
}

DI void store_row64(bf16_t* dst, const f32x16 (&v)[2], int hh) {
#pragma unroll
    for (int dt = 0; dt < 2; ++dt)
#pragma unroll
        for (int g4 = 0; g4 < 4; ++g4) { u32x2 w; w.x = pk2(v[dt][4 * g4], v[dt][4 * g4 + 1]); w.y = pk2(v[dt][4 * g4 + 2], v[dt][4 * g4 + 3]); *(u32x2*)(dst + 32 * dt + 8 * g4 + 4 * hh) = w; }
}

DI void attn_phase(const Ctx& C, ARGP a, int L) {
    const bf16_t* proj = (const bf16_t*)(C.ws + WS_BIG);
    bf16_t* mix = (bf16_t*)(C.ws + WS_MIX);
    unsigned* qctr = (unsigned*)(C.ws + WS_CTL) + CW_QUEUE + 64 * L;
    volatile LAS int* slot = (volatile LAS int*)(C.lds + AT_MISC);
    const int tid = C.tid, lane = C.lane, w = C.wave, r = lane & 31, hh = lane >> 5;
    for (;;) {
        __syncthreads();
        if (tid == 0) slot[0] = (int)atomicAdd(qctr, 1u);
        __syncthreads();
        const int idx = slot[0];
        if (idx >= 4096) break;
        const int qb8 = 7 - (idx >> 9), rem = idx & 511;
        if (rem >= 256) {
            const int r3 = rem - 256, b = r3 >> 3, h = r3 & 7; const int tok = 256 * qb8 + 32 * w + r; const size_t mrow = (size_t)b * SEQ + tok;
            bf16x8 qf[1][4];
#pragma unroll
            for (int s = 0; s < 4; ++s) qf[0][s] = *(const bf16x8*)(proj + mrow * NPROJ + C_FQ + h * 64 + 16 * s + 8 * hh);
            f32x16 o[1][2]; float m[1] = {-1e30f}, l[1] = {0.f};
#pragma unroll
            for (int dt = 0; dt < 2; ++dt)
#pragma unroll
                for (int i = 0; i < 16; ++i) o[0][dt][i] = 0.f;
            const bf16_t* kb = proj + (size_t)b * SEQ * NPROJ + C_FK + h * 64; const bf16_t* vb = proj + (size_t)b * SEQ * NPROJ + C_FV + h * 64;
            const float* cb = (const float*)(C.ws + WS_CKL) + (size_t)(b * 8 + h) * SEQ;
            flash_pass<true, false, 4, 1>(C, kb, vb, cb, 0, 4 * qb8 + 3, 4 * qb8 + (w >> 1), -1, qf, o, m, l, 0.125f * LOG2E, tok, 0xffffffffu, hh);
            const float lt = l[0] + shx<32>(l[0]); const float inv = 1.0f / lt;
#pragma unroll
            for (int dt = 0; dt < 2; ++dt)
#pragma unroll
                for (int i = 0; i < 16; ++i) o[0][dt][i] *= inv;
            store_row64(mix + mrow * DM + 512 + h * 64, o[0], hh);
        } else if (rem < 128) {
            const int b = rem >> 2, h = rem & 3; const int tok = 256 * qb8 + 32 * w + r; const size_t mrow = (size_t)b * SEQ + tok;
            bf16x8 qf[2][2];
#pragma unroll
            for (int mp = 0; mp < 2; ++mp)
#pragma unroll
                for (int s = 0; s < 2; ++s) qf[mp][s] = *(const bf16x8*)(proj + mrow * NPROJ + C_DQ + h * 64 + mp * 32 + 16 * s + 8 * hh);
            f32x16 o[2][2]; float m[2] = {-1e30f, -1e30f}, l[2] = {0.f, 0.f};
#pragma unroll
            for (int mp = 0; mp < 2; ++mp)
#pragma unroll
                for (int dt = 0; dt < 2; ++dt)
#pragma unroll
                    for (int i = 0; i < 16; ++i) o[mp][dt][i] = 0.f;
            const bf16_t* kb = proj + (size_t)b * SEQ * NPROJ + C_DK + h * 64; const bf16_t* vb = proj + (size_t)b * SEQ * NPROJ + C_DV + h * 64;
            flash_pass<false, false, 2, 2>(C, kb, vb, nullptr, 0, 4 * qb8 + 3, 4 * qb8 + (w >> 1), -1, qf, o, m, l, 0.17677669529f * LOG2E, tok, 0xffffffffu, hh);
            const float lam = ((const float*)(C.ws + WS_TBL + TB_LAM))[L]; const float li = 0.8f - 0.6f * expf(-0.3f * (float)L);
            const float i0 = 1.0f / (l[0] + shx<32>(l[0])), i1 = lam / (l[1] + shx<32>(l[1]));
            float ss = 0.f;
#pragma unroll
            for (int dt = 0; dt < 2; ++dt)
#pragma unroll
                for (int i = 0; i < 16; ++i) { const float v = o[0][dt][i] * i0 - o[1][dt][i] * i1; o[0][dt][i] = v; ss += v * v; }
            ss += shx<32>(ss);
            const float rms = (1.0f / sqrtf(ss * (1.0f / 64.0f) + LN_EPS)) * (1.0f - li);
            const float* sg = a->in[19] + L * 64;
#pragma unroll
            for (int dt = 0; dt < 2; ++dt)
#pragma unroll
                for (int g4 = 0; g4 < 4; ++g4) { const f32x4 gv = *(const f32x4*)(sg + 32 * dt + 8 * g4 + 4 * hh);
#pragma unroll
                    for (int e = 0; e < 4; ++e) o[0][dt][4 * g4 + e] *= rms * gv[e]; }
            store_row64(mix + mrow * DM + 256 + h * 64, o[0], hh);
        } else {
            const int r2 = rem - 128, b = r2 & 31, qb = 4 * qb8 + 3 - (r2 >> 5); const int tok = 64 * qb + 8 * w + (r >> 2), g = r & 3; const size_t mrow = (size_t)b * SEQ + tok;
            bf16x8 qf[1][4];
#pragma unroll
            for (int s = 0; s < 4; ++s) qf[0][s] = *(const bf16x8*)(proj + mrow * NPROJ + C_NQ + g * 64 + 16 * s + 8 * hh);
            const unsigned sel = ((const unsigned*)(C.ws + WS_SEL))[mrow];
            const bf16_t* pb = proj + (size_t)b * SEQ * NPROJ + C_NKV;
            f32x16 o[1][2], keep[2]; float m[1] = {-1e30f}, l[1] = {0.f};
#pragma unroll
            for (int dt = 0; dt < 2; ++dt)
#pragma unroll
                for (int i = 0; i < 16; ++i) o[0][dt][i] = 0.f;
            flash_pass<false, true, 4, 1>(C, pb + 128, pb + 192, nullptr, 0, qb, qb, -1, qf, o, m, l, 0.125f * LOG2E, tok, sel, hh);
            { const float g1 = 1.0f / (1.0f + __expf(-bf2f(proj[mrow * NPROJ + C_NG + g * 3 + 1]))); const float inv = g1 / (l[0] + shx<32>(l[0]));
              const float* oc = (const float*)(C.ws + WS_OCMP) + mrow * 256 + g * 64;
#pragma unroll
              for (int dt = 0; dt < 2; ++dt)
#pragma unroll
                  for (int g4 = 0; g4 < 4; ++g4) { const f32x4 cv = *(const f32x4*)(oc + 32 * dt + 8 * g4 + 4 * hh);
#pragma unroll
                      for (int e = 0; e < 4; ++e) { keep[dt][4 * g4 + e] = o[0][dt][4 * g4 + e] * inv + cv[e]; o[0][dt][4 * g4 + e] = 0.f; } } }
            m[0] = -1e30f; l[0] = 0.f;
            const int jlo = qb >= 8 ? qb - 8 : 0;
            flash_pass<false, false, 4, 1>(C, pb + 256, pb + 320, nullptr, jlo, qb, qb, qb >= 8 ? qb - 8 : -1, qf, o, m, l, 0.125f * LOG2E, tok, 0xffffffffu, hh);
            { const float g2 = 1.0f / (1.0f + __expf(-bf2f(proj[mrow * NPROJ + C_NG + g * 3 + 2]))); const float inv = g2 / (l[0] + shx<32>(l[0]));
#pragma unroll
              for (int dt = 0; dt < 2; ++dt)
#pragma unroll
                  for (int i = 0; i < 16; ++i) keep[dt][i] += o[0][dt][i] * inv; }
            store_row64(mix + mrow * DM + g * 64, keep, hh);
        }
    }
}
constexpr int LDS_BYTES = 147456;
constexpr int N_PHASES = 1 + 13 * DEPTH;

template <class Epi>
DI void run_gemm(const Ctx& C, const bf16_t* A, const bf16_t* Bt, int N, int K, const Epi& E, const bool opaque = false) {
    if (opaque) asm volatile("" : "+s"(K), "+s"(N));
    pg8::Gemm g{A, Bt, MTOK, N, K}; pg8::StaticOrder S; S.init(MTOK, N, C.G, C.bid);
    pg8::gemm_phase<Epi, pg8::StaticOrder, true, true>((LAS unsigned char*)C.lds, g, S, E, C.tid);
}

__global__ void __launch_bounds__(512, 2) mega_fwd(Args args_k) {
    const ARGP ap0 = (ARGP)__builtin_amdgcn_kernarg_segment_ptr();
    extern __shared__ __attribute__((aligned(16))) unsigned char lds_raw[];
    Ctx C0; Ctx& C = C0; const int wave_s = __builtin_amdgcn_readfirstlane((int)threadIdx.x >> 6); C.wave = wave_s; C.lane = 0; C.tid = 0; C.bid = blockIdx.x; C.G = gridDim.x;
    C.ws = args_k.ws; C.lds = (LAS unsigned char*)lds_raw;
    cg::grid_group grid = cg::this_grid();
#define BST ((volatile LAS unsigned*)(C.lds + 131072 + 256))
    if (threadIdx.x < 2) BST[threadIdx.x] = 0u;
    __syncthreads();
    (void)xcd_barrier_post((unsigned*)(C.ws + WS_CTL) + 4096, BST);
    const int lo = args_k.ph_lo, hi = args_k.ph_hi;
    float* X = args_k.out;
    bf16_t* XB = (bf16_t*)(C.ws + WS_XB); bf16_t* BIG = (bf16_t*)(C.ws + WS_BIG); bf16_t* MIX = (bf16_t*)(C.ws + WS_MIX);
#define PH_BEGIN(k) if (lo <= (k) && (k) < hi) { ARGP args = ap0; asm volatile("" : "+s"(args)); Ctx C = C0; { int l_ = (int)__builtin_amdgcn_mbcnt_hi(~0u, __builtin_amdgcn_mbcnt_lo(~0u, 0u)); asm volatile("" : "+v"(l_)); C.lane = l_; C.tid = wave_s * 64 + l_; int b_ = blockIdx.x, g_ = gridDim.x; asm volatile("" : "+s"(b_), "+s"(g_)); C.bid = b_; C.G = g_; }
#define PH_END(k) asm volatile("s_waitcnt vmcnt(0)" ::: "memory"); if ((k) + 1 < hi) { if ((k) == 0) grid.sync(); else { XcdBarrier xb_; xb_.bar = (unsigned*)(C.ws + WS_CTL) + 4096; xb_.x = xb_xcc_id(); xb_.st = BST; xcd_barrier(xb_); } } }
    PH_BEGIN(0) prep_phase(C, args); PH_END(0)
    for (int L = 0; L < DEPTH; ++L) {
        const int pb = 1 + 13 * L;
        unsigned char* wb = C.ws + WS_W + (size_t)L * W_LAYER;
        PH_BEGIN(pb + 0) { pg8::EpiSwiGLU E{BIG, DFFP}; run_gemm(C, L == 0 ? XB : MIX, (const bf16_t*)(wb + W_UP1), NUP, DM, E); } PH_END(pb + 0)
        PH_BEGIN(pb + 1) { pg8::EpiResid<false> E{L == 0 ? args->in[0] : X, XB, DN_ALPHA, 0.5f, nullptr}; run_gemm(C, BIG, (const bf16_t*)(wb + W_DN1), DM, DFFP, E); } PH_END(pb + 1)
        PH_BEGIN(pb + 2) ln_phase(C, XB, args->in[2] + (size_t)(L * 3 + 0) * DM, args->in[3] + (size_t)(L * 3 + 0) * DM); PH_END(pb + 2)
        PH_BEGIN(pb + 3) { pg8::EpiProjRope E{C.ws, NPROJ}; run_gemm(C, XB, (const bf16_t*)(wb + W_IN), NPROJ, DM, E); } PH_END(pb + 3)
        PH_BEGIN(pb + 4) attn_prep_phase(C, args, L); PH_END(pb + 4)
        PH_BEGIN(pb + 5) cmp_attn_phase(C, L); PH_END(pb + 5)
        PH_BEGIN(pb + 6) attn_phase(C, args, L); PH_END(pb + 6)
        PH_BEGIN(pb + 7) { pg8::EpiResid<true> E{nullptr, XB, DN_ALPHA, 1.0f, XB}; run_gemm(C, MIX, (const bf16_t*)(wb + W_OUT), DM, DM, E); } PH_END(pb + 7)
        PH_BEGIN(pb + 8) ln_phase(C, XB, args->in[2] + (size_t)(L * 3 + 1) * DM, args->in[3] + (size_t)(L * 3 + 1) * DM); PH_END(pb + 8)
        PH_BEGIN(pb + 9) { pg8::EpiSwiGLU E{BIG, DFFP}; run_gemm(C, XB, (const bf16_t*)(wb + W_UP2), NUP, DM, E); } PH_END(pb + 9)
        PH_BEGIN(pb + 10) { pg8::EpiResid<true> E{nullptr, XB, DN_ALPHA, 0.5f, XB}; run_gemm(C, BIG, (const bf16_t*)(wb + W_DN2), DM, DFFP, E); } PH_END(pb + 10)
        PH_BEGIN(pb + 11) { ln_phase(C, XB, args->in[2] + (size_t)(L * 3 + 2) * DM, args->in[3] + (size_t)(L * 3 + 2) * DM); __syncthreads();
            pg8::EpiBf16 E{BIG, DM}; run_gemm(C, (const bf16_t*)(C.ws + WS_PB) + (size_t)L * MTOK * PLED, (const bf16_t*)(wb + W_PLEP), DM, PLED, E, true); } PH_END(pb + 11)
        PH_BEGIN(pb + 12) { pg8::EpiPle E{XB, X, L == DEPTH - 1 ? (bf16_t*)nullptr : MIX, args->in[22] + (size_t)L * DM, BIG}; run_gemm(C, XB, (const bf16_t*)(wb + W_PLEG), DM, DM, E); } PH_END(pb + 12)
    }
}

#ifndef MK_SPLIT
#define MK_SPLIT 0
#endif
extern "C" void kernel_launch(void* const* d_in, const int* in_sizes, int n_in, void* d_out, int out_size, void* d_ws, size_t ws_size, hipStream_t stream) {
    static int grid = 0;
    if (grid == 0) {
        if (n_in != 24 || out_size != MTOK * DM || ws_size < WS_END) { fprintf(stderr, "kernel_launch: unexpected shapes (n_in %d out %d ws %zu)\n", n_in, out_size, ws_size); grid = -1; return; }
        if (hipFuncSetAttribute((const void*)mega_fwd, hipFuncAttributeMaxDynamicSharedMemorySize, LDS_BYTES) != hipSuccess) { fprintf(stderr, "kernel_launch: hipFuncSetAttribute failed\n"); grid = -1; return; }
        int dev = 0, cus = 0, per_cu = 0; hipGetDevice(&dev); hipDeviceGetAttribute(&cus, hipDeviceAttributeMultiprocessorCount, dev);
        hipOccupancyMaxActiveBlocksPerMultiprocessor(&per_cu, (const void*)mega_fwd, 512, LDS_BYTES);
        if (per_cu < 1) { fprintf(stderr, "kernel_launch: occupancy query says %d blocks/CU\n", per_cu); per_cu = 1; }
        (void)hipGetLastError();
        grid = cus;
    }
    if (grid < 0) return;
    hipMemsetAsync((char*)d_ws + WS_CTL, 0, 1 * MiB, stream);
    Args a{};
    for (int i = 0; i < 24; ++i) a.in[i] = (const float*)d_in[i];
    a.out = (float*)d_out; a.ws = (unsigned char*)d_ws;
#if MK_SPLIT
    for (int p = 0; p < N_PHASES; ++p) { a.ph_lo = p; a.ph_hi = p + 1; hipLaunchKernelGGL(mega_fwd, dim3(grid), dim3(512), LDS_BYTES, stream, a); }
#else
    a.ph_lo = 0; a.ph_hi = N_PHASES;
    void* kargs[] = {&a};
    hipError_t e = hipLaunchCooperativeKernel((const void*)mega_fwd, dim3(grid), dim3(512), kargs, LDS_BYTES, stream);
    if (e != hipSuccess) fprintf(stderr, "cooperative launch failed: %s (grid %d)\n", hipGetErrorString(e), grid);
#endif
}
```

```cpp
#include <hip/hip_runtime.h>
#include <hip/hip_cooperative_groups.h>
#include <cstdio>
#include <cstdint>
#include <cmath>
namespace cg = cooperative_groups;

__device__ __forceinline__ int lane_here() { int l; asm volatile("v_mbcnt_lo_u32_b32 %0, -1, 0\n\tv_mbcnt_hi_u32_b32 %0, -1, %0" : "=&v"(l)); return l; }
template <int O> __device__ __forceinline__ int shxi(int v) {
    if constexpr (O < 32) return __builtin_amdgcn_ds_swizzle(v, (O << 10) | 0x1f);
    else return __builtin_amdgcn_ds_bpermute((lane_here() ^ O) << 2, v);
}
template <int O> __device__ __forceinline__ float shx(float v) { return __builtin_bit_cast(float, shxi<O>(__builtin_bit_cast(int, v))); }

constexpr size_t K_WS_BIG = (size_t)484 << 20, K_WS_TBL = (size_t)1 << 20, K_TB_COS64 = 0, K_TB_SIN64 = 256 * 1024, K_TB_COS32 = 512 * 1024, K_TB_SIN32 = 640 * 1024;

namespace pg8 {
#define PG8_LAS __attribute__((address_space(3)))
typedef unsigned short bf16_t;
typedef short bf16x8 __attribute__((ext_vector_type(8)));
typedef float f32x4 __attribute__((ext_vector_type(4)));
typedef unsigned u32x4 __attribute__((ext_vector_type(4)));
constexpr int BM = 256, BK = 64, HALF = 128, HTB = HALF * BK * 2  , STAGE_BYTES = 8 * HTB, NXCD = 8, WGM = 8;

__host__ __device__ __forceinline__ int lds_byte(int r, int c) { const int st = (r >> 4) * 2 + (c >> 5), rr = r & 15, cc = c & 31, ob = rr * 64 + cc * 2; return st * 1024 + (ob ^ (((ob >> 9) & 1) << 5)); }
__host__ __device__ __forceinline__ void stage_rc(int b, int& R, int& C) { const int st = b / 1024, sb = b % 1024, swz = sb ^ (((sb >> 9) & 1) << 5); R = (st >> 1) * 16 + swz / 64; C = (st & 1) * 32 + (swz % 64) / 2; }
__host__ __device__ __forceinline__ int perm32(int rho) { const int n = rho >> 4, i = rho & 15; return 8 * (i >> 2) + 4 * n + (i & 3); }

struct Unit { int pm, pn; };
struct Gemm { const bf16_t* A; const bf16_t* Bt; int M, N, K; };

struct StaticOrder {
    int nM, nN, nwg, G, c;
    __host__ __device__ void init(int M, int N, int G_, int c_) { nM = M / BM; nN = N / BM; nwg = nM * nN; G = G_; c = c_; }
    __host__ __device__ bool next(int i, Unit& u) const {
        const long L = (long)i * G + c; if (L >= nwg) return false;
        int wgid = (int)L; { const int q = nwg / NXCD, r = nwg % NXCD, xcd = wgid % NXCD, off = wgid / NXCD; wgid = (xcd < r ? xcd * (q + 1) : r * (q + 1) + (xcd - r) * q) + off; }
        const int nig = WGM * nN, gid = wgid / nig, fm = gid * WGM, gsz = (nM - fm) < WGM ? (nM - fm) : WGM;
        u.pm = fm + ((wgid % nig) % gsz); u.pn = (wgid % nig) / gsz; return true;
    }
    __device__ __forceinline__ void a_ready(const Unit&) const {}
    __device__ __forceinline__ void done(const Unit&) const {}
};

__device__ __forceinline__ unsigned cvt_pk_bf16(float lo, float hi) { unsigned r; asm volatile("v_cvt_pk_bf16_f32 %0, %1, %2" : "=v"(r) : "v"(lo), "v"(hi)); return r; }
typedef unsigned u32x2 __attribute__((ext_vector_type(2)));
typedef float f32x2 __attribute__((ext_vector_type(2)));
struct EpiBf16 {
    static constexpr bool PERM = true, AFTER_DRAIN = false;
    bf16_t* O; int ldc;
    __device__ __forceinline__ void operator()(const f32x4 (&acc)[2][2][4][2], const Unit& u, int wr, int wc, int fr, int fq) const {
        const int row0 = u.pm * BM + wr * 64 + fr; const int col0 = u.pn * BM + wc * 32 + 8 * fq;
#pragma unroll
        for (int ai = 0; ai < 2; ++ai)
#pragma unroll
            for (int m = 0; m < 4; ++m) { bf16_t* rowp = O + (size_t)(row0 + ai * HALF + m * 16) * ldc + col0;
#pragma unroll
                for (int bj = 0; bj < 2; ++bj) { const f32x4 v0 = acc[ai][bj][m][0], v1 = acc[ai][bj][m][1];
                    u32x4 w; w.x = cvt_pk_bf16(v0[0], v0[1]); w.y = cvt_pk_bf16(v0[2], v0[3]); w.z = cvt_pk_bf16(v1[0], v1[1]); w.w = cvt_pk_bf16(v1[2], v1[3]);
                    *(u32x4*)(rowp + bj * HALF) = w; } __builtin_amdgcn_sched_barrier(0); }
    }
};
__device__ __forceinline__ int proj_seg_type(int s) { return (s < 4 || s == 6 || s == 8) ? 1 : ((s >= 10 && s < 18) ? 2 : 0); }
struct EpiProjRope {
    static constexpr bool PERM = true, AFTER_DRAIN = false;
    unsigned char* ws; int ldc;
    __device__ __forceinline__ void operator()(const f32x4 (&acc)[2][2][4][2], const Unit& u, int wr, int wc, int fr, int fq) const {
        asm volatile("" : "+v"(fr), "+v"(fq));
        unsigned char* w_ = ws; asm volatile("" : "+s"(w_));
        bf16_t* O = (bf16_t*)(w_ + ::K_WS_BIG); const float* cos64 = (const float*)(w_ + ::K_WS_TBL + ::K_TB_COS64); const float* sin64 = (const float*)(w_ + ::K_WS_TBL + ::K_TB_SIN64);
        const float* cos32 = (const float*)(w_ + ::K_WS_TBL + ::K_TB_COS32); const float* sin32 = (const float*)(w_ + ::K_WS_TBL + ::K_TB_SIN32);
        const int s = u.pn * 4 + wc, ty = proj_seg_type(s);
        const int row0 = u.pm * BM + wr * 64 + fr;
        const int d0 = (ty == 2) ? 64 * s + 32 * (fq >> 1) + 8 * (fq & 1) : 64 * s + 8 * fq;
        const int dstep = (ty == 2) ? 16 : 32;
        const float* ct = (ty == 2) ? cos32 : cos64; const float* st = (ty == 2) ? sin32 : sin64;
        const int tw = (ty == 2) ? 16 : 32, i0 = (ty == 2) ? 8 * (fq & 1) : 8 * fq;
#pragma unroll
        for (int ai = 0; ai < 2; ++ai)
#pragma unroll
            for (int m = 0; m < 4; ++m) { const int row = row0 + ai * HALF + m * 16; bf16_t* rowp = O + (size_t)row * ldc + d0; const int pos = row & 2047;
#pragma unroll
                for (int n = 0; n < 2; ++n) { f32x4 x1 = acc[ai][0][m][n], x2 = acc[ai][1][m][n];
                    if (ty != 0) { const f32x4 cv = *(const f32x4*)(ct + pos * tw + i0 + 4 * n), sv = *(const f32x4*)(st + pos * tw + i0 + 4 * n);
                        const f32x4 y1 = x1 * cv - x2 * sv, y2 = x2 * cv + x1 * sv; x1 = y1; x2 = y2; }
                    u32x2 w; w.x = cvt_pk_bf16(x1[0], x1[1]); w.y = cvt_pk_bf16(x1[2], x1[3]); *(u32x2*)(rowp + 4 * n) = w;
                    w.x = cvt_pk_bf16(x2[0], x2[1]); w.y = cvt_pk_bf16(x2[2], x2[3]); *(u32x2*)(rowp + dstep + 4 * n) = w;
                    __builtin_amdgcn_sched_barrier(0); } }
    }
};
__device__ __forceinline__ float silu_mul(float g, float uu) { return g * uu * __builtin_amdgcn_rcpf(1.0f + __builtin_amdgcn_exp2f(-1.44269504f * g)); }
struct EpiSwiGLU {
    static constexpr bool PERM = true, AFTER_DRAIN = false;
    bf16_t* H; int ldh;
    __device__ __forceinline__ void operator()(const f32x4 (&acc)[2][2][4][2], const Unit& u, int wr, int wc, int fr, int fq) const {
        const int row0 = u.pm * BM + wr * 64 + fr; const int col0 = u.pn * HALF + wc * 32 + 8 * fq;
#pragma unroll
        for (int ai = 0; ai < 2; ++ai)
#pragma unroll
            for (int m = 0; m < 4; ++m) { bf16_t* rowp = H + (size_t)(row0 + ai * HALF + m * 16) * ldh + col0;
                const f32x4 g0 = acc[ai][0][m][0], g1 = acc[ai][0][m][1], u0 = acc[ai][1][m][0], u1 = acc[ai][1][m][1];
                u32x4 w; w.x = cvt_pk_bf16(silu_mul(g0[0], u0[0]), silu_mul(g0[1], u0[1])); w.y = cvt_pk_bf16(silu_mul(g0[2], u0[2]), silu_mul(g0[3], u0[3]));
                w.z = cvt_pk_bf16(silu_mul(g1[0], u1[0]), silu_mul(g1[1], u1[1])); w.w = cvt_pk_bf16(silu_mul(g1[2], u1[2]), silu_mul(g1[3], u1[3]));
                *(u32x4*)rowp = w; __builtin_amdgcn_sched_barrier(0); }
    }
};
template <bool FROMBF16> struct EpiResid {
    static constexpr bool PERM = false, AFTER_DRAIN = false;
    const float* X; bf16_t* YB; float alpha, s; const bf16_t* XBs;
    __device__ __forceinline__ void operator()(const f32x4 (&acc)[2][2][4][2], const Unit& u, int wr, int wc, int fr, int fq) const {
        asm volatile("" : "+v"(fr), "+v"(fq));
        float a_ = alpha, s_ = s; asm volatile("" : "+v"(a_), "+v"(s_));
        const int col0 = u.pn * BM + wc * 32 + 4 * fq;
#pragma unroll
        for (int ai = 0; ai < 2; ++ai)
#pragma unroll
            for (int m = 0; m < 4; ++m) { const int row = u.pm * BM + ai * HALF + wr * 64 + m * 16 + fr; const size_t off = (size_t)row * 1024 + col0;
#pragma unroll
                for (int bj = 0; bj < 2; ++bj)
#pragma unroll
                    for (int n = 0; n < 2; ++n) { f32x4 xv;
                        if (FROMBF16) { const u32x2 pw = *(const u32x2*)(XBs + off + bj * HALF + n * 16); xv[0] = __uint_as_float(pw.x << 16); xv[1] = __uint_as_float(pw.x & 0xffff0000u); xv[2] = __uint_as_float(pw.y << 16); xv[3] = __uint_as_float(pw.y & 0xffff0000u); }
                        else xv = *(const f32x4*)(X + off + bj * HALF + n * 16);
                        const f32x4 yv = xv * a_ + acc[ai][bj][m][n] * s_;
                        u32x2 w; w.x = cvt_pk_bf16(yv[0], yv[1]); w.y = cvt_pk_bf16(yv[2], yv[3]); *(u32x2*)(YB + off + bj * HALF + n * 16) = w; } }
    }
};
struct EpiPle {
    static constexpr bool PERM = false, AFTER_DRAIN = false;
    const bf16_t* XBs; float* OUT; bf16_t* XB; const float* bias; const bf16_t* PP;
    __device__ __forceinline__ void operator()(const f32x4 (&acc)[2][2][4][2], const Unit& u, int wr, int wc, int fr, int fq) const {
        const int col0 = u.pn * BM + wc * 32 + 4 * fq;
#pragma unroll
        for (int ai = 0; ai < 2; ++ai)
#pragma unroll
            for (int m = 0; m < 4; ++m) { const int row = u.pm * BM + ai * HALF + wr * 64 + m * 16 + fr; const size_t off = (size_t)row * 1024 + col0;
#pragma unroll
                for (int bj = 0; bj < 2; ++bj)
#pragma unroll
                    for (int n = 0; n < 2; ++n) { const int co = bj * HALF + n * 16;
                        f32x4 xv; { const u32x2 xw = *(const u32x2*)(XBs + off + co); xv[0] = __uint_as_float(xw.x << 16); xv[1] = __uint_as_float(xw.x & 0xffff0000u); xv[2] = __uint_as_float(xw.y << 16); xv[3] = __uint_as_float(xw.y & 0xffff0000u); }
                        const f32x4 bv = *(const f32x4*)(bias + col0 + co);
                        const u32x2 pw = *(const u32x2*)(PP + off + co);
                        f32x4 pv; pv[0] = __uint_as_float(pw.x << 16); pv[1] = __uint_as_float(pw.x & 0xffff0000u); pv[2] = __uint_as_float(pw.y << 16); pv[3] = __uint_as_float(pw.y & 0xffff0000u);
                        f32x4 o;
#pragma unroll
                        for (int e = 0; e < 4; ++e) { const float z = acc[ai][bj][m][n][e] + bv[e]; const float sg = __builtin_amdgcn_rcpf(1.0f + __builtin_amdgcn_exp2f(-1.44269504f * z)); o[e] = xv[e] + sg * pv[e]; }
                        if (OUT) *(f32x4*)(OUT + off + co) = o;
                        if (XB) { u32x2 w; w.x = cvt_pk_bf16(o[0], o[1]); w.y = cvt_pk_bf16(o[2], o[3]); *(u32x2*)(XB + off + co) = w; } } }
    }
};
template <class Epi, class Sched, bool ALIGN_EPI = false, bool SP2 = false>
__device__ __forceinline__ void gemm_phase(PG8_LAS unsigned char* lds, const Gemm g, const Sched& S, const Epi& E, const int tid_in) {
    int tid_ = tid_in; asm volatile("" : "+v"(tid_));
    const int tid = tid_, wid = __builtin_amdgcn_readfirstlane(tid >> 6), lane = tid & 63, wr = wid >> 2, wc = wid & 3, fr = lane & 15, fq = lane >> 4;
    const int K = g.K, nt = K / BK;
    unsigned voffA[2], voffB[2];
#pragma unroll
    for (int i = 0; i < 2; ++i) { int R, C; stage_rc(tid * 16 + i * 8192, R, C); const int Rb = Epi::PERM ? ((R & ~31) + perm32(R & 31)) : R;
        voffA[i] = (unsigned)(R * K + C) * 2u; voffB[i] = (unsigned)(Rb * K + C) * 2u; }
    const size_t kstep = (size_t)(BK * 2);
    const size_t hstep = (size_t)HALF * K * 2;
    const size_t tstep = 2 * hstep;
    const unsigned ldsw = (unsigned)wid * 1024u;
    const int aoff = lds_byte(wr * 64 + fr, fq * 8), boff = lds_byte(wc * 32 + fr, fq * 8);
#define PG8_SA(b, h) (((b) * 2 + (h)) * HTB)
#define PG8_SB(b, h) ((4 + (b) * 2 + (h)) * HTB)
#define PG8_STAGE(bufoff, gbase, voff) do { _Pragma("unroll") for (int _i = 0; _i < 2; ++_i) \
        __builtin_amdgcn_global_load_lds((const unsigned*)((const char*)(gbase) + (voff)[_i]), (PG8_LAS unsigned*)(lds + (bufoff) + ldsw + _i * 8192), 16, 0, 0); } while (0)
#define PG8_LDA(dst, b, h) do { _Pragma("unroll") for (int m = 0; m < 4; ++m) _Pragma("unroll") for (int k = 0; k < 2; ++k) dst[m][k] = *(const PG8_LAS bf16x8*)(lds + PG8_SA(b, h) + aoff + m * 2048 + k * 1024); } while (0)
#define PG8_LDB(dst, b, h) do { _Pragma("unroll") for (int n = 0; n < 2; ++n) _Pragma("unroll") for (int k = 0; k < 2; ++k) dst[n][k] = *(const PG8_LAS bf16x8*)(lds + PG8_SB(b, h) + boff + n * 2048 + k * 1024); } while (0)
#define PG8_MMA(ai, bj, At, Bt) do { __builtin_amdgcn_s_setprio(1); _Pragma("unroll") for (int m = 0; m < 4; ++m) _Pragma("unroll") for (int n = 0; n < 2; ++n) _Pragma("unroll") for (int k = 0; k < 2; ++k) \
        acc[ai][bj][m][n] = __builtin_amdgcn_mfma_f32_16x16x32_bf16(Bt[n][k], At[m][k], acc[ai][bj][m][n], 0, 0, 0); __builtin_amdgcn_s_setprio(0); } while (0)
#define PG8_WAIT_V(n) asm volatile("s_waitcnt vmcnt(" #n ")" ::: "memory")
#define PG8_WAIT_L(n) asm volatile("s_waitcnt lgkmcnt(" #n ")" ::: "memory")
#define PG8_BAR __builtin_amdgcn_s_barrier()
#define PG8_SCHED __builtin_amdgcn_sched_barrier(0)
    Unit cur, nxt; int ui = 0;
    if (!S.next(0, cur)) return;
    f32x4 acc[2][2][4][2];
#pragma unroll
    for (int a = 0; a < 2; ++a)
#pragma unroll
        for (int b = 0; b < 2; ++b)
#pragma unroll
            for (int m = 0; m < 4; ++m)
#pragma unroll
                for (int n = 0; n < 2; ++n) acc[a][b][m][n] = (f32x4){0.f, 0.f, 0.f, 0.f};
    bf16x8 At[4][2], B0[2][2], B1[2][2];
    const char* cA = (const char*)g.A + (size_t)cur.pm * tstep; const char* cB = (const char*)g.Bt + (size_t)cur.pn * tstep;
    S.a_ready(cur);
    if constexpr (SP2) {
        PG8_STAGE(PG8_SB(0, 0), cB, voffB); PG8_STAGE(PG8_SB(0, 1), cB + hstep, voffB); PG8_STAGE(PG8_SA(0, 0), cA, voffA); PG8_STAGE(PG8_SA(0, 1), cA + hstep, voffA);
        if (wr == 1) PG8_BAR;
        PG8_WAIT_V(2); PG8_BAR;
        PG8_STAGE(PG8_SB(1, 0), cB + kstep, voffB); PG8_STAGE(PG8_SA(1, 0), cA + kstep, voffA); PG8_STAGE(PG8_SB(1, 1), cB + hstep + kstep, voffB);
        PG8_WAIT_V(6); PG8_BAR;
    } else {
        PG8_STAGE(PG8_SB(0, 0), cB, voffB); PG8_STAGE(PG8_SA(0, 0), cA, voffA); PG8_STAGE(PG8_SB(0, 1), cB + hstep, voffB); PG8_STAGE(PG8_SA(0, 1), cA + hstep, voffA);
        if (wr == 1) PG8_BAR;
        PG8_WAIT_V(4); PG8_BAR;
        PG8_STAGE(PG8_SB(1, 0), cB + kstep, voffB); PG8_STAGE(PG8_SA(1, 0), cA + kstep, voffA); PG8_STAGE(PG8_SB(1, 1), cB + hstep + kstep, voffB);
        PG8_WAIT_V(6); PG8_BAR;
    }
    for (;;) {
        const bool has_next = S.next(ui + 1, nxt);
        const char* nA = has_next ? (const char*)g.A + (size_t)nxt.pm * tstep : cA; const char* nB = has_next ? (const char*)g.Bt + (size_t)nxt.pn * tstep : cB;
        for (int t = 0; t < nt; t += 2) {
            const bool last = (t == nt - 2);
            const char* a1 = cA + (size_t)(t + 1) * kstep;
            const char* a2 = last ? nA : cA + (size_t)(t + 2) * kstep; const char* b2 = last ? nB : cB + (size_t)(t + 2) * kstep;
            const char* a3 = a2 + kstep; const char* b3 = b2 + kstep;
            if (last && has_next) S.a_ready(nxt);
            if constexpr (SP2) {
            PG8_LDB(B0, 0, 0); PG8_LDB(B1, 0, 1); PG8_SCHED; PG8_LDA(At, 0, 0); PG8_STAGE(PG8_SA(1, 1), a1 + hstep, voffA);
            PG8_WAIT_V(8); PG8_WAIT_L(0); PG8_BAR; PG8_MMA(0, 0, At, B0); PG8_MMA(0, 1, At, B1); PG8_BAR; PG8_SCHED;
            PG8_LDA(At, 0, 1); PG8_STAGE(PG8_SB(0, 0), b2, voffB); PG8_STAGE(PG8_SB(0, 1), b2 + hstep, voffB); PG8_STAGE(PG8_SA(0, 0), a2, voffA);
            PG8_WAIT_V(8); PG8_WAIT_L(0); PG8_BAR; PG8_MMA(1, 0, At, B0); PG8_MMA(1, 1, At, B1); PG8_BAR; PG8_SCHED;
            PG8_LDB(B0, 1, 0); PG8_LDB(B1, 1, 1); PG8_SCHED; PG8_LDA(At, 1, 0); PG8_STAGE(PG8_SA(0, 1), a2 + hstep, voffA);
            PG8_WAIT_V(8); PG8_WAIT_L(0); PG8_BAR; PG8_MMA(0, 0, At, B0); PG8_MMA(0, 1, At, B1); PG8_BAR; PG8_SCHED;
            PG8_LDA(At, 1, 1); PG8_STAGE(PG8_SB(1, 0), b3, voffB); PG8_STAGE(PG8_SB(1, 1), b3 + hstep, voffB); PG8_STAGE(PG8_SA(1, 0), a3, voffA);
            PG8_WAIT_V(8); PG8_WAIT_L(0); PG8_BAR; PG8_MMA(1, 0, At, B0); PG8_MMA(1, 1, At, B1); PG8_BAR; PG8_SCHED;
            } else {
            PG8_LDB(B0, 0, 0); PG8_SCHED; PG8_LDA(At, 0, 0); PG8_STAGE(PG8_SA(1, 1), a1 + hstep, voffA);
            PG8_WAIT_L(8); PG8_BAR; PG8_WAIT_L(0); PG8_MMA(0, 0, At, B0); PG8_BAR; PG8_SCHED;
            PG8_LDB(B1, 0, 1); PG8_STAGE(PG8_SB(0, 0), b2, voffB);
            PG8_BAR; PG8_WAIT_L(0); PG8_MMA(0, 1, At, B1); PG8_BAR;
            PG8_LDA(At, 0, 1); PG8_STAGE(PG8_SA(0, 0), a2, voffA);
            PG8_BAR; PG8_WAIT_L(0); PG8_MMA(1, 0, At, B0); PG8_BAR; PG8_SCHED;
            PG8_STAGE(PG8_SB(0, 1), b2 + hstep, voffB);
            PG8_WAIT_V(6); PG8_BAR; PG8_MMA(1, 1, At, B1); PG8_BAR;
            PG8_LDB(B0, 1, 0); PG8_SCHED; PG8_LDA(At, 1, 0); PG8_STAGE(PG8_SA(0, 1), a2 + hstep, voffA);
            PG8_WAIT_L(8); PG8_BAR; PG8_WAIT_L(0); PG8_MMA(0, 0, At, B0); PG8_BAR; PG8_SCHED;
            PG8_LDB(B1, 1, 1); PG8_STAGE(PG8_SB(1, 0), b3, voffB);
            PG8_BAR; PG8_WAIT_L(0); PG8_MMA(0, 1, At, B1); PG8_BAR;
            PG8_LDA(At, 1, 1); PG8_STAGE(PG8_SA(1, 0), a3, voffA);
            PG8_BAR; PG8_WAIT_L(0); PG8_MMA(1, 0, At, B0); PG8_BAR; PG8_SCHED;
            PG8_STAGE(PG8_SB(1, 1), b3 + hstep, voffB);
            PG8_WAIT_V(6); PG8_BAR; PG8_MMA(1, 1, At, B1); PG8_BAR;
            }
        }
        if constexpr (ALIGN_EPI) { if (wr == 0) PG8_BAR; }
        if constexpr (!Epi::AFTER_DRAIN) { E(acc, cur, wr, wc, fr, fq); S.done(cur); }
        if (!has_next) break;
#pragma unroll
        for (int a = 0; a < 2; ++a)
#pragma unroll
            for (int b = 0; b < 2; ++b)
#pragma unroll
                for (int m = 0; m < 4; ++m)
#pragma unroll
                    for (int n = 0; n < 2; ++n) acc[a][b][m][n] = (f32x4){0.f, 0.f, 0.f, 0.f};
        cur = nxt; cA = nA; cB = nB; ++ui;
        if constexpr (ALIGN_EPI) { if (wr == 1) PG8_BAR; }
    }
    PG8_WAIT_V(0);
    if constexpr (!ALIGN_EPI) { if (wr == 0) PG8_BAR; }
    PG8_BAR;
    if constexpr (Epi::AFTER_DRAIN) { E.fused(acc, cur, wr, wc, fr, fq, lds, wid, lane); S.done(cur); }
#undef PG8_SA
#undef PG8_SB
#undef PG8_STAGE
#undef PG8_LDA
#undef PG8_LDB
#undef PG8_MMA
#undef PG8_WAIT_V
#undef PG8_WAIT_L
#undef PG8_BAR
#undef PG8_SCHED
}
}
#define DI __device__ __forceinline__
#define LAS __attribute__((address_space(3)))
typedef unsigned short bf16_t;
typedef short bf16x8 __attribute__((ext_vector_type(8)));
typedef short s16x4 __attribute__((ext_vector_type(4)));
typedef float f32x2 __attribute__((ext_vector_type(2)));
typedef float f32x4 __attribute__((ext_vector_type(4)));
typedef float f32x16 __attribute__((ext_vector_type(16)));
typedef unsigned u32x2 __attribute__((ext_vector_type(2)));
typedef unsigned u32x4 __attribute__((ext_vector_type(4)));
typedef __bf16 bf16x2_t __attribute__((ext_vector_type(2)));

constexpr int DM = 1024, BATCH = 32, SEQ = 2048, DEPTH = 2, MTOK = BATCH * SEQ, DFF = 2752, DFFP = 2816, NUP = 2 * DFFP, NPROJ = 3072, PLED = 256;
constexpr int IN_COLS = 2964;
constexpr int C_NQ = 0, C_NKV = 256, C_DQ = 640, C_DK = 896, C_DV = 1152, C_FQ = 1408, C_FK = 1920, C_FV = 2432, C_NG = 2944, C_FF = 2956;
constexpr float LN_EPS = 1e-5f;
constexpr float DN_ALPHA = 1.41421356237f;
constexpr float LOG2E = 1.44269504089f;

constexpr size_t MiB = 1u << 20;
constexpr size_t WS_CTL = 0;
constexpr size_t WS_TBL = 1 * MiB;
constexpr size_t TB_COS64 = 0, TB_SIN64 = 256 * 1024, TB_COS32 = 512 * 1024, TB_SIN32 = 640 * 1024, TB_CBIAS = 768 * 1024, TB_LAM = 772 * 1024;
constexpr size_t WS_KC = 2 * MiB, WS_VC = 2 * MiB + 512 * 1024;
constexpr size_t WS_SEL = 3 * MiB;
constexpr size_t WS_CKL = 4 * MiB;
constexpr size_t WS_W = 8 * MiB, W_LAYER = 46 * MiB;
constexpr size_t W_UP1 = 0, W_DN1 = 11 * MiB, W_UP2 = W_DN1 + 5632 * 1024, W_DN2 = W_UP2 + 11 * MiB, W_IN = W_DN2 + 5632 * 1024, W_OUT = W_IN + 6 * MiB,
                 W_PLEG = W_OUT + 2 * MiB, W_PLEP = W_PLEG + 2 * MiB, W_K1 = W_PLEP + 512 * 1024, W_V1 = W_K1 + 1 * MiB, W_K2 = W_V1 + 1 * MiB, W_V2 = W_K2 + 32 * 1024;
static_assert(W_V2 + 32 * 1024 <= W_LAYER, "weights fit");
constexpr size_t WS_XB = 100 * MiB;
constexpr size_t WS_PB = 228 * MiB;
constexpr size_t WS_OCMP = 292 * MiB;
constexpr size_t WS_MIX = 356 * MiB;
constexpr size_t WS_BIG = 484 * MiB;
constexpr size_t WS_END = 868 * MiB;
constexpr size_t WS_LNST = 6 * MiB;
static_assert(K_WS_BIG == WS_BIG && K_WS_TBL == WS_TBL && K_TB_COS64 == TB_COS64 && K_TB_SIN64 == TB_SIN64 && K_TB_COS32 == TB_COS32 && K_TB_SIN32 == TB_SIN32, "epilogue offsets");
constexpr int CW_QUEUE = 64;

DI unsigned pk2(float lo, float hi) { f32x2 v = {lo, hi}; return __builtin_bit_cast(unsigned, __builtin_convertvector(v, bf16x2_t)); }
DI float bf2f(bf16_t h) { return __uint_as_float((unsigned)h << 16); }
DI bf16_t f2bf(float f) { return (bf16_t)(pk2(f, 0.f) & 0xffffu); }
DI float wave_sum(float v) {
    v += shx<1>(v); v += shx<2>(v); v += shx<4>(v); v += shx<8>(v); v += shx<16>(v); v += shx<32>(v);
    return v;
}
DI int crow(int i, int hh) { return (i & 3) + 8 * (i >> 2) + 4 * hh; }
#define MFMA32(a, b, c) __builtin_amdgcn_mfma_f32_32x32x16_bf16((a), (b), (c), 0, 0, 0)
#define MFMA16(a, b, c) __builtin_amdgcn_mfma_f32_16x16x32_bf16((a), (b), (c), 0, 0, 0)
#define LDS_WAIT() asm volatile("s_waitcnt lgkmcnt(0)" ::: "memory")

struct Args {
    const float* in[24]; float* out; unsigned char* ws; int ph_lo, ph_hi;
};
typedef const __attribute__((address_space(4))) Args* ARGP;
struct Ctx {
    int tid, lane, wave, bid, G;
    unsigned char* ws; LAS unsigned char* lds;
};

DI void tr_item(const float* W, int ldn, int Ksrc, int srccol, bf16_t* WT, int ldk, int k0, int nrow0, LAS float* scr, int lane) {
#pragma unroll
    for (int i = 0; i < 32; ++i) { const int kk = 2 * i + (lane >> 5), k = k0 + kk; float v = 0.f; if (srccol >= 0 && k < Ksrc) v = W[(size_t)k * ldn + srccol]; scr[kk * 33 + (lane & 31)] = v; }
    LDS_WAIT();
    const int c = lane & 7;
#pragma unroll
    for (int j = 0; j < 4; ++j) { const int n = (lane >> 3) + 8 * j; const LAS float* s = scr + (8 * c) * 33 + n;
        u32x4 o; o.x = pk2(s[0 * 33], s[1 * 33]); o.y = pk2(s[2 * 33], s[3 * 33]); o.z = pk2(s[4 * 33], s[5 * 33]); o.w = pk2(s[6 * 33], s[7 * 33]);
        *(u32x4*)(WT + (size_t)(nrow0 + n) * ldk + k0 + 8 * c) = o; }
    LDS_WAIT();
}
DI int proj_col_of_row(int n) { const int tile = n >> 8, bj = (n >> 7) & 1, wc = (n >> 5) & 3, j = n & 31, sg = tile * 4 + wc;
    return (sg >= 10 && sg < 18) ? 64 * sg + 32 * (j >> 4) + 16 * bj + (j & 15) : 64 * sg + 32 * bj + j; }
DI int win_map(int n) { return n < 640 ? n : (n < 2944 ? n + 12 : (n < 2956 ? n - 2944 + 640 : (n < 2964 ? n : -1))); }

DI void prep_phase(const Ctx& C, ARGP a) {
    LAS float* scr = (LAS float*)(C.lds + C.wave * 16384);
    const int gw = C.bid * 8 + C.wave, NGW = C.G * 8, lane = C.lane;
    constexpr int I_UP = 16 * 176, I_DN = 44 * 32, I_IN = 16 * 96, I_SQ = 16 * 32, I_PP = 4 * 32, I_P1 = 32 * 8, I_P2 = 4 * 2;
    constexpr int PER_LAYER = 2 * I_UP + 2 * I_DN + I_IN + 2 * I_SQ + I_PP + 2 * I_P1 + 2 * I_P2;
    for (int it = gw; it < DEPTH * PER_LAYER; it += NGW) {
        const int L = it / PER_LAYER; int r = it % PER_LAYER;
        unsigned char* wb = C.ws + WS_W + (size_t)L * W_LAYER;
        if (r < 2 * I_UP) { const int f = r / I_UP; r %= I_UP; const int kb = r / 176, nb = r % 176; const int n = 32 * nb + (lane & 31);
            const int pn = n >> 8, bj = (n >> 7) & 1, hid = 128 * pn + (n & 127);
            const float* src = a->in[(f ? 7 : 4) + bj] + (size_t)L * DM * DFF;
            tr_item(src, DFF, DM, hid < DFF ? hid : -1, (bf16_t*)(wb + (f ? W_UP2 : W_UP1)), DM, 64 * kb, 32 * nb, scr, lane); continue; }
        r -= 2 * I_UP;
        if (r < 2 * I_DN) { const int f = r / I_DN; r %= I_DN; const int kb = r / 32, nb = r % 32;
            const float* src = a->in[f ? 9 : 6] + (size_t)L * DFF * DM;
            tr_item(src, DM, DFF, 32 * nb + (lane & 31), (bf16_t*)(wb + (f ? W_DN2 : W_DN1)), DFFP, 64 * kb, 32 * nb, scr, lane); continue; }
        r -= 2 * I_DN;
        if (r < I_IN) { const int kb = r / 96, nb = r % 96;
            tr_item(a->in[10] + (size_t)L * DM * IN_COLS, IN_COLS, DM, win_map(proj_col_of_row(32 * nb + (lane & 31))), (bf16_t*)(wb + W_IN), DM, 64 * kb, 32 * nb, scr, lane); continue; }
        r -= I_IN;
        if (r < 2 * I_SQ) { const int f = r / I_SQ; r %= I_SQ; const int kb = r / 32, nb = r % 32;
            tr_item(a->in[f ? 21 : 20] + (size_t)L * DM * DM, DM, DM, 32 * nb + (lane & 31), (bf16_t*)(wb + (f ? W_PLEG : W_OUT)), DM, 64 * kb, 32 * nb, scr, lane); continue; }
        r -= 2 * I_SQ;
        if (r < I_PP) { const int kb = r / 32, nb = r % 32;
            tr_item(a->in[23] + (size_t)L * PLED * DM, DM, PLED, 32 * nb + (lane & 31), (bf16_t*)(wb + W_PLEP), PLED, 64 * kb, 32 * nb, scr, lane); continue; }
        r -= I_PP;
        if (r < 2 * I_P1) { const int f = r / I_P1; r %= I_P1; const int kb = r / 8, nb = r % 8;
            tr_item(a->in[f ? 16 : 14] + (size_t)L * 2048 * 256, 256, 2048, 32 * nb + (lane & 31), (bf16_t*)(wb + (f ? W_V1 : W_K1)), 2048, 64 * kb, 32 * nb, scr, lane); continue; }
        r -= 2 * I_P1;
        { const int f = r / I_P2; r %= I_P2; const int kb = r / 2, nb = r % 2;
            tr_item(a->in[f ? 17 : 15] + (size_t)L * 256 * 64, 64, 256, 32 * nb + (lane & 31), (bf16_t*)(wb + (f ? W_V2 : W_K2)), 256, 64 * kb, 32 * nb, scr, lane); }
    }
    const size_t gt = (size_t)C.bid * 512 + C.tid, NT = (size_t)C.G * 512;
    { const float* x = a->in[0]; bf16_t* xb = (bf16_t*)(C.ws + WS_XB); const float* p = a->in[1]; bf16_t* pb = (bf16_t*)(C.ws + WS_PB);
      constexpr size_t NX = (size_t)MTOK * DM / 8, NP = (size_t)DEPTH * MTOK * PLED / 8;
      for (size_t i0 = gt; i0 < NX + NP; i0 += 4 * NT) { f32x4 v[4][2];
#pragma unroll
          for (int q = 0; q < 4; ++q) { size_t i = i0 + q * NT; if (i >= NX + NP) i = gt; const float* src = i < NX ? x + i * 8 : p + (i - NX) * 8; v[q][0] = *(const f32x4*)src; v[q][1] = *(const f32x4*)(src + 4); }
#pragma unroll
          for (int q = 0; q < 4; ++q) { size_t i = i0 + q * NT; if (i >= NX + NP) i = gt; bf16_t* dst = i < NX ? xb + i * 8 : pb + (i - NX) * 8;
              u32x4 o; o.x = pk2(v[q][0][0], v[q][0][1]); o.y = pk2(v[q][0][2], v[q][0][3]); o.z = pk2(v[q][1][0], v[q][1][1]); o.w = pk2(v[q][1][2], v[q][1][3]); *(u32x4*)dst = o; } } }
    { float* tb = (float*)(C.ws + WS_TBL);
      for (size_t i = gt; i < (size_t)SEQ * 48; i += NT) {
          int pos, k; float inv; const bool big = i < (size_t)SEQ * 32; size_t j;
          if (big) { j = i; pos = (int)(i >> 5); k = (int)(i & 31); inv = exp2f(-(float)k * (13.2877123795f / 32.0f)); }
          else { j = i - (size_t)SEQ * 32; pos = (int)(j >> 4); k = (int)(j & 15); inv = exp2f(-(float)k * (13.2877123795f / 16.0f)); }
          const float ang = (float)pos * inv; double rv = (double)ang * 0.15915494309189535; rv -= floor(rv); const float fr = (float)rv;
          const float cs = __builtin_amdgcn_cosf(fr), sn = __builtin_amdgcn_sinf(fr);
          if (big) { tb[TB_COS64 / 4 + j] = cs; tb[TB_SIN64 / 4 + j] = sn; } else { tb[TB_COS32 / 4 + j] = cs; tb[TB_SIN32 / 4 + j] = sn; } } }
    { float* cb = (float*)(C.ws + WS_TBL + TB_CBIAS);
      for (int o = gw; o < DEPTH * 2 * 256; o += NGW) { const int L = o >> 9, kv = (o >> 8) & 1, n = o & 255;
          const float* pe = a->in[kv ? 13 : 12] + (size_t)L * 2048; const float* w1 = a->in[kv ? 16 : 14] + (size_t)L * 2048 * 256;
          float s = 0.f; for (int k = lane; k < 2048; k += 64) s += pe[k] * w1[(size_t)k * 256 + n];
          s = wave_sum(s); if (lane == 0) cb[o] = s; } }
    if (C.bid == 0 && C.tid < DEPTH) { const int L = C.tid; const float* lp = a->in[18] + L * 128; float s1 = 0.f, s2 = 0.f;
        for (int k = 0; k < 32; ++k) { s1 += lp[k] * lp[32 + k]; s2 += lp[64 + k] * lp[96 + k]; }
        const float li = 0.8f - 0.6f * expf(-0.3f * (float)L);
        ((float*)(C.ws + WS_TBL + TB_LAM))[L] = expf(s1) - expf(s2) + li; }
}

DI void ln_phase(const Ctx& C, bf16_t* XB, const float* g, const float* b) {
    const int gw = C.bid * 8 + C.wave, NGW = C.G * 8, lane = C.lane;
    f32x4 gv[4], bv[4];
#pragma unroll
    for (int j = 0; j < 4; ++j) { gv[j] = *(const f32x4*)(g + 16 * lane + 4 * j); bv[j] = *(const f32x4*)(b + 16 * lane + 4 * j); }
    for (int m = gw; m < MTOK; m += NGW) {
        u32x4* xr = (u32x4*)(XB + (size_t)m * DM + 16 * lane); const u32x4 r0 = xr[0], r1 = xr[1];
        f32x4 v[4];
        v[0][0] = __uint_as_float(r0.x << 16); v[0][1] = __uint_as_float(r0.x & 0xffff0000u); v[0][2] = __uint_as_float(r0.y << 16); v[0][3] = __uint_as_float(r0.y & 0xffff0000u);
        v[1][0] = __uint_as_float(r0.z << 16); v[1][1] = __uint_as_float(r0.z & 0xffff0000u); v[1][2] = __uint_as_float(r0.w << 16); v[1][3] = __uint_as_float(r0.w & 0xffff0000u);
        v[2][0] = __uint_as_float(r1.x << 16); v[2][1] = __uint_as_float(r1.x & 0xffff0000u); v[2][2] = __uint_as_float(r1.y << 16); v[2][3] = __uint_as_float(r1.y & 0xffff0000u);
        v[3][0] = __uint_as_float(r1.z << 16); v[3][1] = __uint_as_float(r1.z & 0xffff0000u); v[3][2] = __uint_as_float(r1.w << 16); v[3][3] = __uint_as_float(r1.w & 0xffff0000u);
        float s = 0.f;
#pragma unroll
        for (int j = 0; j < 4; ++j) s += (v[j][0] + v[j][1]) + (v[j][2] + v[j][3]);
        const float mean = wave_sum(s) * (1.f / DM); float s2 = 0.f;
#pragma unroll
        for (int j = 0; j < 4; ++j) { v[j] = v[j] - mean; s2 += (v[j][0] * v[j][0] + v[j][1] * v[j][1]) + (v[j][2] * v[j][2] + v[j][3] * v[j][3]); }
        const float rstd = 1.0f / sqrtf(wave_sum(s2) * (1.f / DM) + LN_EPS);
        f32x4 o[4];
#pragma unroll
        for (int j = 0; j < 4; ++j) o[j] = v[j] * rstd * gv[j] + bv[j];
        u32x4 w0, w1; w0.x = pk2(o[0][0], o[0][1]); w0.y = pk2(o[0][2], o[0][3]); w0.z = pk2(o[1][0], o[1][1]); w0.w = pk2(o[1][2], o[1][3]);
        w1.x = pk2(o[2][0], o[2][1]); w1.y = pk2(o[2][2], o[2][3]); w1.z = pk2(o[3][0], o[3][1]); w1.w = pk2(o[3][2], o[3][3]);
        xr[0] = w0; xr[1] = w1;
    }
}
#define XLAS __attribute__((address_space(3)))
#define XB_TMO      128
#define XB_XCNT(j)  (256  + 64 * (j))
#define XB_XSUB(j)  (1280 + 64 * (j))
#define XB_XGEN(j)  (2304 + 64 * (j))
#define XB_TOP      3328
#define XB_TOPGEN   3392
#define XCD_BAR_WORDS 3456
#define XB_SPIN_CAP (1u << 18)

__device__ __forceinline__ unsigned xb_ld(unsigned* p)              { return __hip_atomic_load(p, __ATOMIC_RELAXED, __HIP_MEMORY_SCOPE_AGENT); }
__device__ __forceinline__ unsigned xb_add(unsigned* p, unsigned v) { return __hip_atomic_fetch_add(p, v, __ATOMIC_RELAXED, __HIP_MEMORY_SCOPE_AGENT); }
__device__ __forceinline__ unsigned xb_xcc_id() { return (unsigned)__builtin_amdgcn_s_getreg((3 << 11) | 20) & 0xFu; }
#define XB_SPIN(cond, bar) do { unsigned _sp = 0; while (cond) { __builtin_amdgcn_s_sleep(1); \
    if ((++_sp & 255u) == 0u) { if (xb_ld(&(bar)[XB_TMO])) break; if (_sp > XB_SPIN_CAP) { atomicAdd(&(bar)[XB_TMO], 1u); break; } } } } while (0)

struct XcdBarrier {
    unsigned* bar; unsigned x;
    volatile XLAS unsigned* st;
};

__device__ __forceinline__ XcdBarrier xcd_barrier_post(unsigned* bar, volatile XLAS unsigned* st) {
    XcdBarrier b; b.bar = bar; b.x = xb_xcc_id(); b.st = st;
    if (threadIdx.x == 0) (void)xb_add(&bar[XB_XCNT(b.x)], 1u);
    return b;
}
__device__ __forceinline__ void xcd_barrier_complete(unsigned* bar, unsigned x, unsigned& nloc, unsigned& nx) {
    const unsigned G = gridDim.x * gridDim.y * gridDim.z;
    unsigned sum, cnt, mine, sp = 0u;
    for (;;) {
        sum = 0u; cnt = 0u; mine = 0u;
#pragma unroll
        for (unsigned j = 0; j < 16; ++j) { const unsigned c = xb_ld(&bar[XB_XCNT(j)]); sum += c; cnt += (c > 0u) ? 1u : 0u; mine = (j == x) ? c : mine; }
        if (sum == G) break;
        __builtin_amdgcn_s_sleep(1);
        if ((++sp & 255u) == 0u) { if (xb_ld(&bar[XB_TMO])) break; if (sp > XB_SPIN_CAP) { atomicAdd(&bar[XB_TMO], 1u); break; } }
    }
    nloc = mine > 0u ? mine : 1u; nx = cnt > 0u ? cnt : 1u;
}

__device__ __forceinline__ void xcd_barrier(const XcdBarrier& b) {
    asm volatile("s_waitcnt vmcnt(0)" ::: "memory");
    __syncthreads();
    if (threadIdx.x == 0) {
        unsigned* bar = b.bar;
        __builtin_amdgcn_s_waitcnt(0);
        unsigned nloc = b.st[0], nx = b.st[1];
        if (nloc == 0u) { xcd_barrier_complete(bar, b.x, nloc, nx); b.st[0] = nloc; b.st[1] = nx; }
        const unsigned old = xb_add(&bar[XB_XSUB(b.x)], 1u);
        const unsigned gen = old / nloc;
        if (old + 1u == (gen + 1u) * nloc) {
            __builtin_amdgcn_fence(__ATOMIC_RELEASE, "agent");
            asm volatile("s_waitcnt vmcnt(0)" ::: "memory");
            const unsigned og = xb_add(&bar[XB_TOP], 1u);
            const unsigned tg = og / nx;
            if (og + 1u == (tg + 1u) * nx) xb_add(&bar[XB_TOPGEN], 1u);
            else XB_SPIN(xb_ld(&bar[XB_TOPGEN]) == tg, bar);
            __builtin_amdgcn_fence(__ATOMIC_ACQUIRE, "agent");
            xb_add(&bar[XB_XGEN(b.x)], 1u);
            asm volatile("s_waitcnt vmcnt(0)" ::: "memory");
        } else {
            XB_SPIN(xb_ld(&bar[XB_XGEN(b.x)]) == gen, bar);
            __builtin_amdgcn_fence(__ATOMIC_ACQUIRE, "agent");
            asm volatile("s_waitcnt vmcnt(0)" ::: "memory");
        }
    }
    __syncthreads();
}
DI float gelu_tanh(float x) { const float z = 0.7978845608f * (x + 0.044715f * x * x * x); const float e = __builtin_amdgcn_exp2f(2.0f * LOG2E * z); return 0.5f * x * (2.0f - 2.0f * __builtin_amdgcn_rcpf(e + 1.0f)); }

DI void cmp_mlp_unit(const Ctx& C, const bf16_t* proj, int b, int cgp, int kv, const bf16_t* W1t, const bf16_t* W2t, const float* bias, bf16_t* outp, const float* cos64, const float* sin64) {
    constexpr int SP = 72, HP = 264;
    LAS bf16_t* span = (LAS bf16_t*)C.lds;
    LAS bf16_t* Hs = (LAS bf16_t*)(C.lds + 528 * SP * 2);
    LAS float* Os = (LAS float*)(C.lds + 528 * SP * 2 + 32 * HP * 2);
    const int tid = C.tid, lane = C.lane, w = C.wave, row16 = lane & 15, quad = lane >> 4;
    const int t0 = 512 * cgp;
    for (int idx = tid; idx < 528 * 8; idx += 512) { const int tr = idx >> 3, ch = idx & 7, t = t0 + tr; u32x4 v = {0u, 0u, 0u, 0u};
        if (t < SEQ) v = *(const u32x4*)(proj + (size_t)(b * SEQ + t) * NPROJ + C_NKV + kv * 64 + ch * 8);
        *(LAS u32x4*)(span + tr * SP + ch * 8) = v; }
    __syncthreads();
    f32x4 acc[2][2];
#pragma unroll
    for (int i = 0; i < 2; ++i)
#pragma unroll
        for (int j = 0; j < 2; ++j) acc[i][j] = (f32x4){0.f, 0.f, 0.f, 0.f};
    const bf16_t* wb0 = W1t + (size_t)(32 * w + row16) * 2048 + quad * 8;
#pragma unroll 4
    for (int ks = 0; ks < 64; ++ks) { const int l = ks >> 1, dq = ks & 1, k0 = l * 64 + 32 * dq;
        const bf16x8 b0 = *(const bf16x8*)(wb0 + k0), b1 = *(const bf16x8*)(wb0 + 16 * 2048 + k0);
        const bf16x8 a0 = *(const LAS bf16x8*)(span + (16 * row16 + l) * SP + 32 * dq + quad * 8);
        const bf16x8 a1 = *(const LAS bf16x8*)(span + (16 * (16 + row16) + l) * SP + 32 * dq + quad * 8);
        acc[0][0] = MFMA16(a0, b0, acc[0][0]); acc[0][1] = MFMA16(a0, b1, acc[0][1]); acc[1][0] = MFMA16(a1, b0, acc[1][0]); acc[1][1] = MFMA16(a1, b1, acc[1][1]); }
#pragma unroll
    for (int mi = 0; mi < 2; ++mi)
#pragma unroll
        for (int ni = 0; ni < 2; ++ni) { const int n = 32 * w + 16 * ni + row16; const float bs = bias[n];
#pragma unroll
            for (int j = 0; j < 4; ++j) Hs[(16 * mi + quad * 4 + j) * HP + n] = f2bf(gelu_tanh(acc[mi][ni][j] + bs)); }
    __syncthreads();
    { const int mt = w >> 2, nt = w & 3; f32x4 a2 = {0.f, 0.f, 0.f, 0.f};
#pragma unroll
      for (int ks = 0; ks < 8; ++ks) { const bf16x8 av = *(const LAS bf16x8*)(Hs + (16 * mt + row16) * HP + 32 * ks + quad * 8);
          const bf16x8 bv = *(const bf16x8*)(W2t + (size_t)(16 * nt + row16) * 256 + 32 * ks + quad * 8); a2 = MFMA16(av, bv, a2); }
#pragma unroll
      for (int j = 0; j < 4; ++j) Os[(16 * mt + quad * 4 + j) * 64 + 16 * nt + row16] = a2[j]; }
    __syncthreads();
    { const int c = tid >> 4, cglob = 32 * cgp + c; bf16_t* op = outp + (size_t)(b * 128 + cglob) * 64;
#pragma unroll
      for (int e = 0; e < 2; ++e) { const int i = (tid & 15) * 2 + e; float x1 = Os[c * 64 + i], x2 = Os[c * 64 + i + 32];
          if (cglob >= 127) { x1 = 0.f; x2 = 0.f; }
          else if (kv == 0) { const int pos = 16 * cglob + 31; const float cs = cos64[pos * 32 + i], sn = sin64[pos * 32 + i]; const float y1 = x1 * cs - x2 * sn, y2 = x2 * cs + x1 * sn; x1 = y1; x2 = y2; }
          op[i] = f2bf(x1); op[i + 32] = f2bf(x2); } }
    __syncthreads();
}

DI void attn_prep_phase(const Ctx& C, ARGP a, int L) {
    bf16_t* proj = (bf16_t*)(C.ws + WS_BIG);
    const float* tb = (const float*)(C.ws + WS_TBL);
    const float* cos64 = tb + TB_COS64 / 4; const float* sin64 = tb + TB_SIN64 / 4; const float* cos32 = tb + TB_COS32 / 4; const float* sin32 = tb + TB_SIN32 / 4;
    unsigned char* wb = C.ws + WS_W + (size_t)L * W_LAYER;
    for (int u = C.bid; u < BATCH * 4 * 2; u += C.G) { const int kv = u & 1, cgp = (u >> 1) & 3, b = u >> 3;
        cmp_mlp_unit(C, proj, b, cgp, kv, (const bf16_t*)(wb + (kv ? W_V1 : W_K1)), (const bf16_t*)(wb + (kv ? W_V2 : W_K2)),
                     (const float*)(C.ws + WS_TBL + TB_CBIAS) + (L * 2 + kv) * 256, (bf16_t*)(C.ws + (kv ? WS_VC : WS_KC)), cos64, sin64); }
    const int gw = C.bid * 8 + C.wave, NGW = C.G * 8, lane = C.lane;
    for (int u = gw; u < BATCH * 8; u += NGW) { const int b = u >> 3, h = u & 7; const float bf = a->in[11][L * 8 + h];
        float* ck = (float*)(C.ws + WS_CKL) + (size_t)u * SEQ + lane * 32; const bf16_t* fp = proj + (size_t)(b * SEQ + lane * 32) * NPROJ + C_FF + h;
        float run = 0.f; float loc[32];
#pragma unroll
        for (int i = 0; i < 32; ++i) { const float x = bf2f(fp[(size_t)i * NPROJ]) + bf; const float ls = fminf(x, 0.f) - log1pf(expf(-fabsf(x))); run += ls; loc[i] = run; }
        float incl = run;
#pragma unroll
        for (int o = 1; o < 64; o <<= 1) { const float t = __builtin_bit_cast(float, __builtin_amdgcn_ds_bpermute((lane - o) << 2, __builtin_bit_cast(int, incl))); if (lane >= o) incl += t; }
        const float base = incl - run;
#pragma unroll
        for (int i = 0; i < 32; ++i) ck[i] = (base + loc[i]) * LOG2E; }
}

constexpr int KP = 72;
DI void cmp_attn_phase(const Ctx& C, int L) {
    const bf16_t* proj = (const bf16_t*)(C.ws + WS_BIG);
    LAS bf16_t* Ks = (LAS bf16_t*)C.lds;
    LAS bf16_t* Vs = (LAS bf16_t*)(C.lds + 128 * KP * 2);
    LAS float* Ps = (LAS float*)(C.lds + 2 * 128 * KP * 2 + C.wave * 5120);
    LAS float* Sc = Ps + 8 * 128;
    const int tid = C.tid, lane = C.lane, w = C.wave, r = lane & 31, hh = lane >> 5;
    const float c1 = 0.125f * LOG2E;
    for (int ug = C.bid; ug < BATCH * 8; ug += C.G) {
        const int b = ug >> 3;
        __syncthreads();
        for (int idx = tid; idx < 128 * 8 * 2; idx += 512) { const int kvs = idx >> 10, rem = idx & 1023, c = rem >> 3, ch = rem & 7;
            const u32x4 v = *(const u32x4*)((const bf16_t*)(C.ws + (kvs ? WS_VC : WS_KC)) + (size_t)(b * 128 + c) * 64 + ch * 8);
            *(LAS u32x4*)((kvs ? Vs : Ks) + c * KP + ch * 8) = v; }
        __syncthreads();
        for (int uu = 0; uu < 4; ++uu) {
            const int t0 = ((ug & 7) * 4 + uu) * 64; const int tok = t0 + 8 * w + (r >> 2), g = r & 3; const size_t m = (size_t)b * SEQ + tok;
            bf16x8 qf[4];
#pragma unroll
            for (int s = 0; s < 4; ++s) qf[s] = *(const bf16x8*)(proj + m * NPROJ + C_NQ + g * 64 + 16 * s + 8 * hh);
            f32x16 p[4];
#pragma unroll
            for (int kt = 0; kt < 4; ++kt) { f32x16 acc;
#pragma unroll
                for (int i = 0; i < 16; ++i) acc[i] = 0.f;
#pragma unroll
                for (int s = 0; s < 4; ++s) { const bf16x8 kf = *(const LAS bf16x8*)(Ks + (32 * kt + r) * KP + 16 * s + 8 * hh); acc = MFMA32(kf, qf[s], acc); }
                p[kt] = acc; }
            float mx = -1e30f; const int climh = ((tok - 31) >> 4) - 4 * hh;
#pragma unroll
            for (int kt = 0; kt < 4; ++kt)
#pragma unroll
                for (int i = 0; i < 16; ++i) { const bool ok = (32 * kt + (i & 3) + 8 * (i >> 2)) <= climh; p[kt][i] = ok ? p[kt][i] : -INFINITY; mx = fmaxf(mx, p[kt][i]); }
            mx = fmaxf(mx, shx<32>(mx));
            float sum = 0.f; const float off = mx * c1;
#pragma unroll
            for (int kt = 0; kt < 4; ++kt)
#pragma unroll
                for (int i = 0; i < 16; ++i) { const float e = __builtin_amdgcn_exp2f(p[kt][i] * c1 - off); p[kt][i] = e; sum += e; }
            sum += shx<32>(sum);
            const float inv = (tok >= 31) ? 1.0f / sum : 0.f;
#pragma unroll
            for (int kt = 0; kt < 4; ++kt)
#pragma unroll
                for (int i = 0; i < 16; ++i) p[kt][i] *= inv;
            __builtin_amdgcn_sched_barrier(0);
            f32x16 o[2];
#pragma unroll
            for (int dt = 0; dt < 2; ++dt)
#pragma unroll
                for (int i = 0; i < 16; ++i) o[dt][i] = 0.f;
            const int i16 = lane & 15, q4 = i16 >> 2, pp = i16 & 3, blk = (lane >> 4) & 1;
            const LAS bf16_t* vb = Vs + (4 * hh + q4) * KP + 16 * blk + 4 * pp;
#pragma unroll
            for (int kt = 0; kt < 4; ++kt)
#pragma unroll
                for (int s = 0; s < 2; ++s) { u32x4 pw; pw.x = pk2(p[kt][8 * s], p[kt][8 * s + 1]); pw.y = pk2(p[kt][8 * s + 2], p[kt][8 * s + 3]); pw.z = pk2(p[kt][8 * s + 4], p[kt][8 * s + 5]); pw.w = pk2(p[kt][8 * s + 6], p[kt][8 * s + 7]);
                    const bf16x8 pf = __builtin_bit_cast(bf16x8, pw);
#pragma unroll
                    for (int dt = 0; dt < 2; ++dt) { const s16x4 lo = __builtin_amdgcn_ds_read_tr16_b64_v4i16((LAS s16x4*)(vb + (32 * kt + 16 * s) * KP + 32 * dt));
                        const s16x4 hi = __builtin_amdgcn_ds_read_tr16_b64_v4i16((LAS s16x4*)(vb + (32 * kt + 16 * s + 8) * KP + 32 * dt));
                        const bf16x8 vf = __builtin_shufflevector(lo, hi, 0, 1, 2, 3, 4, 5, 6, 7); o[dt] = MFMA32(vf, pf, o[dt]); } __builtin_amdgcn_sched_barrier(0); }
            __builtin_amdgcn_sched_barrier(0);
            { const float gl = bf2f(proj[m * NPROJ + C_NG + g * 3 + 0]); const float gate = 1.0f / (1.0f + __expf(-gl));
              float* op = (float*)(C.ws + WS_OCMP) + m * 256 + g * 64;
#pragma unroll
              for (int dt = 0; dt < 2; ++dt)
#pragma unroll
                  for (int g4 = 0; g4 < 4; ++g4) { f32x4 v; v[0] = o[dt][4 * g4] * gate; v[1] = o[dt][4 * g4 + 1] * gate; v[2] = o[dt][4 * g4 + 2] * gate; v[3] = o[dt][4 * g4 + 3] * gate;
                      *(f32x4*)(op + 32 * dt + 8 * g4 + 4 * hh) = v; } }
            __builtin_amdgcn_sched_barrier(0);
#pragma unroll
            for (int kt = 0; kt < 4; ++kt)
#pragma unroll
                for (int i = 0; i < 16; ++i) { float v = p[kt][i]; v += shx<1>(v); v += shx<2>(v); p[kt][i] = v; }
            __builtin_amdgcn_sched_barrier(0);
            if (g == 0) {
#pragma unroll
                for (int kt = 0; kt < 4; ++kt)
#pragma unroll
                    for (int g4 = 0; g4 < 4; ++g4) { f32x4 v; v[0] = p[kt][4 * g4]; v[1] = p[kt][4 * g4 + 1]; v[2] = p[kt][4 * g4 + 2]; v[3] = p[kt][4 * g4 + 3];
                        *(LAS f32x4*)(Ps + (r >> 2) * 128 + 32 * kt + 8 * g4 + 4 * hh) = v; } }
            LDS_WAIT();
            { const int tk = lane >> 3, jg = lane & 7; const int t = t0 + 8 * w + tk; const int blk_t = t >> 6;
              float sc[4];
#pragma unroll
              for (int jj = 0; jj < 4; ++jj) { const int j = 4 * jg + jj; float imp = 0.f;
#pragma unroll
                  for (int cc = -1; cc < 4; ++cc) { const int c = 4 * j + cc; if (c >= 0) imp += Ps[tk * 128 + c]; }
                  const bool forced = (j == 0) || (j == blk_t) || (j == blk_t - 1); const bool valid = (j * 64) <= t;
                  sc[jj] = forced ? 1e9f : (valid ? imp : -1.0f); Sc[tk * 32 + j] = sc[jj]; }
              LDS_WAIT();
              unsigned bits = 0u;
#pragma unroll
              for (int jj = 0; jj < 4; ++jj) { const int j = 4 * jg + jj; int cnt = 0;
                  for (int j2 = 0; j2 < 32; ++j2) { const float o2 = Sc[tk * 32 + j2]; cnt += (o2 > sc[jj] || (o2 == sc[jj] && j2 < j)) ? 1 : 0; }
                  if (cnt < 16) bits |= 1u << j; }
              bits |= (unsigned)shxi<1>((int)bits); bits |= (unsigned)shxi<2>((int)bits); bits |= (unsigned)shxi<4>((int)bits);
              if (jg == 0) ((unsigned*)(C.ws + WS_SEL))[(size_t)b * SEQ + t] = bits; }
            LDS_WAIT();
        }
    }
}
constexpr int AT_KBUF = 64 * KP * 2;
constexpr int AT_K0 = 0, AT_V0 = 2 * AT_KBUF, AT_C0 = 4 * AT_KBUF, AT_MISC = AT_C0 + 2 * 256;

template <bool BIAS, bool SEL, int NS>
DI void tile_step(const LAS bf16_t* Kl, const LAS bf16_t* Vl, const LAS float* Cl, const bf16x8 (&qf)[NS], f32x16 (&o)[2], float& m, float& l,
                  const float c1, const int mmode, const int key0, const int trow, const bool kill, const int hh) {
    f32x16 p[2];
#pragma unroll
    for (int kt = 0; kt < 2; ++kt) { f32x16 acc;
#pragma unroll
        for (int i = 0; i < 16; ++i) acc[i] = 0.f;
#pragma unroll
        for (int s = 0; s < NS; ++s) { const bf16x8 kf = *(const LAS bf16x8*)(Kl + 32 * kt * KP + 16 * s); acc = MFMA32(kf, qf[s], acc); }
        p[kt] = acc; }
    if (BIAS) {
        const f32x2 c1v = {c1, c1};
#pragma unroll
        for (int kt = 0; kt < 2; ++kt)
#pragma unroll
            for (int g4 = 0; g4 < 4; ++g4) { const f32x4 cv = *(const LAS f32x4*)(Cl + 32 * kt + 8 * g4);
                f32x2 a0 = {p[kt][4 * g4], p[kt][4 * g4 + 1]}, a1 = {p[kt][4 * g4 + 2], p[kt][4 * g4 + 3]};
                a0 = a0 * c1v - (f32x2){cv[0], cv[1]}; a1 = a1 * c1v - (f32x2){cv[2], cv[3]};
                p[kt][4 * g4] = a0[0]; p[kt][4 * g4 + 1] = a0[1]; p[kt][4 * g4 + 2] = a1[0]; p[kt][4 * g4 + 3] = a1[1]; }
    }
    const int lim = trow - key0 - 4 * hh;
    if (mmode == 1) {
#pragma unroll
        for (int kt = 0; kt < 2; ++kt)
#pragma unroll
            for (int i = 0; i < 16; ++i) p[kt][i] = ((32 * kt + (i & 3) + 8 * (i >> 2)) > lim) ? -INFINITY : p[kt][i];
    } else if (mmode == 2) {
#pragma unroll
        for (int kt = 0; kt < 2; ++kt)
#pragma unroll
            for (int i = 0; i < 16; ++i) p[kt][i] = ((32 * kt + (i & 3) + 8 * (i >> 2)) <= lim - 512) ? -INFINITY : p[kt][i];
    }
    if (SEL) { if (kill) {
#pragma unroll
        for (int kt = 0; kt < 2; ++kt)
#pragma unroll
            for (int i = 0; i < 16; ++i) p[kt][i] = -INFINITY; } }
    float mx = p[0][0];
#pragma unroll
    for (int kt = 0; kt < 2; ++kt)
#pragma unroll
        for (int i = 0; i < 16; ++i) mx = fmaxf(mx, p[kt][i]);
    mx = fmaxf(mx, shx<32>(mx));
    const float mn = fmaxf(m, mx);
    float alpha, off, sc;
    if (BIAS) { alpha = __builtin_amdgcn_exp2f(m - mn); off = mn; sc = 1.0f; } else { alpha = __builtin_amdgcn_exp2f((m - mn) * c1); off = mn * c1; sc = c1; }
    m = mn;
    f32x2 rs2 = {0.f, 0.f}; const f32x2 scv = {sc, sc}, offv = {off, off};
#pragma unroll
    for (int kt = 0; kt < 2; ++kt)
#pragma unroll
        for (int i = 0; i < 16; i += 2) { f32x2 a = {p[kt][i], p[kt][i + 1]}; a = a * scv - offv; f32x2 e; e[0] = __builtin_amdgcn_exp2f(a[0]); e[1] = __builtin_amdgcn_exp2f(a[1]);
            p[kt][i] = e[0]; p[kt][i + 1] = e[1]; rs2 += e; }
    l = l * alpha + (rs2[0] + rs2[1]);
    const f32x2 av = {alpha, alpha};
#pragma unroll
    for (int dt = 0; dt < 2; ++dt)
#pragma unroll
        for (int i = 0; i < 16; i += 2) { f32x2 a = {o[dt][i], o[dt][i + 1]}; a = a * av; o[dt][i] = a[0]; o[dt][i + 1] = a[1]; }
#pragma unroll
    for (int kt = 0; kt < 2; ++kt)
#pragma unroll
        for (int s = 0; s < 2; ++s) { u32x4 pw; pw.x = pk2(p[kt][8 * s], p[kt][8 * s + 1]); pw.y = pk2(p[kt][8 * s + 2], p[kt][8 * s + 3]); pw.z = pk2(p[kt][8 * s + 4], p[kt][8 * s + 5]); pw.w = pk2(p[kt][8 * s + 6], p[kt][8 * s + 7]);
            const bf16x8 pf = __builtin_bit_cast(bf16x8, pw);
#pragma unroll
            for (int dt = 0; dt < 2; ++dt) { const s16x4 lo = __builtin_amdgcn_ds_read_tr16_b64_v4i16((LAS s16x4*)(Vl + (32 * kt + 16 * s) * KP + 32 * dt));
                const s16x4 hi = __builtin_amdgcn_ds_read_tr16_b64_v4i16((LAS s16x4*)(Vl + (32 * kt + 16 * s + 8) * KP + 32 * dt));
                const bf16x8 vf = __builtin_shufflevector(lo, hi, 0, 1, 2, 3, 4, 5, 6, 7); o[dt] = MFMA32(vf, pf, o[dt]); } }
}

struct TileRegs { u32x4 k, v; float c; };
template <bool BIAS>
DI void tile_gload(TileRegs& R, const bf16_t* kbase, const bf16_t* vbase, const float* cbase, int key0, int tid) {
    const size_t off = (size_t)(key0 + (tid >> 3)) * NPROJ + (tid & 7) * 8;
    R.k = *(const u32x4*)(kbase + off); R.v = *(const u32x4*)(vbase + off);
    if (BIAS) { if (tid < 64) R.c = cbase[key0 + tid]; }
}
template <bool BIAS>
DI void tile_lstore(const TileRegs& R, LAS unsigned char* lds, int buf, int tid) {
    const int o = ((tid >> 3) * KP + (tid & 7) * 8) * 2;
    *(LAS u32x4*)(lds + AT_K0 + buf * AT_KBUF + o) = R.k; *(LAS u32x4*)(lds + AT_V0 + buf * AT_KBUF + o) = R.v;
    if (BIAS) { if (tid < 64) *(LAS float*)(lds + AT_C0 + buf * 256 + tid * 4) = R.c; }
}

template <bool BIAS, bool SEL, int NS, int NMAP>
DI void flash_pass(const Ctx& C, const bf16_t* kbase, const bf16_t* vbase, const float* cbase, int j0, int j1, int wave_last, int lowtile,
                   const bf16x8 (&qf)[NMAP][NS], f32x16 (&o)[NMAP][2], float (&m)[NMAP], float (&l)[NMAP], float c1, int trow, unsigned selbits, int hh) {
    const int tid = C.tid, lane = C.lane, r = lane & 31;
    const int i16 = lane & 15, q4 = i16 >> 2, pp = i16 & 3, blk = (lane >> 4) & 1;
    TileRegs R;
    tile_gload<BIAS>(R, kbase, vbase, cbase, 64 * j0, tid);
    tile_lstore<BIAS>(R, C.lds, 0, tid);
    __syncthreads();
    int cur = 0;
    for (int j = j0; j <= j1; ++j) {
        if (j < j1) tile_gload<BIAS>(R, kbase, vbase, cbase, 64 * (j + 1), tid);
        if (j <= wave_last) {
            const LAS bf16_t* Kt = (const LAS bf16_t*)(C.lds + AT_K0 + cur * AT_KBUF);
            const LAS bf16_t* Vl = (const LAS bf16_t*)(C.lds + AT_V0 + cur * AT_KBUF) + (4 * hh + q4) * KP + 16 * blk + 4 * pp;
            const LAS float* Cl = (const LAS float*)(C.lds + AT_C0 + cur * 256) + 4 * hh;
            const int mmode = (j == wave_last) ? 1 : ((j == lowtile) ? 2 : 0);
            const bool kill = SEL ? (((selbits >> j) & 1u) == 0u) : false;
#pragma unroll
            for (int mp = 0; mp < NMAP; ++mp)
                tile_step<BIAS, SEL, NS>(Kt + r * KP + 8 * hh + mp * 32, Vl, Cl, qf[mp], o[mp], m[mp], l[mp], c1, mmode, 64 * j, trow, kill, hh);
        }
        if (j < j1) tile_lstore<BIAS>(R, C.lds, cur ^ 1, tid);
        __syncthreads();
        cur ^= 1;
    }
}

DI void store_row64(bf16_t* dst, const f32x16 (&v)[2], int hh) {
#pragma unroll
    for (int dt = 0; dt < 2; ++dt)
#pragma unroll
        for (int g4 = 0; g4 < 4; ++g4) { u32x2 w; w.x = pk2(v[dt][4 * g4], v[dt][4 * g4 + 1]); w.y = pk2(v[dt][4 * g4 + 2], v[dt][4 * g4 + 3]); *(u32x2*)(dst + 32 * dt + 8 * g4 + 4 * hh) = w; }
}

DI void attn_phase(const Ctx& C, ARGP a, int L) {
    const bf16_t* proj = (const bf16_t*)(C.ws + WS_BIG);
    bf16_t* mix = (bf16_t*)(C.ws + WS_MIX);
    unsigned* qctr = (unsigned*)(C.ws + WS_CTL) + CW_QUEUE + 64 * L;
    volatile LAS int* slot = (volatile LAS int*)(C.lds + AT_MISC);
    const int tid = C.tid, lane = C.lane, w = C.wave, r = lane & 31, hh = lane >> 5;
    for (;;) {
        __syncthreads();
        if (tid == 0) slot[0] = (int)atomicAdd(qctr, 1u);
        __syncthreads();
        const int idx = slot[0];
        if (idx >= 4096) break;
        const int qb8 = 7 - (idx >> 9), rem = idx & 511;
        if (rem >= 256) {
            const int r3 = rem - 256, b = r3 >> 3, h = r3 & 7; const int tok = 256 * qb8 + 32 * w + r; const size_t mrow = (size_t)b * SEQ + tok;
            bf16x8 qf[1][4];
#pragma unroll
            for (int s = 0; s < 4; ++s) qf[0][s] = *(const bf16x8*)(proj + mrow * NPROJ + C_FQ + h * 64 + 16 * s + 8 * hh);
            f32x16 o[1][2]; float m[1] = {-1e30f}, l[1] = {0.f};
#pragma unroll
            for (int dt = 0; dt < 2; ++dt)
#pragma unroll
                for (int i = 0; i < 16; ++i) o[0][dt][i] = 0.f;
            const bf16_t* kb = proj + (size_t)b * SEQ * NPROJ + C_FK + h * 64; const bf16_t* vb = proj + (size_t)b * SEQ * NPROJ + C_FV + h * 64;
            const float* cb = (const float*)(C.ws + WS_CKL) + (size_t)(b * 8 + h) * SEQ;
            flash_pass<true, false, 4, 1>(C, kb, vb, cb, 0, 4 * qb8 + 3, 4 * qb8 + (w >> 1), -1, qf, o, m, l, 0.125f * LOG2E, tok, 0xffffffffu, hh);
            const float lt = l[0] + shx<32>(l[0]); const float inv = 1.0f / lt;
#pragma unroll
            for (int dt = 0; dt < 2; ++dt)
#pragma unroll
                for (int i = 0; i < 16; ++i) o[0][dt][i] *= inv;
            store_row64(mix + mrow * DM + 512 + h * 64, o[0], hh);
        } else if (rem < 128) {
            const int b = rem >> 2, h = rem & 3; const int tok = 256 * qb8 + 32 * w + r; const size_t mrow = (size_t)b * SEQ + tok;
            bf16x8 qf[2][2];
#pragma unroll
            for (int mp = 0; mp < 2; ++mp)
#pragma unroll
                for (int s = 0; s < 2; ++s) qf[mp][s] = *(const bf16x8*)(proj + mrow * NPROJ + C_DQ + h * 64 + mp * 32 + 16 * s + 8 * hh);
            f32x16 o[2][2]; float m[2] = {-1e30f, -1e30f}, l[2] = {0.f, 0.f};
#pragma unroll
            for (int mp = 0; mp < 2; ++mp)
#pragma unroll
                for (int dt = 0; dt < 2; ++dt)
#pragma unroll
                    for (int i = 0; i < 16; ++i) o[mp][dt][i] = 0.f;
            const bf16_t* kb = proj + (size_t)b * SEQ * NPROJ + C_DK + h * 64; const bf16_t* vb = proj + (size_t)b * SEQ * NPROJ + C_DV + h * 64;
            flash_pass<false, false, 2, 2>(C, kb, vb, nullptr, 0, 4 * qb8 + 3, 4 * qb8 + (w >> 1), -1, qf, o, m, l, 0.17677669529f * LOG2E, tok, 0xffffffffu, hh);
            const float lam = ((const float*)(C.ws + WS_TBL + TB_LAM))[L]; const float li = 0.8f - 0.6f * expf(-0.3f * (float)L);
            const float i0 = 1.0f / (l[0] + shx<32>(l[0])), i1 = lam / (l[1] + shx<32>(l[1]));
            float ss = 0.f;
#pragma unroll
            for (int dt = 0; dt < 2; ++dt)
#pragma unroll
                for (int i = 0; i < 16; ++i) { const float v = o[0][dt][i] * i0 - o[1][dt][i] * i1; o[0][dt][i] = v; ss += v * v; }
            ss += shx<32>(ss);
            const float rms = (1.0f / sqrtf(ss * (1.0f / 64.0f) + LN_EPS)) * (1.0f - li);
            const float* sg = a->in[19] + L * 64;
#pragma unroll
            for (int dt = 0; dt < 2; ++dt)
#pragma unroll
                for (int g4 = 0; g4 < 4; ++g4) { const f32x4 gv = *(const f32x4*)(sg + 32 * dt + 8 * g4 + 4 * hh);
#pragma unroll
                    for (int e = 0; e < 4; ++e) o[0][dt][4 * g4 + e] *= rms * gv[e]; }
            store_row64(mix + mrow * DM + 256 + h * 64, o[0], hh);
        } else {
            const int r2 = rem - 128, b = r2 & 31, qb = 4 * qb8 + 3 - (r2 >> 5); const int tok = 64 * qb + 8 * w + (r >> 2), g = r & 3; const size_t mrow = (size_t)b * SEQ + tok;
            bf16x8 qf[1][4];
#pragma unroll
            for (int s = 0; s < 4; ++s) qf[0][s] = *(const bf16x8*)(proj + mrow * NPROJ + C_NQ + g * 64 + 16 * s + 8 * hh);
            const unsigned sel = ((const unsigned*)(C.ws + WS_SEL))[mrow];
            const bf16_t* pb = proj + (size_t)b * SEQ * NPROJ + C_NKV;
            f32x16 o[1][2], keep[2]; float m[1] = {-1e30f}, l[1] = {0.f};
#pragma unroll
            for (int dt = 0; dt < 2; ++dt)
#pragma unroll
                for (int i = 0; i < 16; ++i) o[0][dt][i] = 0.f;
            flash_pass<false, true, 4, 1>(C, pb + 128, pb + 192, nullptr, 0, qb, qb, -1, qf, o, m, l, 0.125f * LOG2E, tok, sel, hh);
            { const float g1 = 1.0f / (1.0f + __expf(-bf2f(proj[mrow * NPROJ + C_NG + g * 3 + 1]))); const float inv = g1 / (l[0] + shx<32>(l[0]));
              const float* oc = (const float*)(C.ws + WS_OCMP) + mrow * 256 + g * 64;
#pragma unroll
              for (int dt = 0; dt < 2; ++dt)
#pragma unroll
                  for (int g4 = 0; g4 < 4; ++g4) { const f32x4 cv = *(const f32x4*)(oc + 32 * dt + 8 * g4 + 4 * hh);
#pragma unroll
                      for (int e = 0; e < 4; ++e) { keep[dt][4 * g4 + e] = o[0][dt][4 * g4 + e] * inv + cv[e]; o[0][dt][4 * g4 + e] = 0.f; } } }
            m[0] = -1e30f; l[0] = 0.f;
            const int jlo = qb >= 8 ? qb - 8 : 0;
            flash_pass<false, false, 4, 1>(C, pb + 256, pb + 320, nullptr, jlo, qb, qb, qb >= 8 ? qb - 8 : -1, qf, o, m, l, 0.125f * LOG2E, tok, 0xffffffffu, hh);
            { const float g2 = 1.0f / (1.0f + __expf(-bf2f(proj[mrow * NPROJ + C_NG + g * 3 + 2]))); const float inv = g2 / (l[0] + shx<32>(l[0]));
#pragma unroll
              for (int dt = 0; dt < 2; ++dt)
#pragma unroll
                  for (int i = 0; i < 16; ++i) keep[dt][i] += o[0][dt][i] * inv; }
            store_row64(mix + mrow * DM + g * 64, keep, hh);
        }
    }
}
constexpr int LDS_BYTES = 147456;
constexpr int N_PHASES = 1 + 13 * DEPTH;

template <class Epi>
DI void run_gemm(const Ctx& C, const bf16_t* A, const bf16_t* Bt, int N, int K, const Epi& E, const bool opaque = false) {
    if (opaque) asm volatile("" : "+s"(K), "+s"(N));
    pg8::Gemm g{A, Bt, MTOK, N, K}; pg8::StaticOrder S; S.init(MTOK, N, C.G, C.bid);
    pg8::gemm_phase<Epi, pg8::StaticOrder, true, true>((LAS unsigned char*)C.lds, g, S, E, C.tid);
}

__global__ void __launch_bounds__(512, 2) mega_fwd(Args args_k) {
    const ARGP ap0 = (ARGP)__builtin_amdgcn_kernarg_segment_ptr();
    extern __shared__ __attribute__((aligned(16))) unsigned char lds_raw[];
    Ctx C0; Ctx& C = C0; const int wave_s = __builtin_amdgcn_readfirstlane((int)threadIdx.x >> 6); C.wave = wave_s; C.lane = 0; C.tid = 0; C.bid = blockIdx.x; C.G = gridDim.x;
    C.ws = args_k.ws; C.lds = (LAS unsigned char*)lds_raw;
    cg::grid_group grid = cg::this_grid();
#define BST ((volatile LAS unsigned*)(C.lds + 131072 + 256))
    if (threadIdx.x < 2) BST[threadIdx.x] = 0u;
    __syncthreads();
    (void)xcd_barrier_post((unsigned*)(C.ws + WS_CTL) + 4096, BST);
    const int lo = args_k.ph_lo, hi = args_k.ph_hi;
    float* X = args_k.out;
    bf16_t* XB = (bf16_t*)(C.ws + WS_XB); bf16_t* BIG = (bf16_t*)(C.ws + WS_BIG); bf16_t* MIX = (bf16_t*)(C.ws + WS_MIX);
#define PH_BEGIN(k) if (lo <= (k) && (k) < hi) { ARGP args = ap0; asm volatile("" : "+s"(args)); Ctx C = C0; { int l_ = (int)__builtin_amdgcn_mbcnt_hi(~0u, __builtin_amdgcn_mbcnt_lo(~0u, 0u)); asm volatile("" : "+v"(l_)); C.lane = l_; C.tid = wave_s * 64 + l_; int b_ = blockIdx.x, g_ = gridDim.x; asm volatile("" : "+s"(b_), "+s"(g_)); C.bid = b_; C.G = g_; }
#define PH_END(k) asm volatile("s_waitcnt vmcnt(0)" ::: "memory"); if ((k) + 1 < hi) { if ((k) == 0) grid.sync(); else { XcdBarrier xb_; xb_.bar = (unsigned*)(C.ws + WS_CTL) + 4096; xb_.x = xb_xcc_id(); xb_.st = BST; xcd_barrier(xb_); } } }
    PH_BEGIN(0) prep_phase(C, args); PH_END(0)
    for (int L = 0; L < DEPTH; ++L) {
        const int pb = 1 + 13 * L;
        unsigned char* wb = C.ws + WS_W + (size_t)L * W_LAYER;
        PH_BEGIN(pb + 0) { pg8::EpiSwiGLU E{BIG, DFFP}; run_gemm(C, L == 0 ? XB : MIX, (const bf16_t*)(wb + W_UP1), NUP, DM, E); } PH_END(pb + 0)
        PH_BEGIN(pb + 1) { pg8::EpiResid<true> E{nullptr, XB, DN_ALPHA, 0.5f, (const bf16_t*)(C.ws + (L == 0 ? WS_XB : WS_MIX))}; run_gemm(C, BIG, (const bf16_t*)(wb + W_DN1), DM, DFFP, E); } PH_END(pb + 1)
        PH_BEGIN(pb + 2) ln_phase(C, XB, args->in[2] + (size_t)(L * 3 + 0) * DM, args->in[3] + (size_t)(L * 3 + 0) * DM); PH_END(pb + 2)
        PH_BEGIN(pb + 3) { pg8::EpiProjRope E{C.ws, NPROJ}; run_gemm(C, XB, (const bf16_t*)(wb + W_IN), NPROJ, DM, E); } PH_END(pb + 3)
        PH_BEGIN(pb + 4) attn_prep_phase(C, args, L); PH_END(pb + 4)
        PH_BEGIN(pb + 5) cmp_attn_phase(C, L); PH_END(pb + 5)
        PH_BEGIN(pb + 6) attn_phase(C, args, L); PH_END(pb + 6)
        PH_BEGIN(pb + 7) { pg8::EpiResid<true> E{nullptr, XB, DN_ALPHA, 1.0f, XB}; run_gemm(C, MIX, (const bf16_t*)(wb + W_OUT), DM, DM, E); } PH_END(pb + 7)
        PH_BEGIN(pb + 8) ln_phase(C, XB, args->in[2] + (size_t)(L * 3 + 1) * DM, args->in[3] + (size_t)(L * 3 + 1) * DM); PH_END(pb + 8)
        PH_BEGIN(pb + 9) { pg8::EpiSwiGLU E{BIG, DFFP}; run_gemm(C, XB, (const bf16_t*)(wb + W_UP2), NUP, DM, E); } PH_END(pb + 9)
        PH_BEGIN(pb + 10) { pg8::EpiResid<true> E{nullptr, XB, DN_ALPHA, 0.5f, XB}; run_gemm(C, BIG, (const bf16_t*)(wb + W_DN2), DM, DFFP, E); } PH_END(pb + 10)
        PH_BEGIN(pb + 11) { ln_phase(C, XB, args->in[2] + (size_t)(L * 3 + 2) * DM, args->in[3] + (size_t)(L * 3 + 2) * DM); __syncthreads();
            pg8::EpiBf16 E{BIG, DM}; run_gemm(C, (const bf16_t*)(C.ws + WS_PB) + (size_t)L * MTOK * PLED, (const bf16_t*)(wb + W_PLEP), DM, PLED, E, true); } PH_END(pb + 11)
        PH_BEGIN(pb + 12) { pg8::EpiPle E{XB, L == DEPTH - 1 ? X : (float*)nullptr, L == DEPTH - 1 ? (bf16_t*)nullptr : MIX, args->in[22] + (size_t)L * DM, BIG}; run_gemm(C, XB, (const bf16_t*)(wb + W_PLEG), DM, DM, E); } PH_END(pb + 12)
    }
}

#ifndef MK_SPLIT
#define MK_SPLIT 0
#endif
extern "C" void kernel_launch(void* const* d_in, const int* in_sizes, int n_in, void* d_out, int out_size, void* d_ws, size_t ws_size, hipStream_t stream) {
    static int grid = 0;
    if (grid == 0) {
        if (n_in != 24 || out_size != MTOK * DM || ws_size < WS_END) { fprintf(stderr, "kernel_launch: unexpected shapes (n_in %d out %d ws %zu)\n", n_in, out_size, ws_size); grid = -1; return; }
        if (hipFuncSetAttribute((const void*)mega_fwd, hipFuncAttributeMaxDynamicSharedMemorySize, LDS_BYTES) != hipSuccess) { fprintf(stderr, "kernel_launch: hipFuncSetAttribute failed\n"); grid = -1; return; }
        int dev = 0, cus = 0, per_cu = 0; hipGetDevice(&dev); hipDeviceGetAttribute(&cus, hipDeviceAttributeMultiprocessorCount, dev);
        hipOccupancyMaxActiveBlocksPerMultiprocessor(&per_cu, (const void*)mega_fwd, 512, LDS_BYTES);
        if (per_cu < 1) { fprintf(stderr, "kernel_launch: occupancy query says %d blocks/CU\n", per_cu); per_cu = 1; }
        (void)hipGetLastError();
        grid = cus;
    }
    if (grid < 0) return;
    hipMemsetAsync((char*)d_ws + WS_CTL, 0, 1 * MiB, stream);
    Args a{};
    for (int i = 0; i < 24; ++i) a.in[i] = (const float*)d_in[i];
    a.out = (float*)d_out; a.ws = (unsigned char*)d_ws;
#if MK_SPLIT
    for (int p = 0; p < N_PHASES; ++p) { a.ph_lo = p; a.ph_hi = p + 1; hipLaunchKernelGGL(mega_fwd, dim3(grid), dim3(512), LDS_BYTES, stream, a); }
#else
    a.ph_lo = 0; a.ph_hi = N_PHASES;
    void* kargs[] = {&a};
    hipError_t e = hipLaunchCooperativeKernel((const void*)mega_fwd, dim3(grid), dim3(512), kargs, LDS_BYTES, stream);
    if (e != hipSuccess) fprintf(stderr, "cooperative launch failed: %s (grid %d)\n", hipGetErrorString(e), grid);
#endif
}
```
